# Optimizing an MI355X kernel written in HIP

```python
import jax, jax.numpy as jnp
from jax import lax
import numpy as np

D_MODEL = 1024
BATCH = 4
SEQ = 8192
DEPTH = 2

HEAD_DIM = 64
CONV_CH = 256
CONV_WIDTH = 3
HGRN_HEADS = 4
HGRN_DK = 64
HGRN_DV = 64
HGRN_QK = HGRN_HEADS * HGRN_DK
HGRN_WIDTH = HGRN_HEADS * HGRN_DV
CHUNK = 64
FOX_HEADS = 8
FOX_WIDTH = FOX_HEADS * HEAD_DIM
Q_BLOCK = 128
MIX_WIDTH = CONV_CH + HGRN_WIDTH + FOX_WIDTH
MIX_IN_SIZES = (CONV_CH, CONV_CH, CONV_CH,
                HGRN_QK, HGRN_QK, HGRN_WIDTH, HGRN_WIDTH,
                FOX_WIDTH, FOX_WIDTH, FOX_WIDTH, FOX_HEADS)
MIX_IN = sum(MIX_IN_SIZES)
D_FF = 2816
EPS = 1e-6
MASK_VALUE = -1e30

kernel_name = "hybrid_parallel_conv_hgrn2_fox_macaron"


def rms_norm(x, gain):
    xf = x.astype(jnp.float32)
    inv = lax.rsqrt(jnp.mean(xf * xf, axis=-1, keepdims=True) + EPS)
    return (xf * inv).astype(x.dtype) * gain


def swiglu(h, w_in, w_out):
    gate, up = jnp.split(h @ w_in, 2, axis=-1)
    return (jax.nn.silu(gate) * up) @ w_out


def short_conv_mixer(x_in, b_gate, c_gate, conv_w):
    u = c_gate * x_in
    taps = conv_w[:, None, :].astype(u.dtype)
    y = lax.conv_general_dilated(u, taps, window_strides=(1,),
                                 padding=((CONV_WIDTH - 1, 0),),
                                 dimension_numbers=('NWC', 'WIO', 'NWC'),
                                 feature_group_count=CONV_CH)
    return b_gate * y


def hgrn2_mixer(q, f_logit, v, g, lb, out_gain):
    f32 = jnp.float32
    bsz, seqlen, _ = q.shape
    n_chunks = seqlen // CHUNK
    z = f_logit.astype(f32)
    lb = lb.astype(f32)
    log_f = jax.nn.log_sigmoid(z) + jnp.log1p(lb * jnp.exp(-z))
    k = (1.0 - lb) * jax.nn.sigmoid(-z)

    def to_chunks(t, d):
        return t.astype(f32).reshape(bsz, n_chunks, CHUNK, HGRN_HEADS, d).transpose(1, 0, 3, 2, 4)

    qc, kc, lfc = to_chunks(q, HGRN_DK), to_chunks(k, HGRN_DK), to_chunks(log_f, HGRN_DK)
    vc = to_chunks(v, HGRN_DV)
    causal = jnp.tril(jnp.ones((CHUNK, CHUNK), dtype=bool))[:, :, None]

    def step(state, inp):
        qb, kb, vb, lfb = inp
        bcum = jnp.cumsum(lfb, axis=-2)
        rel = bcum[..., :, None, :] - bcum[..., None, :, :]
        decay = jnp.where(causal, jnp.exp(jnp.where(causal, rel, 0.0)), 0.0)
        scores = jnp.einsum('bhtd,bhsd,bhtsd->bhts', qb, kb, decay)
        o = (jnp.einsum('bhts,bhsv->bhtv', scores, vb)
             + jnp.einsum('bhtd,bhdv->bhtv', qb * jnp.exp(bcum), state))
        b_last = bcum[..., -1:, :]
        state = (jnp.exp(b_last[..., 0, :])[..., None] * state
                 + jnp.einsum('bhsd,bhsv->bhdv', kb * jnp.exp(b_last - bcum), vb))
        return state, o

    s0 = jnp.zeros((bsz, HGRN_HEADS, HGRN_DK, HGRN_DV), f32)
    _, o = lax.scan(step, s0, (qc, kc, vc, lfc))
    o = o.transpose(1, 0, 3, 2, 4).reshape(bsz, seqlen, HGRN_HEADS, HGRN_DV)
    gate = g.astype(f32).reshape(bsz, seqlen, HGRN_HEADS, HGRN_DV)
    o = rms_norm(o, out_gain) * jax.nn.silu(gate)
    return o.reshape(bsz, seqlen, HGRN_WIDTH).astype(q.dtype)


def fox_mixer(q, k, v, f_logit, f_bias, q_gain, k_gain):
    f32 = jnp.float32
    bsz, seqlen, _ = q.shape

    def heads(t):
        return t.reshape(bsz, seqlen, FOX_HEADS, HEAD_DIM).transpose(0, 2, 1, 3)

    qh = rms_norm(heads(q), q_gain) * (HEAD_DIM ** -0.5)
    kh = rms_norm(heads(k), k_gain)
    vh = heads(v)
    log_f = jax.nn.log_sigmoid((f_logit + f_bias).astype(f32))
    cum = jnp.cumsum(log_f, axis=1).transpose(0, 2, 1)
    kpos = jnp.arange(seqlen)

    def block(i):
        start = i * Q_BLOCK
        qb = lax.dynamic_slice_in_dim(qh, start, Q_BLOCK, axis=2)
        cb = lax.dynamic_slice_in_dim(cum, start, Q_BLOCK, axis=2)
        qpos = start + jnp.arange(Q_BLOCK)
        s = (jnp.einsum('bhqd,bhkd->bhqk', qb, kh).astype(f32)
             + (cb[..., :, None] - cum[..., None, :]))
        s = jnp.where(qpos[:, None] >= kpos[None, :], s, MASK_VALUE)
        p = jax.nn.softmax(s, axis=-1)
        return jnp.einsum('bhqk,bhkd->bhqd', p.astype(vh.dtype), vh)

    o = lax.map(block, jnp.arange(seqlen // Q_BLOCK))
    return o.transpose(1, 0, 3, 2, 4).reshape(bsz, seqlen, FOX_WIDTH)


def setup_inputs(seed: int = 0) -> dict:
    key = jax.random.key(seed)
    ks = jax.random.split(key, 17)
    nrm = jax.random.normal
    f32 = jnp.float32
    return {
        "x": nrm(ks[0], (BATCH, SEQ, D_MODEL), f32),
        "ffn1_norm": 1.0 + 0.02 * nrm(ks[1], (DEPTH, D_MODEL), f32),
        "ffn1_w_in": nrm(ks[2], (DEPTH, D_MODEL, 2 * D_FF), f32) * D_MODEL ** -0.5,
        "ffn1_w_out": nrm(ks[3], (DEPTH, D_FF, D_MODEL), f32) * D_FF ** -0.5,
        "mix_norm": 1.0 + 0.02 * nrm(ks[4], (DEPTH, D_MODEL), f32),
        "w_mix_in": nrm(ks[5], (DEPTH, D_MODEL, MIX_IN), f32) * D_MODEL ** -0.5,
        "conv_w": nrm(ks[6], (DEPTH, CONV_WIDTH, CONV_CH), f32) * CONV_WIDTH ** -0.5,
        "hgrn_lb_logits": nrm(ks[7], (DEPTH, HGRN_QK), f32),
        "hgrn_out_gain": 1.0 + 0.02 * nrm(ks[8], (DEPTH, HGRN_DV), f32),
        "fox_q_gain": 1.0 + 0.02 * nrm(ks[9], (DEPTH, HEAD_DIM), f32),
        "fox_k_gain": 1.0 + 0.02 * nrm(ks[10], (DEPTH, HEAD_DIM), f32),
        "fox_f_bias": 2.0 + 0.5 * nrm(ks[11], (DEPTH, FOX_HEADS), f32),
        "w_mix_out": nrm(ks[12], (DEPTH, MIX_WIDTH, D_MODEL), f32) * MIX_WIDTH ** -0.5,
        "ffn2_norm": 1.0 + 0.02 * nrm(ks[13], (DEPTH, D_MODEL), f32),
        "ffn2_w_in": nrm(ks[14], (DEPTH, D_MODEL, 2 * D_FF), f32) * D_MODEL ** -0.5,
        "ffn2_w_out": nrm(ks[15], (DEPTH, D_FF, D_MODEL), f32) * D_FF ** -0.5,
    }


def reference(x, ffn1_norm, ffn1_w_in, ffn1_w_out, mix_norm, w_mix_in, conv_w,
              hgrn_lb_logits, hgrn_out_gain, fox_q_gain, fox_k_gain, fox_f_bias,
              w_mix_out, ffn2_norm, ffn2_w_in, ffn2_w_out):
    lb_soft = jax.nn.softmax(hgrn_lb_logits.astype(jnp.float32), axis=0)
    lower_bounds = jnp.clip(jnp.cumsum(lb_soft, axis=0) - lb_soft[0:1], 0.0, 1.0)
    split_at = [int(s) for s in np.cumsum(MIX_IN_SIZES)[:-1]]
    for l in range(DEPTH):
        x = x + 0.5 * swiglu(rms_norm(x, ffn1_norm[l]), ffn1_w_in[l], ffn1_w_out[l])
        h = rms_norm(x, mix_norm[l]) @ w_mix_in[l]
        (c_x, c_b, c_c, h_q, h_f, h_i, h_g, f_q, f_k, f_v, f_f) = jnp.split(h, split_at, axis=-1)
        y = jnp.concatenate([
            short_conv_mixer(c_x, c_b, c_c, conv_w[l]),
            hgrn2_mixer(h_q, h_f, h_i, h_g, lower_bounds[l], hgrn_out_gain[l]),
            fox_mixer(f_q, f_k, f_v, f_f, fox_f_bias[l], fox_q_gain[l], fox_k_gain[l]),
        ], axis=-1)
        x = x + y @ w_mix_out[l]
        x = x + 0.5 * swiglu(rms_norm(x, ffn2_norm[l]), ffn2_w_in[l], ffn2_w_out[l])
    return x
```

```cpp
#include <hip/hip_runtime.h>
#include <cstdio>
#include <cstdint>
namespace pg8 {
#define PG8_LAS __attribute__((address_space(3)))
typedef unsigned short bf16_t;
typedef short bf16x8 __attribute__((ext_vector_type(8)));
typedef float f32x4 __attribute__((ext_vector_type(4)));
typedef unsigned u32x4 __attribute__((ext_vector_type(4)));
constexpr int BM = 256, BK = 64, HALF = 128, HTB = HALF * BK * 2  , STAGE_BYTES = 8 * HTB, NXCD = 8, WGM = 8;

__host__ __device__ __forceinline__ int lds_byte(int r, int c) { const int st = (r >> 4) * 2 + (c >> 5), rr = r & 15, cc = c & 31, ob = rr * 64 + cc * 2; return st * 1024 + (ob ^ (((ob >> 9) & 1) << 5)); }
__host__ __device__ __forceinline__ void stage_rc(int b, int& R, int& C) { const int st = b / 1024, sb = b % 1024, swz = sb ^ (((sb >> 9) & 1) << 5); R = (st >> 1) * 16 + swz / 64; C = (st & 1) * 32 + (swz % 64) / 2; }
__host__ __device__ __forceinline__ int perm32(int rho) { const int n = rho >> 4, i = rho & 15; return 8 * (i >> 2) + 4 * n + (i & 3); }

struct Unit { int pm, pn; };
struct Gemm { const bf16_t* A; const bf16_t* Bt; int M, N, K; };

struct StaticOrder {
    int nM, nN, nwg, G, c;
    __host__ __device__ void init(int M, int N, int G_, int c_) { nM = M / BM; nN = N / BM; nwg = nM * nN; G = G_; c = c_; }
    __host__ __device__ bool next(int i, Unit& u) const {
        const long L = (long)i * G + c; if (L >= nwg) return false;
        int wgid = (int)L; { const int q = nwg / NXCD, r = nwg % NXCD, xcd = wgid % NXCD, off = wgid / NXCD; wgid = (xcd < r ? xcd * (q + 1) : r * (q + 1) + (xcd - r) * q) + off; }
        const int nig = WGM * nN, gid = wgid / nig, fm = gid * WGM, gsz = (nM - fm) < WGM ? (nM - fm) : WGM;
        u.pm = fm + ((wgid % nig) % gsz); u.pn = (wgid % nig) / gsz; return true;
    }
    __device__ __forceinline__ void a_ready(const Unit&) const {}
    __device__ __forceinline__ void done(const Unit&) const {}
};

__device__ __forceinline__ unsigned cvt_pk_bf16(float lo, float hi) { unsigned r; asm volatile("v_cvt_pk_bf16_f32 %0, %1, %2" : "=v"(r) : "v"(lo), "v"(hi)); return r; }
typedef float f32x2 __attribute__((ext_vector_type(2)));
constexpr float RMS_EPS = 1e-6f;
__device__ __forceinline__ float silu_f(float g) { return g * __builtin_amdgcn_rcpf(1.0f + __builtin_amdgcn_exp2f(-1.4426950408889634f * g)); }
struct EpiGlu {
    static constexpr bool PERM = true, AFTER_DRAIN = false;
    bf16_t* O; int ldc; const float* rss;
    __device__ __forceinline__ void operator()(const f32x4 (&acc)[2][2][4][2], const Unit& u, int wr, int wc, int fr, int fq) const {
        const int row0 = u.pm * BM + wr * 64 + fr, col0 = u.pn * HALF + wc * 32 + 8 * fq;
#pragma unroll
        for (int ai = 0; ai < 2; ++ai)
#pragma unroll
            for (int m = 0; m < 4; ++m) { const int row = row0 + ai * HALF + m * 16; const float inv = rsqrtf(rss[row] * (1.0f / 1024.0f) + RMS_EPS);
                const f32x4 g0 = acc[ai][0][m][0] * inv, g1 = acc[ai][0][m][1] * inv, u0 = acc[ai][1][m][0] * inv, u1 = acc[ai][1][m][1] * inv;
                u32x4 w; w.x = cvt_pk_bf16(silu_f(g0[0]) * u0[0], silu_f(g0[1]) * u0[1]); w.y = cvt_pk_bf16(silu_f(g0[2]) * u0[2], silu_f(g0[3]) * u0[3]);
                w.z = cvt_pk_bf16(silu_f(g1[0]) * u1[0], silu_f(g1[1]) * u1[1]); w.w = cvt_pk_bf16(silu_f(g1[2]) * u1[2], silu_f(g1[3]) * u1[3]);
                *(u32x4*)(O + (size_t)row * ldc + col0) = w; }
    }
};
typedef unsigned u32x2 __attribute__((ext_vector_type(2)));
struct EpiResid {
    static constexpr bool PERM = false, AFTER_DRAIN = false;
    const float* base; float* out; bf16_t* xb; float* rss_next; float alpha;
    __device__ __forceinline__ void operator()(const f32x4 (&acc)[2][2][4][2], const Unit& u, int wr, int wc, int fr, int fq) const {
        const int row0 = u.pm * BM + wr * 64 + fr, col0 = u.pn * BM + wc * 32 + 4 * fq;
#pragma unroll
        for (int ai = 0; ai < 2; ++ai)
#pragma unroll
            for (int m = 0; m < 4; ++m) { const int row = row0 + ai * HALF + m * 16; const size_t off = (size_t)row * 1024 + col0; float ss = 0.f;
#pragma unroll
                for (int bj = 0; bj < 2; ++bj)
#pragma unroll
                    for (int n = 0; n < 2; ++n) { const f32x4 b = *(const f32x4*)(base + off + bj * HALF + n * 16); const f32x4 o = b + acc[ai][bj][m][n] * alpha;
                        *(f32x4*)(out + off + bj * HALF + n * 16) = o; ss += (o[0] * o[0] + o[1] * o[1]) + (o[2] * o[2] + o[3] * o[3]);
                        if (xb) { u32x2 w; w.x = cvt_pk_bf16(o[0], o[1]); w.y = cvt_pk_bf16(o[2], o[3]); *(u32x2*)(xb + off + bj * HALF + n * 16) = w; } }
                ss += __shfl_xor(ss, 16); ss += __shfl_xor(ss, 32);
                if (rss_next && fq == 0) atomicAdd(rss_next + row, ss); }
    }
};
struct EpiMix {
    static constexpr bool PERM = true, AFTER_DRAIN = false;
    bf16_t* H; const float* rss; const float* qgain; const float* kgain; const float* fbias; float* foxlf;
    __device__ __forceinline__ void operator()(const f32x4 (&acc)[2][2][4][2], const Unit& u, int wr, int wc, int fr, int fq) const {
        const int row0 = u.pm * BM + wr * 64 + fr, col0 = u.pn * BM + wc * 64 + 8 * fq;
        const int mode = (u.pn == 7 || u.pn == 8) ? 1 : (u.pn == 9 || u.pn == 10) ? 2 : (u.pn == 13) ? 3 : 0;
        f32x4 gv[2][2];
#pragma unroll
        for (int bj = 0; bj < 2; ++bj)
#pragma unroll
            for (int n = 0; n < 2; ++n) gv[bj][n] = (f32x4){1.f, 1.f, 1.f, 1.f};
        if (mode == 1 || mode == 2) { const float* gp = (mode == 1 ? qgain : kgain) + 8 * fq; const float sc = (mode == 1) ? 0.125f * 1.4426950408889634f : 1.0f;
#pragma unroll
            for (int bj = 0; bj < 2; ++bj)
#pragma unroll
                for (int n = 0; n < 2; ++n) gv[bj][n] = *(const f32x4*)(gp + 32 * bj + 4 * n) * sc; }
#pragma unroll
        for (int ai = 0; ai < 2; ++ai)
#pragma unroll
            for (int m = 0; m < 4; ++m) { const int row = row0 + ai * HALF + m * 16; float inv = rsqrtf(rss[row] * (1.0f / 1024.0f) + RMS_EPS);
                f32x4 v[2][2];
#pragma unroll
                for (int bj = 0; bj < 2; ++bj)
#pragma unroll
                    for (int n = 0; n < 2; ++n) v[bj][n] = acc[ai][bj][m][n] * inv;
                if (mode == 1 || mode == 2) { float ss = 0.f;
#pragma unroll
                    for (int bj = 0; bj < 2; ++bj)
#pragma unroll
                        for (int n = 0; n < 2; ++n) ss += (v[bj][n][0] * v[bj][n][0] + v[bj][n][1] * v[bj][n][1]) + (v[bj][n][2] * v[bj][n][2] + v[bj][n][3] * v[bj][n][3]);
                    ss += __shfl_xor(ss, 16); ss += __shfl_xor(ss, 32);
                    const float hinv = rsqrtf(ss * (1.0f / 64.0f) + RMS_EPS);
#pragma unroll
                    for (int bj = 0; bj < 2; ++bj)
#pragma unroll
                        for (int n = 0; n < 2; ++n) v[bj][n] = v[bj][n] * hinv * gv[bj][n]; }
                if (mode == 3 && wc == 0 && fq == 0) { const int b = row >> 13, t = row & 8191;
#pragma unroll
                    for (int n = 0; n < 2; ++n)
#pragma unroll
                        for (int i = 0; i < 4; ++i) { const int h = 4 * n + i; const float a = v[0][n][i] + fbias[h];
                            const float ls = fminf(a, 0.f) - log1pf(__expf(-fabsf(a)));
                            foxlf[(size_t)(b * 8 + h) * 8192 + t] = ls * 1.4426950408889634f; } }
#pragma unroll
                for (int bj = 0; bj < 2; ++bj) { u32x4 w; w.x = cvt_pk_bf16(v[bj][0][0], v[bj][0][1]); w.y = cvt_pk_bf16(v[bj][0][2], v[bj][0][3]); w.z = cvt_pk_bf16(v[bj][1][0], v[bj][1][1]); w.w = cvt_pk_bf16(v[bj][1][2], v[bj][1][3]);
                    *(u32x4*)(H + (size_t)row * 3584 + col0 + 32 * bj) = w; } }
    }
};
template <class Epi, class Sched, bool ALIGN_EPI = false, bool SP2 = false>
__device__ __forceinline__ void gemm_phase(PG8_LAS unsigned char* lds, const Gemm g, const Sched& S, const Epi& E) {
    int tid_l = threadIdx.x; asm volatile("" : "+v"(tid_l));
    const int tid = tid_l, wid = __builtin_amdgcn_readfirstlane(tid >> 6), lane = tid & 63, wr = wid >> 2, wc = wid & 3, fr = lane & 15, fq = lane >> 4;
    const int K = g.K, nt = K / BK;
    unsigned voffA[2], voffB[2];
#pragma unroll
    for (int i = 0; i < 2; ++i) { int R, C; stage_rc(tid * 16 + i * 8192, R, C); const int Rb = Epi::PERM ? ((R & ~31) + perm32(R & 31)) : R;
        voffA[i] = (unsigned)(R * K + C) * 2u; voffB[i] = (unsigned)(Rb * K + C) * 2u; }
    const size_t kstep = (size_t)(BK * 2);
    const size_t hstep = (size_t)HALF * K * 2;
    const size_t tstep = 2 * hstep;
    const unsigned ldsw = (unsigned)wid * 1024u;
    const int aoff = lds_byte(wr * 64 + fr, fq * 8), boff = lds_byte(wc * 32 + fr, fq * 8);
#define PG8_SA(b, h) (((b) * 2 + (h)) * HTB)
#define PG8_SB(b, h) ((4 + (b) * 2 + (h)) * HTB)
#define PG8_STAGE(bufoff, gbase, voff) do { _Pragma("unroll") for (int _i = 0; _i < 2; ++_i) \
        __builtin_amdgcn_global_load_lds((const unsigned*)((const char*)(gbase) + (voff)[_i]), (PG8_LAS unsigned*)(lds + (bufoff) + ldsw + _i * 8192), 16, 0, 0); } while (0)
#define PG8_LDA(dst, b, h) do { _Pragma("unroll") for (int m = 0; m < 4; ++m) _Pragma("unroll") for (int k = 0; k < 2; ++k) dst[m][k] = *(const PG8_LAS bf16x8*)(lds + PG8_SA(b, h) + aoff + m * 2048 + k * 1024); } while (0)
#define PG8_LDB(dst, b, h) do { _Pragma("unroll") for (int n = 0; n < 2; ++n) _Pragma("unroll") for (int k = 0; k < 2; ++k) dst[n][k] = *(const PG8_LAS bf16x8*)(lds + PG8_SB(b, h) + boff + n * 2048 + k * 1024); } while (0)
#define PG8_MMA(ai, bj, At, Bt) do { __builtin_amdgcn_s_setprio(1); _Pragma("unroll") for (int m = 0; m < 4; ++m) _Pragma("unroll") for (int n = 0; n < 2; ++n) _Pragma("unroll") for (int k = 0; k < 2; ++k) \
        acc[ai][bj][m][n] = __builtin_amdgcn_mfma_f32_16x16x32_bf16(Bt[n][k], At[m][k], acc[ai][bj][m][n], 0, 0, 0); __builtin_amdgcn_s_setprio(0); } while (0)
#define PG8_WAIT_V(n) asm volatile("s_waitcnt vmcnt(" #n ")" ::: "memory")
#define PG8_WAIT_L(n) asm volatile("s_waitcnt lgkmcnt(" #n ")" ::: "memory")
#define PG8_BAR __builtin_amdgcn_s_barrier()
#define PG8_SCHED __builtin_amdgcn_sched_barrier(0)
    Unit cur, nxt; int ui = 0;
    if (!S.next(0, cur)) return;
    f32x4 acc[2][2][4][2];
#pragma unroll
    for (int a = 0; a < 2; ++a)
#pragma unroll
        for (int b = 0; b < 2; ++b)
#pragma unroll
            for (int m = 0; m < 4; ++m)
#pragma unroll
                for (int n = 0; n < 2; ++n) acc[a][b][m][n] = (f32x4){0.f, 0.f, 0.f, 0.f};
    bf16x8 At[4][2], B0[2][2], B1[2][2];
    const char* cA = (const char*)g.A + (size_t)cur.pm * tstep; const char* cB = (const char*)g.Bt + (size_t)cur.pn * tstep;
    S.a_ready(cur);
    if constexpr (SP2) {
        PG8_STAGE(PG8_SB(0, 0), cB, voffB); PG8_STAGE(PG8_SB(0, 1), cB + hstep, voffB); PG8_STAGE(PG8_SA(0, 0), cA, voffA); PG8_STAGE(PG8_SA(0, 1), cA + hstep, voffA);
        if (wr == 1) PG8_BAR;
        PG8_WAIT_V(2); PG8_BAR;
        PG8_STAGE(PG8_SB(1, 0), cB + kstep, voffB); PG8_STAGE(PG8_SA(1, 0), cA + kstep, voffA); PG8_STAGE(PG8_SB(1, 1), cB + hstep + kstep, voffB);
        PG8_WAIT_V(6); PG8_BAR;
    } else {
        PG8_STAGE(PG8_SB(0, 0), cB, voffB); PG8_STAGE(PG8_SA(0, 0), cA, voffA); PG8_STAGE(PG8_SB(0, 1), cB + hstep, voffB); PG8_STAGE(PG8_SA(0, 1), cA + hstep, voffA);
        if (wr == 1) PG8_BAR;
        PG8_WAIT_V(4); PG8_BAR;
        PG8_STAGE(PG8_SB(1, 0), cB + kstep, voffB); PG8_STAGE(PG8_SA(1, 0), cA + kstep, voffA); PG8_STAGE(PG8_SB(1, 1), cB + hstep + kstep, voffB);
        PG8_WAIT_V(6); PG8_BAR;
    }
    for (;;) {
        const bool has_next = S.next(ui + 1, nxt);
        const char* nA = has_next ? (const char*)g.A + (size_t)nxt.pm * tstep : cA; const char* nB = has_next ? (const char*)g.Bt + (size_t)nxt.pn * tstep : cB;
        for (int t = 0; t < nt; t += 2) {
            const bool last = (t == nt - 2);
            const char* a1 = cA + (size_t)(t + 1) * kstep;
            const char* a2 = last ? nA : cA + (size_t)(t + 2) * kstep; const char* b2 = last ? nB : cB + (size_t)(t + 2) * kstep;
            const char* a3 = a2 + kstep; const char* b3 = b2 + kstep;
            if (last && has_next) S.a_ready(nxt);
            if constexpr (SP2) {
            PG8_LDB(B0, 0, 0); PG8_LDB(B1, 0, 1); PG8_SCHED; PG8_LDA(At, 0, 0); PG8_STAGE(PG8_SA(1, 1), a1 + hstep, voffA);
            PG8_WAIT_V(8); PG8_WAIT_L(0); PG8_BAR; PG8_MMA(0, 0, At, B0); PG8_MMA(0, 1, At, B1); PG8_BAR; PG8_SCHED;
            PG8_LDA(At, 0, 1); PG8_STAGE(PG8_SB(0, 0), b2, voffB); PG8_STAGE(PG8_SB(0, 1), b2 + hstep, voffB); PG8_STAGE(PG8_SA(0, 0), a2, voffA);
            PG8_WAIT_V(8); PG8_WAIT_L(0); PG8_BAR; PG8_MMA(1, 0, At, B0); PG8_MMA(1, 1, At, B1); PG8_BAR; PG8_SCHED;
            PG8_LDB(B0, 1, 0); PG8_LDB(B1, 1, 1); PG8_SCHED; PG8_LDA(At, 1, 0); PG8_STAGE(PG8_SA(0, 1), a2 + hstep, voffA);
            PG8_WAIT_V(8); PG8_WAIT_L(0); PG8_BAR; PG8_MMA(0, 0, At, B0); PG8_MMA(0, 1, At, B1); PG8_BAR; PG8_SCHED;
            PG8_LDA(At, 1, 1); PG8_STAGE(PG8_SB(1, 0), b3, voffB); PG8_STAGE(PG8_SB(1, 1), b3 + hstep, voffB); PG8_STAGE(PG8_SA(1, 0), a3, voffA);
            PG8_WAIT_V(8); PG8_WAIT_L(0); PG8_BAR; PG8_MMA(1, 0, At, B0); PG8_MMA(1, 1, At, B1); PG8_BAR; PG8_SCHED;
            } else {
            PG8_LDB(B0, 0, 0); PG8_SCHED; PG8_LDA(At, 0, 0); PG8_STAGE(PG8_SA(1, 1), a1 + hstep, voffA);
            PG8_WAIT_L(8); PG8_BAR; PG8_WAIT_L(0); PG8_MMA(0, 0, At, B0); PG8_BAR; PG8_SCHED;
            PG8_LDB(B1, 0, 1); PG8_STAGE(PG8_SB(0, 0), b2, voffB);
            PG8_BAR; PG8_WAIT_L(0); PG8_MMA(0, 1, At, B1); PG8_BAR;
            PG8_LDA(At, 0, 1); PG8_STAGE(PG8_SA(0, 0), a2, voffA);
            PG8_BAR; PG8_WAIT_L(0); PG8_MMA(1, 0, At, B0); PG8_BAR; PG8_SCHED;
            PG8_STAGE(PG8_SB(0, 1), b2 + hstep, voffB);
            PG8_WAIT_V(6); PG8_BAR; PG8_MMA(1, 1, At, B1); PG8_BAR;
            PG8_LDB(B0, 1, 0); PG8_SCHED; PG8_LDA(At, 1, 0); PG8_STAGE(PG8_SA(0, 1), a2 + hstep, voffA);
            PG8_WAIT_L(8); PG8_BAR; PG8_WAIT_L(0); PG8_MMA(0, 0, At, B0); PG8_BAR; PG8_SCHED;
            PG8_LDB(B1, 1, 1); PG8_STAGE(PG8_SB(1, 0), b3, voffB);
            PG8_BAR; PG8_WAIT_L(0); PG8_MMA(0, 1, At, B1); PG8_BAR;
            PG8_LDA(At, 1, 1); PG8_STAGE(PG8_SA(1, 0), a3, voffA);
            PG8_BAR; PG8_WAIT_L(0); PG8_MMA(1, 0, At, B0); PG8_BAR; PG8_SCHED;
            PG8_STAGE(PG8_SB(1, 1), b3 + hstep, voffB);
            PG8_WAIT_V(6); PG8_BAR; PG8_MMA(1, 1, At, B1); PG8_BAR;
            }
        }
        if constexpr (ALIGN_EPI) { if (wr == 0) PG8_BAR; }
        if constexpr (!Epi::AFTER_DRAIN) { E(acc, cur, wr, wc, fr, fq); S.done(cur); }
        if (!has_next) break;
#pragma unroll
        for (int a = 0; a < 2; ++a)
#pragma unroll
            for (int b = 0; b < 2; ++b)
#pragma unroll
                for (int m = 0; m < 4; ++m)
#pragma unroll
                    for (int n = 0; n < 2; ++n) acc[a][b][m][n] = (f32x4){0.f, 0.f, 0.f, 0.f};
        cur = nxt; cA = nA; cB = nB; ++ui;
        if constexpr (ALIGN_EPI) { if (wr == 1) PG8_BAR; }
    }
    PG8_WAIT_V(0);
    if constexpr (!ALIGN_EPI) { if (wr == 0) PG8_BAR; }
    PG8_BAR;
    if constexpr (Epi::AFTER_DRAIN) { E.fused(acc, cur, wr, wc, fr, fq, lds, wid, lane); S.done(cur); }
#undef PG8_SA
#undef PG8_SB
#undef PG8_STAGE
#undef PG8_LDA
#undef PG8_LDB
#undef PG8_MMA
#undef PG8_WAIT_V
#undef PG8_WAIT_L
#undef PG8_BAR
#undef PG8_SCHED
}
}
#include <hip/hip_bf16.h>
#include <cmath>
namespace attn_body {
using bf16=__hip_bfloat16;
using bf16x8=__attribute__((ext_vector_type(8)))short;
using s16x4=__attribute__((ext_vector_type(4)))short;
using f32x16=__attribute__((ext_vector_type(16)))float;
using u32x4=__attribute__((ext_vector_type(4)))unsigned;
constexpr int BATCH=4,NHEAD=8,SEQ=8192,D=64,HP=3584,OP=1024;
constexpr int NW=8,QBLK=32,QB=QBLK*NW,KVBLK=64,NQB=SEQ/QB;
constexpr int ATTN_UNIT_ROWS=QB;
__device__ __forceinline__ int crow(int r,int hi){return (r&3)+8*(r>>2)+4*hi;}
#define SBAR() __builtin_amdgcn_sched_barrier(0)
__device__ __forceinline__ void cmask(f32x16&p0,f32x16&p1,int jb,int qrel,int hi){
  const float NEG=-INFINITY; int kb=64*jb+4*hi;
  #pragma unroll
  for(int r=0;r<16;++r){int kv=kb+(r&3)+8*(r>>2); if(kv>qrel)p0[r]=NEG; if(kv+32>qrel)p1[r]=NEG;}
}

constexpr int NSLOT=3, SLOTB=8192;
constexpr int LDS_K=0, LDS_V=NSLOT*SLOTB, LDS_WS=2*NSLOT*SLOTB, LDS_OST=LDS_WS+NW*64*4, LDS_BIAS=LDS_OST+NW*4096, LDS_BYTES=LDS_BIAS+SEQ*4;
constexpr float C2=0.125f*1.4426950408889634f;
__device__ __forceinline__ void glds16(const void*gsrc,unsigned lds_dst){unsigned keep;
  asm volatile("s_mov_b32 %0, m0\n\ts_mov_b32 m0, %2\n\ts_nop 0\n\tglobal_load_lds_dwordx4 %1, off\n\ts_mov_b32 m0, %0":"=&s"(keep):"v"(gsrc),"s"(lds_dst):"memory");}
__device__ __forceinline__ float max3f(float a,float b,float c){float r;asm("v_max3_f32 %0, %1, %2, %3":"=v"(r):"v"(a),"v"(b),"v"(c));return r;}
__device__ __forceinline__ float max2f(float a,float b){float r;asm("v_max_f32_e32 %0, %1, %2":"=v"(r):"v"(a),"v"(b));return r;}
__device__ __forceinline__ float fadd_s(float a,float b){float r;asm("v_add_f32_e32 %0, %1, %2":"=v"(r):"v"(a),"v"(b));return r;}
__device__ __forceinline__ float fsub_s(float a,float b){float r;asm("v_sub_f32_e32 %0, %1, %2":"=v"(r):"v"(a),"v"(b));return r;}
typedef float f32x2_t __attribute__((ext_vector_type(2))); typedef __bf16 bf16x2_t __attribute__((ext_vector_type(2)));
__device__ __forceinline__ unsigned cvtpk_s(float lo,float hi){f32x2_t v={lo,hi};bf16x2_t b=__builtin_convertvector(v,bf16x2_t);return __builtin_bit_cast(unsigned,b);}
#define WAIT_BAR(N) asm volatile("s_waitcnt vmcnt(" #N ") lgkmcnt(0)\n\ts_barrier":::"memory")

__device__ __forceinline__ void qkt(f32x16&p0,f32x16&p1,const char*Kslot,const bf16x8*qr,const f32x16&negm,int r32,int hi){
  const char*kb=Kslot+hi*1024+r32*16;
  #pragma unroll
  for(int d0=0;d0<4;++d0){
    const bf16x8 b0=*reinterpret_cast<const bf16x8*>(kb+d0*2048);
    const bf16x8 b1=*reinterpret_cast<const bf16x8*>(kb+d0*2048+512);
    if(d0==0){p0=__builtin_amdgcn_mfma_f32_32x32x16_bf16(b0,qr[0],negm,0,0,0);p1=__builtin_amdgcn_mfma_f32_32x32x16_bf16(b1,qr[0],negm,0,0,0);}
    else{p0=__builtin_amdgcn_mfma_f32_32x32x16_bf16(b0,qr[d0],p0,0,0,0);p1=__builtin_amdgcn_mfma_f32_32x32x16_bf16(b1,qr[d0],p1,0,0,0);}}
}
typedef __attribute__((address_space(3))) const char* lds_cptr;
typedef short v4i16_t __attribute__((ext_vector_type(4)));
__device__ __forceinline__ void kload8(bf16x8*kf,lds_cptr kp){
  kf[0]=*(const __attribute__((address_space(3))) bf16x8*)(kp);      kf[1]=*(const __attribute__((address_space(3))) bf16x8*)(kp+512);
  kf[2]=*(const __attribute__((address_space(3))) bf16x8*)(kp+2048); kf[3]=*(const __attribute__((address_space(3))) bf16x8*)(kp+2560);
  kf[4]=*(const __attribute__((address_space(3))) bf16x8*)(kp+4096); kf[5]=*(const __attribute__((address_space(3))) bf16x8*)(kp+4608);
  kf[6]=*(const __attribute__((address_space(3))) bf16x8*)(kp+6144); kf[7]=*(const __attribute__((address_space(3))) bf16x8*)(kp+6656);
}
__device__ __forceinline__ void kload2(bf16x8*kf,lds_cptr kp,int j){ kf[2*j]=*(const __attribute__((address_space(3))) bf16x8*)(kp+j*2048); kf[2*j+1]=*(const __attribute__((address_space(3))) bf16x8*)(kp+j*2048+512); }
__device__ __forceinline__ s16x4 vtr(lds_cptr p){ return __builtin_bit_cast(s16x4,__builtin_amdgcn_ds_read_tr16_b64_v4i16((__attribute__((address_space(3))) v4i16_t*)p)); }
__device__ __forceinline__ float rowmax(const f32x16&p0,const f32x16&p1){
  float a=max3f(p0[0],p0[1],p1[0]),b=max3f(p0[2],p0[3],p1[1]);a=max3f(a,p1[2],p1[3]);
  #pragma unroll
  for(int r=4;r<16;r+=4){a=max3f(a,p0[r],p0[r+1]);b=max3f(b,p0[r+2],p0[r+3]);a=max3f(a,p1[r],p1[r+1]);b=max3f(b,p1[r+2],p1[r+3]);}
  const float m=max2f(a,b);
  auto rr=__builtin_amdgcn_permlane32_swap(__float_as_uint(m),__float_as_uint(m),false,false);
  return max2f(__uint_as_float(rr[0]),__uint_as_float(rr[1]));
}
__device__ __forceinline__ void pv(f32x16*o,int vb,bf16x8 pa0,bf16x8 pa1,bf16x8 pa2,bf16x8 pa3){
  #pragma unroll
  for(int d0=0;d0<2;++d0){s16x4 lo[4],hi[4];
    #pragma unroll
    for(int ks=0;ks<4;++ks){
      asm volatile("ds_read_b64_tr_b16 %0,%1 offset:%c2":"=&v"(lo[ks]):"v"(vb),"i"(d0*4096+ks*1024):"memory");
      asm volatile("ds_read_b64_tr_b16 %0,%1 offset:%c2":"=&v"(hi[ks]):"v"(vb),"i"(d0*4096+ks*1024+512):"memory");}
    asm volatile("s_waitcnt lgkmcnt(0)":::"memory");SBAR();
    #define PK(k) (bf16x8){lo[k][0],lo[k][1],lo[k][2],lo[k][3],hi[k][0],hi[k][1],hi[k][2],hi[k][3]}
    o[d0]=__builtin_amdgcn_mfma_f32_32x32x16_bf16(pa0,PK(0),o[d0],0,0,0);
    o[d0]=__builtin_amdgcn_mfma_f32_32x32x16_bf16(pa1,PK(1),o[d0],0,0,0);
    o[d0]=__builtin_amdgcn_mfma_f32_32x32x16_bf16(pa2,PK(2),o[d0],0,0,0);
    o[d0]=__builtin_amdgcn_mfma_f32_32x32x16_bf16(pa3,PK(3),o[d0],0,0,0);
    #undef PK
  }
}

#ifndef ATTN_STORE16
#define ATTN_STORE16(p,v) (*(u32x4*)(p)=(v))
#endif
template<int THRL> __device__ __forceinline__ void attn_unit(int b,int h,int qb,const bf16*Q,const bf16*__restrict__ K,const bf16*__restrict__ V,bf16*O,const float*__restrict__ cum2,char*shm){
  int tid_l=threadIdx.x; asm volatile("":"+v"(tid_l)); const int tid=tid_l,lane=tid&63,r32=lane&31,hi=lane>>5; const int wid=__builtin_amdgcn_readfirstlane(tid>>6);
  const long rowbase=(long)b*SEQ; const int q0=qb*QB;
  const bf16*Qw=Q+(rowbase+q0+wid*QBLK)*HP+h*D;
  const bf16*Kh=K+rowbase*HP+h*D,*Vh=V+rowbase*HP+h*D;
  const lds_cptr shm3=(lds_cptr)shm; const unsigned lds0=(unsigned)(uintptr_t)shm;
  float*wsf=(float*)(shm+LDS_WS)+wid*64;
  const bf16*ksrc=Kh+(long)lane*HP+wid*8;
  const bf16*vsrc=Vh+(long)(16*(wid&3)+(lane>>2))*HP+(wid>>2)*32+(lane&3)*8;
  const unsigned kdst=lds0+LDS_K+wid*1024, vdst=lds0+LDS_V+wid*1024;
  #define DMA_K(t,slot) glds16(ksrc+(long)(t)*KVBLK*HP,(unsigned)__builtin_amdgcn_readfirstlane(kdst+(slot)))
  #define DMA_V(t,slot) glds16(vsrc+(long)(t)*KVBLK*HP,(unsigned)__builtin_amdgcn_readfirstlane(vdst+(slot)))
  const int vb0=(int)(lds0+LDS_V)+((lane>>4)&1)*32+(lane&3)*8+(4*hi+((lane&15)>>2))*64;
  const char*Kbase=shm+LDS_K; bf16x8 kf[8];
  const lds_cptr kp0=shm3+LDS_K+hi*1024+r32*16; const lds_cptr vp0=shm3+LDS_V+((lane>>4)&1)*32+(lane&3)*8+(4*hi+((lane&15)>>2))*64;
  const int NT=(q0+QB)/KVBLK;
  typedef float f32x4b __attribute__((ext_vector_type(4)));
  { const float* cb=cum2+(long)(b*NHEAD+h)*SEQ; const float cref=cb[q0]; __attribute__((address_space(3))) float* bl=(__attribute__((address_space(3))) float*)(shm3+LDS_BIAS);
    for(int i=tid*4;i<q0+QB;i+=NW*64*4){ const f32x4b c=*(const f32x4b*)(cb+i); *(__attribute__((address_space(3))) f32x4b*)(bl+i)=(f32x4b){cref-c[0],cref-c[1],cref-c[2],cref-c[3]}; }
    asm volatile("s_waitcnt vmcnt(0) lgkmcnt(0)":::"memory"); }
  const __attribute__((address_space(3))) float* biasL=(const __attribute__((address_space(3))) float*)(shm3+LDS_BIAS)+4*hi;
  #define BIASADD(C0,C1,t) do{ const __attribute__((address_space(3))) float* bp_=biasL+64*(t); \
    _Pragma("unroll") for(int j_=0;j_<4;++j_){ const f32x4b b0_=*(const __attribute__((address_space(3))) f32x4b*)(bp_+8*j_); const f32x4b b1_=*(const __attribute__((address_space(3))) f32x4b*)(bp_+32+8*j_); \
      C0[4*j_]+=b0_[0];C0[4*j_+1]+=b0_[1];C0[4*j_+2]+=b0_[2];C0[4*j_+3]+=b0_[3]; C1[4*j_]+=b1_[0];C1[4*j_+1]+=b1_[1];C1[4*j_+2]+=b1_[2];C1[4*j_+3]+=b1_[3]; SBAR(); } }while(0)
  DMA_K(0,0);DMA_V(0,0);DMA_K(1,SLOTB);
  bf16x8 qr[4];
  #pragma unroll
  for(int d0=0;d0<4;++d0)qr[d0]=*reinterpret_cast<const bf16x8*>(&Qw[(long)r32*HP+d0*16+hi*8]);
  const __attribute__((address_space(3))) bf16x8* qst=(const __attribute__((address_space(3))) bf16x8*)(shm3+LDS_OST+wid*4096+lane*16);
  #pragma unroll
  for(int d0=0;d0<4;++d0)*(__attribute__((address_space(3))) bf16x8*)(shm3+LDS_OST+wid*4096+lane*16+d0*1024)=qr[d0];
  #define QLD(d) (qst[(d)*64])
  float mhat=0.f,l_reg=0.f;f32x16 o[2];o[0]=f32x16{};o[1]=f32x16{};f32x16 negm=f32x16{};asm volatile("":"+v"(negm));
  const int qrel=wid*QBLK+r32;
  #define CMASK(P0,P1,t) do{int jb_=(t)-(NT-4); if(jb_>=0)cmask(P0,P1,jb_,qrel,hi);}while(0)
  bool resc=false;
  #define START(P0,P1) do{ const float rm=rowmax(P0,P1); resc=false; \
    { const float dl=rm; mhat=fadd_s(mhat,dl); \
      _Pragma("unroll") for(int r=0;r<16;++r){P0[r]=fsub_s(P0[r],dl);P1[r]=fsub_s(P1[r],dl);} \
      _Pragma("unroll") for(int r=0;r<16;++r)negm[r]=-mhat; asm volatile("":"+v"(negm)); } \
    _Pragma("unroll") for(int r=0;r<16;++r)P0[r]=__builtin_amdgcn_exp2f(P0[r]); }while(0)
  #define RESC() do{ if(resc){ asm volatile("s_waitcnt lgkmcnt(0)":::"memory"); \
      _Pragma("unroll") for(int d_=0;d_<2;++d_) _Pragma("unroll") for(int r=0;r<16;++r)o[d_][r]*=wsf[crow(r,hi)]; } }while(0)
  f32x16 pA0,pA1,pB0,pB1;
  int sl_prev=0,sl_cur=0,sl_next=SLOTB;
  #define ROT() do{sl_prev=sl_cur;sl_cur=sl_next;sl_next=(sl_next==(NSLOT-1)*SLOTB)?0:sl_next+SLOTB;}while(0)
  DMA_K(2,2*SLOTB);
  WAIT_BAR(3);
  qkt(pA0,pA1,Kbase,qr,negm,r32,hi);asm volatile("s_nop 15\n\ts_nop 7":"+v"(pA0),"+v"(pA1));BIASADD(pA0,pA1,0);CMASK(pA0,pA1,0);
  START(pA0,pA1);
  _Pragma("unroll") for(int r=0;r<16;++r)pA1[r]=__builtin_amdgcn_exp2f(pA1[r]);
  WAIT_BAR(0);
  DMA_K(3,0);DMA_V(1,SLOTB);
  ROT();
  kload8(kf,kp0+sl_cur);
  WAIT_BAR(2);
  s16x4 vlo[8],vhi[8]; u32x4 pw0,pw1,pw2,pw3;
  #define PKW(P,B) cvtpk_s(P[B],P[B+1])
  #define PAF(k) __builtin_bit_cast(bf16x8,pw##k)
  #define VFR(i) (bf16x8){vlo[i][0],vlo[i][1],vlo[i][2],vlo[i][3],vhi[i][0],vhi[i][1],vhi[i][2],vhi[i][3]}
  #define PIN(x) asm volatile("":"+v"(x))
  #define MX3(a,b,c) __builtin_fmaxf(__builtin_fmaxf((a),(b)),(c))
  #define GAPA(MF,A0,A1,A2,A3,W0,W1,PW) do{ MF; sacc+=A0; sacc+=A1; sacc+=A2; sacc+=A3; PIN(sacc); W0; W1; PIN(PW); SBAR(); }while(0)
  #define EX(v) __builtin_amdgcn_exp2f(v)
  #define GAPB(MF,X,B) do{ MF; X[B]=EX(X[B]); X[B+1]=EX(X[B+1]); X[B+2]=EX(X[B+2]); X[B+3]=EX(X[B+3]); PIN(X); SBAR(); }while(0)
  #define VRD(i) do{ vlo[i]=vtr(vp_+(((i)>>2)*4096+((i)&3)*1024)); vhi[i]=vtr(vp_+(((i)>>2)*4096+((i)&3)*1024+512)); }while(0)
  #define KRD(G,j) do{ if(G){ kload2(kf,kp0+sl_next,j); SBAR(); } }while(0)
  #define STEP(C0,C1,P0,P1,t,GK,GV,GL) do{ SBAR(); \
    const lds_cptr vp_=vp0+sl_prev; \
    bf16x8 qa_=QLD(0), qb_=QLD(1); VRD(0); SBAR(); float sacc=(P0[0]+P0[1]); \
    GAPA(C0=__builtin_amdgcn_mfma_f32_32x32x16_bf16(kf[0],qa_,negm,0,0,0), P0[2],P0[3],P0[4],P0[5],     pw0[0]=PKW(P0,0), pw0[1]=PKW(P0,2), pw0); \
    VRD(4); SBAR(); GAPA(C1=__builtin_amdgcn_mfma_f32_32x32x16_bf16(kf[1],qa_,negm,0,0,0), P0[6],P0[7],P0[8],P0[9],     pw0[2]=PKW(P0,4), pw0[3]=PKW(P0,6), pw0); \
    qa_=QLD(2); VRD(1); SBAR(); GAPA(C0=__builtin_amdgcn_mfma_f32_32x32x16_bf16(kf[2],qb_,C0,0,0,0),   P0[10],P0[11],P0[12],P0[13], pw1[0]=PKW(P0,8), pw1[1]=PKW(P0,10), pw1); \
    VRD(5); SBAR(); GAPA(C1=__builtin_amdgcn_mfma_f32_32x32x16_bf16(kf[3],qb_,C1,0,0,0),   P0[14],P0[15],P1[0],P1[1],   pw1[2]=PKW(P0,12),pw1[3]=PKW(P0,14), pw1); \
    qb_=QLD(3); VRD(2); SBAR(); GAPA(C0=__builtin_amdgcn_mfma_f32_32x32x16_bf16(kf[4],qa_,C0,0,0,0),   P1[2],P1[3],P1[4],P1[5],     pw2[0]=PKW(P1,0), pw2[1]=PKW(P1,2), pw2); \
    VRD(6); SBAR(); GAPA(C1=__builtin_amdgcn_mfma_f32_32x32x16_bf16(kf[5],qa_,C1,0,0,0),   P1[6],P1[7],P1[8],P1[9],     pw2[2]=PKW(P1,4), pw2[3]=PKW(P1,6), pw2); \
    VRD(3); SBAR(); GAPA(C0=__builtin_amdgcn_mfma_f32_32x32x16_bf16(kf[6],qb_,C0,0,0,0),   P1[10],P1[11],P1[12],P1[13], pw3[0]=PKW(P1,8), pw3[1]=PKW(P1,10), pw3); \
    VRD(7); SBAR(); GAPA(C1=__builtin_amdgcn_mfma_f32_32x32x16_bf16(kf[7],qb_,C1,0,0,0),   P1[14],P1[15],0.f,0.f,       pw3[2]=PKW(P1,12),pw3[3]=PKW(P1,14), pw3); \
    l_reg+=sacc; \
    if(GK){DMA_K((t)+3,sl_cur);} if(GV){DMA_V((t)+1,sl_next);} \
    BIASADD(C0,C1,t); CMASK(C0,C1,t); \
    { float a=MX3(C0[0],C0[1],C1[0]),b=MX3(C0[2],C0[3],C1[1]); a=MX3(a,C1[2],C1[3]); \
      _Pragma("unroll") for(int r=4;r<16;r+=4){a=MX3(a,C0[r],C0[r+1]);b=MX3(b,C0[r+2],C0[r+3]);a=MX3(a,C1[r],C1[r+1]);b=MX3(b,C1[r+2],C1[r+3]);} \
      float rm=__builtin_fmaxf(a,b); { auto rr=__builtin_amdgcn_permlane32_swap(__float_as_uint(rm),__float_as_uint(rm),false,false); rm=__builtin_fmaxf(__uint_as_float(rr[0]),__uint_as_float(rr[1])); } \
      resc=false; \
      if(__builtin_expect(__any(rm>(float)THRL),0)){ const float dl=__builtin_fmaxf(rm,0.f); mhat+=dl; \
        _Pragma("unroll") for(int r=0;r<16;++r){C0[r]-=dl;C1[r]-=dl;} \
        _Pragma("unroll") for(int r=0;r<16;++r)negm[r]=-mhat; asm volatile("":"+v"(negm)); \
        const float f=__builtin_amdgcn_exp2f(-dl); l_reg*=f; if(hi==0)wsf[r32]=f; resc=true; } } \
    SBAR(); \
    GAPB(o[0]=__builtin_amdgcn_mfma_f32_32x32x16_bf16(PAF(0),VFR(0),o[0],0,0,0), C0,0); \
    GAPB(o[1]=__builtin_amdgcn_mfma_f32_32x32x16_bf16(PAF(0),VFR(4),o[1],0,0,0), C0,4); \
    KRD(GL,0); GAPB(o[0]=__builtin_amdgcn_mfma_f32_32x32x16_bf16(PAF(1),VFR(1),o[0],0,0,0), C0,8); \
    KRD(GL,1); GAPB(o[1]=__builtin_amdgcn_mfma_f32_32x32x16_bf16(PAF(1),VFR(5),o[1],0,0,0), C0,12); \
    KRD(GL,2); GAPB(o[0]=__builtin_amdgcn_mfma_f32_32x32x16_bf16(PAF(2),VFR(2),o[0],0,0,0), C1,0); \
    KRD(GL,3); GAPB(o[1]=__builtin_amdgcn_mfma_f32_32x32x16_bf16(PAF(2),VFR(6),o[1],0,0,0), C1,4); \
    GAPB(o[0]=__builtin_amdgcn_mfma_f32_32x32x16_bf16(PAF(3),VFR(3),o[0],0,0,0), C1,8); \
    GAPB(o[1]=__builtin_amdgcn_mfma_f32_32x32x16_bf16(PAF(3),VFR(7),o[1],0,0,0), C1,12); \
    }while(0)
  int t=1;
  #undef CMASK
  #define CMASK(P0,P1,t) do{}while(0)
  for(;t+5<NT;t+=2){
    STEP(pB0,pB1,pA0,pA1,t,true,true,true);     WAIT_BAR(2); RESC(); ROT();
    STEP(pA0,pA1,pB0,pB1,t+1,true,true,true);   WAIT_BAR(2); RESC(); ROT();
  }
  #undef CMASK
  #define CMASK(P0,P1,t) do{int jb_=(t)-(NT-4); if(jb_>=0)cmask(P0,P1,jb_,qrel,hi);}while(0)
  #define ENDW(tt) do{ if((tt)+3<NT){WAIT_BAR(2);} else if((tt)+2<NT){WAIT_BAR(1);} else {WAIT_BAR(0);} }while(0)
  for(;t+1<NT;t+=2){
    STEP(pB0,pB1,pA0,pA1,t,(t+3<NT),(t+1<NT),(t+1<NT));       ENDW(t);   RESC(); ROT();
    STEP(pA0,pA1,pB0,pB1,t+1,(t+4<NT),(t+2<NT),(t+2<NT));     ENDW(t+1); RESC(); ROT();
  }
  STEP(pB0,pB1,pA0,pA1,NT-1,false,false,false); RESC();
  { float sacc=pB0[0]+pB0[1]; _Pragma("unroll") for(int r=2;r<16;++r)sacc+=pB0[r]; _Pragma("unroll") for(int r=0;r<16;++r)sacc+=pB1[r]; l_reg+=sacc;
    pw0=(u32x4){PKW(pB0,0),PKW(pB0,2),PKW(pB0,4),PKW(pB0,6)};pw1=(u32x4){PKW(pB0,8),PKW(pB0,10),PKW(pB0,12),PKW(pB0,14)};pw2=(u32x4){PKW(pB1,0),PKW(pB1,2),PKW(pB1,4),PKW(pB1,6)};pw3=(u32x4){PKW(pB1,8),PKW(pB1,10),PKW(pB1,12),PKW(pB1,14)};
    SBAR(); pv(o,vb0+sl_cur,PAF(0),PAF(1),PAF(2),PAF(3)); }
  #undef PKW
  #undef PAF
  #undef VFR
  #undef PIN
  #undef MX3
  #undef GAPA
  #undef GAPB
  #undef EX
  #undef VRD
  #undef KRD
  #undef STEP
  #undef ENDW
  {auto rr=__builtin_amdgcn_permlane32_swap(__float_as_uint(l_reg),__float_as_uint(l_reg),false,false);l_reg=__uint_as_float(rr[0])+__uint_as_float(rr[1]);}
  if(hi==0)wsf[32+r32]=l_reg;asm volatile("s_waitcnt lgkmcnt(0)":::"memory");
  float rli[16];
  #pragma unroll
  for(int r=0;r<16;++r)rli[r]=__builtin_amdgcn_rcpf(wsf[32+crow(r,hi)]);
  bf16*Ow=O+(rowbase+q0+wid*QBLK)*OP+h*D;
  { bf16*stg=(bf16*)(shm+LDS_OST)+wid*2048;
    #pragma unroll
    for(int r=0;r<16;++r){const int orow=crow(r,hi);
      #pragma unroll
      for(int d0=0;d0<2;++d0)stg[orow*64+d0*32+r32]=__float2bfloat16(o[d0][r]*rli[r]);}
    asm volatile("s_waitcnt lgkmcnt(0)":::"memory");
    #pragma unroll
    for(int i=0;i<4;++i){const int row=i*8+(lane>>3),ch=lane&7; const u32x4 v=*(const u32x4*)(stg+row*64+ch*8); ATTN_STORE16(Ow+(long)row*OP+ch*8,v);} }
  asm volatile("s_waitcnt lgkmcnt(0)\n\ts_barrier":::"memory");
  #undef DMA_K
  #undef DMA_V
  #undef BIASADD
  #undef QLD
  #undef CMASK
  #undef START
  #undef RESC
  #undef ROT
}
constexpr int ATTN_LDS_BYTES=LDS_BYTES;
struct AttnTensors { const bf16* Q; const bf16* K; const bf16* V; bf16* O; const float* cum2; };
struct AttnUnit { int bh; int qb; };
struct StaticOrder {
  int vcu, G;
  __device__ __forceinline__ explicit StaticOrder(int grid,int block):vcu((grid%8==0)?(block%8)*(grid/8)+block/8:block),G(grid){}
  __device__ __forceinline__ bool next(int i,AttnUnit&u)const{
    if(G==256){ if(i>=4)return false; const int s=vcu&7; u.bh=vcu>>3; u.qb=(i==0)?s:(i==1)?15-s:(i==2)?16+s:31-s; return true; }
    const int j=vcu+i*G; if(j>=BATCH*NHEAD*NQB)return false; u.bh=j/NQB; const int q=j%NQB; u.qb=(q&1)?(NQB-1-(q>>1)):(q>>1); return true; }
  __device__ __forceinline__ void a_ready(const AttnUnit&)const{}
  __device__ __forceinline__ void done(const AttnUnit&)const{}
};
template<class Sched,int THRL=8> __device__ __forceinline__ void attn_phase(char*lds,const AttnTensors&T,const Sched&S){
  AttnUnit u;
  for(int i=0;S.next(i,u);++i){ S.a_ready(u); attn_unit<THRL>(u.bh/NHEAD,u.bh%NHEAD,u.qb,T.Q,T.K,T.V,T.O,T.cum2,lds); S.done(u); }
}
#undef SBAR
#undef WAIT_BAR
}
#include <hip/hip_cooperative_groups.h>
namespace cg = cooperative_groups;
#define LAS __attribute__((address_space(3)))
typedef unsigned short bf16;
typedef unsigned v4u __attribute__((ext_vector_type(4)));
typedef float f32x4 __attribute__((ext_vector_type(4)));
typedef short bf16x8 __attribute__((ext_vector_type(8)));
typedef unsigned short u16x8 __attribute__((ext_vector_type(8)));
constexpr int NWAVES = 8;
constexpr int M = 32768, DM = 1024, SEQL = 8192, DFF = 2816, NFF = 5632, NMIX = 3336, HPITCH = 3584, DEPTH = 2;
constexpr size_t MiB = 1u << 20;
constexpr size_t WS_RS = 0, WS_FOXC = 1 * MiB, WS_DEC = 2 * MiB, WS_W = 4 * MiB, W_LAYER = 42 * MiB;
constexpr size_t WO_1IN = 0, WO_1OUT = 11 * MiB, WO_MIX = 16 * MiB + MiB / 2, WO_MO = 23 * MiB + MiB / 2, WO_2IN = 25 * MiB + MiB / 2, WO_2OUT = 36 * MiB + MiB / 2;
constexpr size_t WS_XB = 88 * MiB, WS_HACT = 152 * MiB, WS_Y = 376 * MiB, WS_HST = 440 * MiB, WS_END = 472 * MiB;
constexpr int LDS_BYTES = 147456;
static_assert(attn_body::LDS_BYTES <= 131072, "attention LDS");

__device__ __forceinline__ unsigned f2bf(float f) { unsigned u = __builtin_bit_cast(unsigned, f); return (u + 0x7fffu + ((u >> 16) & 1u)) >> 16; }
__device__ __forceinline__ unsigned pk2(float lo, float hi) { return f2bf(lo) | (f2bf(hi) << 16); }
__device__ __forceinline__ float bf2f(unsigned short b) { return __builtin_bit_cast(float, (unsigned)b << 16); }
__device__ __forceinline__ float wave_sum(float v) {
#pragma unroll
    for (int o = 1; o < 64; o <<= 1) v += __shfl_xor(v, o);
    return v;
}
#define LDS_WAIT() asm volatile("s_waitcnt lgkmcnt(0)" ::: "memory")

__device__ __forceinline__ int dst_row(int mode, int c) {
    if (mode == 1) { const int half = c / DFF, j = c - half * DFF; return 256 * (j >> 7) + 128 * half + (j & 127); }
    if (mode == 2) { const int pn = c >> 8, w = c & 255; return 256 * pn + 128 * ((w & 63) >> 5) + 32 * (w >> 6) + (w & 31); }
    return c;
}
__device__ __forceinline__ void tr_item(const float* W, int K, int N, int nblk, const float* gain, bf16* WT, int mode, LAS float* scr, int item, int lane) {
    const int kb = item / nblk, nb = item % nblk, k0 = 64 * kb, n0 = 32 * nb;
    const int c = n0 + (lane & 31);
#pragma unroll 8
    for (int i = 0; i < 32; ++i) { const int kk = 2 * i + (lane >> 5); float v = 0.f; if (c < N) { v = W[(size_t)(k0 + kk) * N + c]; if (gain) v *= gain[k0 + kk]; } scr[kk * 33 + (lane & 31)] = v; }
    LDS_WAIT(); asm volatile("" ::: "memory");
    const int c8 = lane & 7;
#pragma unroll
    for (int j = 0; j < 4; ++j) { const int n = (lane >> 3) + 8 * j; const LAS float* s = scr + (8 * c8) * 33 + n;
        v4u o; o.x = pk2(s[0 * 33], s[1 * 33]); o.y = pk2(s[2 * 33], s[3 * 33]); o.z = pk2(s[4 * 33], s[5 * 33]); o.w = pk2(s[6 * 33], s[7 * 33]);
        *(v4u*)(WT + (size_t)dst_row(mode, n0 + n) * K + k0 + 8 * c8) = o; }
    LDS_WAIT(); asm volatile("" ::: "memory");
}

struct Args { const float* in[16]; float* out; unsigned char* ws; };
#ifndef EN_G1
#define EN_G1 1
#endif
#ifndef EN_G2
#define EN_G2 1
#endif
#ifndef EN_G3
#define EN_G3 1
#endif
#ifndef EN_MA
#define EN_MA 1
#endif
#ifndef EN_ATT
#define EN_ATT 1
#endif
#ifndef EN_MC
#define EN_MC 1
#endif
#ifndef EN_G5
#define EN_G5 1
#endif

constexpr int HL_LF = 0, HL_SEG = 16384, HL_TOT = 18432, HL_B = 18688, HL_BS = 9216, HL_OL = HL_B + 6 * HL_BS, HP72 = 72;
__device__ __forceinline__ float hgrn_lb(const float* logits, int l, int ch) {
    if (l == 0) return 0.f;
    const float x0 = logits[ch], x1 = logits[256 + ch], mx = fmaxf(x0, x1), e0 = __expf(x0 - mx), e1 = __expf(x1 - mx);
    return fminf(fmaxf(e1 / (e0 + e1), 0.f), 1.f);
}
__device__ __forceinline__ void hgrn_front(LAS unsigned char* lds, const bf16* Hrow  , const float (&lb)[8], float (&kk)[8], int tid) {
    LAS float* LF = (LAS float*)(lds + HL_LF); LAS float* SEG = (LAS float*)(lds + HL_SEG); LAS float* TOT = (LAS float*)(lds + HL_TOT);
    const int s = tid >> 3, cg8 = tid & 7;
    const u16x8 zr = *(const u16x8*)Hrow;
    float lf[8];
#pragma unroll
    for (int i = 0; i < 8; ++i) { const float z = bf2f(zr[i]); const float e = __expf(-fabsf(z)); const float l1 = log1pf(e);
        const float sg = (z >= 0.f ? e : 1.0f) / (1.0f + e);
        lf[i] = fminf(z, 0.f) - l1 + log1pf(lb[i] * __expf(-z)); kk[i] = (1.0f - lb[i]) * sg; }
    *(LAS f32x4*)(LF + s * 64 + cg8 * 8) = (f32x4){lf[0], lf[1], lf[2], lf[3]}; *(LAS f32x4*)(LF + s * 64 + cg8 * 8 + 4) = (f32x4){lf[4], lf[5], lf[6], lf[7]};
    __syncthreads();
    const int d = tid & 63, seg = tid >> 6; float p[8]; float run = 0.f;
#pragma unroll
    for (int j = 0; j < 8; ++j) { run += LF[(8 * seg + j) * 64 + d]; p[j] = run; }
    SEG[seg * 64 + d] = run;
    __syncthreads();
    float off = 0.f, tot = 0.f;
#pragma unroll
    for (int q = 0; q < 8; ++q) { const float v = SEG[q * 64 + d]; tot += v; if (q < seg) off += v; }
#pragma unroll
    for (int j = 0; j < 8; ++j) LF[(8 * seg + j) * 64 + d] = p[j] + off;
    if (seg == 0) TOT[d] = tot;
    __syncthreads();
}
__device__ __forceinline__ f32x4 mfma16(bf16x8 a, bf16x8 b, f32x4 c) { return __builtin_amdgcn_mfma_f32_16x16x32_bf16(a, b, c, 0, 0, 0); }

__device__ __forceinline__ void hgrn_local(LAS unsigned char* lds, const bf16* H, const float* lbl, int l, float* HST, float* DEC, int unit, int tid) {
    const int bh = unit >> 7, c = unit & 127, b = bh >> 2, h = bh & 3, s = tid >> 3, cg8 = tid & 7, lane = tid & 63, w = tid >> 6;
    const bf16* hrow = H + (size_t)(b * SEQL + c * 64 + s) * HPITCH + h * 64 + cg8 * 8;
    float lb[8], kk[8];
#pragma unroll
    for (int i = 0; i < 8; ++i) lb[i] = hgrn_lb(lbl, l, h * 64 + cg8 * 8 + i);
    hgrn_front(lds, hrow + 1024, lb, kk, tid);
    LAS float* LF = (LAS float*)(lds + HL_LF); LAS float* TOT = (LAS float*)(lds + HL_TOT);
    LAS bf16* B0 = (LAS bf16*)(lds + HL_B); LAS bf16* B1 = (LAS bf16*)(lds + HL_B + HL_BS);
    const u16x8 vr = *(const u16x8*)(hrow + 1280);
#pragma unroll
    for (int i = 0; i < 8; ++i) { const int d = cg8 * 8 + i; const float kh = kk[i] * __expf(TOT[d] - LF[s * 64 + d]);
        B0[d * HP72 + s] = (bf16)f2bf(kh); B1[d * HP72 + s] = vr[i]; }
    __syncthreads();
    const int mi = w >> 1, nj0 = 2 * (w & 1), lr = lane & 15, lq = lane >> 4;
    f32x4 acc[2] = {(f32x4){0.f, 0.f, 0.f, 0.f}, (f32x4){0.f, 0.f, 0.f, 0.f}};
#pragma unroll
    for (int ks = 0; ks < 2; ++ks) { const bf16x8 a = *(const LAS bf16x8*)(B0 + (16 * mi + lr) * HP72 + 32 * ks + 8 * lq);
#pragma unroll
        for (int jn = 0; jn < 2; ++jn) { const bf16x8 bb = *(const LAS bf16x8*)(B1 + (16 * (nj0 + jn) + lr) * HP72 + 32 * ks + 8 * lq); acc[jn] = mfma16(a, bb, acc[jn]); } }
    float* U = HST + (size_t)unit * 4096;
#pragma unroll
    for (int jn = 0; jn < 2; ++jn)
#pragma unroll
        for (int r = 0; r < 4; ++r) U[(16 * mi + 4 * lq + r) * 64 + 16 * (nj0 + jn) + lr] = acc[jn][r];
    if (tid < 64) DEC[(size_t)unit * 64 + tid] = __expf(TOT[tid]);
    __syncthreads();
}
__device__ __forceinline__ void hgrn_scan(float* HST, const float* DEC, int unit, int tid) {
    const int bh = unit >> 3, e = (unit & 7) * 512 + tid, d = e >> 6;
    float* p = HST + (size_t)bh * 128 * 4096 + e; const float* dp = DEC + (size_t)bh * 128 * 64 + d;
    float S = 0.f;
    for (int c0 = 0; c0 < 128; c0 += 8) { float u[8], dc[8];
#pragma unroll
        for (int j = 0; j < 8; ++j) { u[j] = p[(size_t)(c0 + j) * 4096]; dc[j] = dp[(c0 + j) * 64]; }
#pragma unroll
        for (int j = 0; j < 8; ++j) { p[(size_t)(c0 + j) * 4096] = S; S = dc[j] * S + u[j]; } }
}
__device__ __forceinline__ void hgrn_out(LAS unsigned char* lds, const bf16* H, const float* lbl, int l, const float* HST, const float* ogain, bf16* Y, int unit, int tid) {
    const int bh = unit >> 7, c = unit & 127, b = bh >> 2, h = bh & 3, s = tid >> 3, cg8 = tid & 7, lane = tid & 63, w = tid >> 6;
    const size_t row = (size_t)(b * SEQL + c * 64 + s);
    const bf16* hrow = H + row * HPITCH + h * 64 + cg8 * 8;
    float lb[8], kk[8];
#pragma unroll
    for (int i = 0; i < 8; ++i) lb[i] = hgrn_lb(lbl, l, h * 64 + cg8 * 8 + i);
    hgrn_front(lds, hrow + 1024, lb, kk, tid);
    LAS float* LF = (LAS float*)(lds + HL_LF);
    LAS bf16* B0 = (LAS bf16*)(lds + HL_B); LAS bf16* B1 = B0 + HL_BS / 2; LAS bf16* B2 = B1 + HL_BS / 2; LAS bf16* B3 = B2 + HL_BS / 2; LAS bf16* B4 = B3 + HL_BS / 2; LAS bf16* B5 = B4 + HL_BS / 2;
    LAS float* OL = (LAS float*)(lds + HL_OL);
    { const u16x8 qr = *(const u16x8*)(hrow + 768); const u16x8 vr = *(const u16x8*)(hrow + 1280);
      float qt[8], kt[8], qh[8];
#pragma unroll
      for (int i = 0; i < 8; ++i) { const int d = cg8 * 8 + i; const float bc = LF[s * 64 + d], rf = LF[31 * 64 + d], q = bf2f(qr[i]);
          qt[i] = q * __expf(fminf(bc - rf, 80.f)); kt[i] = kk[i] * __expf(fminf(rf - bc, 80.f)); qh[i] = q * __expf(bc);
          B3[d * HP72 + s] = vr[i]; }
      *(LAS v4u*)(B0 + s * HP72 + cg8 * 8) = (v4u){pk2(qt[0], qt[1]), pk2(qt[2], qt[3]), pk2(qt[4], qt[5]), pk2(qt[6], qt[7])};
      *(LAS v4u*)(B1 + s * HP72 + cg8 * 8) = (v4u){pk2(kt[0], kt[1]), pk2(kt[2], kt[3]), pk2(kt[4], kt[5]), pk2(kt[6], kt[7])};
      *(LAS v4u*)(B2 + s * HP72 + cg8 * 8) = (v4u){pk2(qh[0], qh[1]), pk2(qh[2], qh[3]), pk2(qh[4], qh[5]), pk2(qh[6], qh[7])};
      const float* Sp = HST + (size_t)unit * 4096 + s * 64 + cg8 * 8;
      const f32x4 s0 = *(const f32x4*)Sp, s1 = *(const f32x4*)(Sp + 4);
#pragma unroll
      for (int i = 0; i < 4; ++i) { B4[(cg8 * 8 + i) * HP72 + s] = (bf16)f2bf(s0[i]); B4[(cg8 * 8 + 4 + i) * HP72 + s] = (bf16)f2bf(s1[i]); } }
    __syncthreads();
    const int mi = w >> 1, nj0 = 2 * (w & 1), lr = lane & 15, lq = lane >> 4;
    { f32x4 acc[2] = {(f32x4){0.f, 0.f, 0.f, 0.f}, (f32x4){0.f, 0.f, 0.f, 0.f}};
#pragma unroll
      for (int ks = 0; ks < 2; ++ks) { const bf16x8 a = *(const LAS bf16x8*)(B0 + (16 * mi + lr) * HP72 + 32 * ks + 8 * lq);
#pragma unroll
          for (int jn = 0; jn < 2; ++jn) { const bf16x8 bb = *(const LAS bf16x8*)(B1 + (16 * (nj0 + jn) + lr) * HP72 + 32 * ks + 8 * lq); acc[jn] = mfma16(a, bb, acc[jn]); } }
#pragma unroll
      for (int jn = 0; jn < 2; ++jn)
#pragma unroll
          for (int r = 0; r < 4; ++r) { const int t = 16 * mi + 4 * lq + r, sp = 16 * (nj0 + jn) + lr; const float v = (sp <= t) ? acc[jn][r] : 0.f; B5[t * HP72 + sp] = (bf16)f2bf(v); } }
    __syncthreads();
    { f32x4 acc[2] = {(f32x4){0.f, 0.f, 0.f, 0.f}, (f32x4){0.f, 0.f, 0.f, 0.f}};
#pragma unroll
      for (int ks = 0; ks < 2; ++ks) { const bf16x8 a = *(const LAS bf16x8*)(B5 + (16 * mi + lr) * HP72 + 32 * ks + 8 * lq);
#pragma unroll
          for (int jn = 0; jn < 2; ++jn) { const bf16x8 bb = *(const LAS bf16x8*)(B3 + (16 * (nj0 + jn) + lr) * HP72 + 32 * ks + 8 * lq); acc[jn] = mfma16(a, bb, acc[jn]); } }
#pragma unroll
      for (int ks = 0; ks < 2; ++ks) { const bf16x8 a = *(const LAS bf16x8*)(B2 + (16 * mi + lr) * HP72 + 32 * ks + 8 * lq);
#pragma unroll
          for (int jn = 0; jn < 2; ++jn) { const bf16x8 bb = *(const LAS bf16x8*)(B4 + (16 * (nj0 + jn) + lr) * HP72 + 32 * ks + 8 * lq); acc[jn] = mfma16(a, bb, acc[jn]); } }
#pragma unroll
      for (int jn = 0; jn < 2; ++jn)
#pragma unroll
          for (int r = 0; r < 4; ++r) OL[(16 * mi + 4 * lq + r) * 68 + 16 * (nj0 + jn) + lr] = acc[jn][r]; }
    __syncthreads();
    { const f32x4 o0 = *(const LAS f32x4*)(OL + s * 68 + cg8 * 8), o1 = *(const LAS f32x4*)(OL + s * 68 + cg8 * 8 + 4);
      float ss = (o0[0] * o0[0] + o0[1] * o0[1]) + (o0[2] * o0[2] + o0[3] * o0[3]) + (o1[0] * o1[0] + o1[1] * o1[1]) + (o1[2] * o1[2] + o1[3] * o1[3]);
      ss += __shfl_xor(ss, 1); ss += __shfl_xor(ss, 2); ss += __shfl_xor(ss, 4);
      const float rinv = rsqrtf(ss * (1.0f / 64.0f) + 1e-6f);
      const u16x8 gr = *(const u16x8*)(hrow + 1536);
      const f32x4 g0 = *(const f32x4*)(ogain + cg8 * 8), g1 = *(const f32x4*)(ogain + cg8 * 8 + 4);
      float o[8];
#pragma unroll
      for (int i = 0; i < 4; ++i) { o[i] = o0[i] * rinv * g0[i] * pg8::silu_f(bf2f(gr[i])); o[4 + i] = o1[i] * rinv * g1[i] * pg8::silu_f(bf2f(gr[4 + i])); }
      *(v4u*)(Y + row * DM + 256 + h * 64 + cg8 * 8) = (v4u){pk2(o[0], o[1]), pk2(o[2], o[3]), pk2(o[4], o[5]), pk2(o[6], o[7])}; }
    __syncthreads();
}
__device__ __forceinline__ void conv_unit(const bf16* H, const float* cw, bf16* Y, int unit, int tid) {
    const int cgp = tid & 31, tl = tid >> 5, ch = cgp * 8;
    float w0[8], w1[8], w2[8];
#pragma unroll
    for (int i = 0; i < 8; ++i) { w0[i] = cw[ch + i]; w1[i] = cw[256 + ch + i]; w2[i] = cw[512 + ch + i]; }
#pragma unroll 1
    for (int p = 0; p < 4; ++p) { const int row = unit * 64 + p * 16 + tl, t = row & (SEQL - 1);
        const bf16* hp = H + (size_t)row * HPITCH + ch;
        const u16x8 x2 = *(const u16x8*)hp, c2 = *(const u16x8*)(hp + 512), bg = *(const u16x8*)(hp + 256);
        u16x8 x1 = (u16x8){0,0,0,0,0,0,0,0}, c1 = x1, x0 = x1, c0 = x1;
        if (t >= 1) { x1 = *(const u16x8*)(hp - HPITCH); c1 = *(const u16x8*)(hp - HPITCH + 512); }
        if (t >= 2) { x0 = *(const u16x8*)(hp - 2 * HPITCH); c0 = *(const u16x8*)(hp - 2 * HPITCH + 512); }
        float o[8];
#pragma unroll
        for (int i = 0; i < 8; ++i) o[i] = bf2f(bg[i]) * (w0[i] * (bf2f(c0[i]) * bf2f(x0[i])) + w1[i] * (bf2f(c1[i]) * bf2f(x1[i])) + w2[i] * (bf2f(c2[i]) * bf2f(x2[i])));
        *(v4u*)(Y + (size_t)row * DM + ch) = (v4u){pk2(o[0], o[1]), pk2(o[2], o[3]), pk2(o[4], o[5]), pk2(o[6], o[7])}; }
}
__device__ __forceinline__ void cumsum_unit(LAS unsigned char* lds, float* C, int unit, int tid) {
    LAS float* WS = (LAS float*)lds; float* p = C + (size_t)unit * SEQL + tid * 16; const int lane = tid & 63, w = tid >> 6;
    float v[16];
#pragma unroll
    for (int j = 0; j < 4; ++j) { const f32x4 x = *(const f32x4*)(p + 4 * j); v[4 * j] = x[0]; v[4 * j + 1] = x[1]; v[4 * j + 2] = x[2]; v[4 * j + 3] = x[3]; }
#pragma unroll
    for (int i = 1; i < 16; ++i) v[i] += v[i - 1];
    const float tot = v[15]; float inc = tot;
#pragma unroll
    for (int o = 1; o < 64; o <<= 1) { const float t = __shfl_up(inc, o); if (lane >= o) inc += t; }
    if (lane == 63) WS[w] = inc;
    __syncthreads();
    float off = inc - tot;
    for (int q = 0; q < w; ++q) off += WS[q];
#pragma unroll
    for (int j = 0; j < 4; ++j) *(f32x4*)(p + 4 * j) = (f32x4){v[4 * j] + off, v[4 * j + 1] + off, v[4 * j + 2] + off, v[4 * j + 3] + off};
    __syncthreads();
}

__global__ void __launch_bounds__(NWAVES * 64, 2) fwd_mega(Args args) {
    extern __shared__ __attribute__((aligned(16))) unsigned char lds_raw[];
    cg::grid_group grid = cg::this_grid();
    LAS unsigned char* lds = (LAS unsigned char*)lds_raw;
    const int tid = threadIdx.x, lane = tid & 63, wave = __builtin_amdgcn_readfirstlane(tid >> 6);
    const int G = gridDim.x, bx = blockIdx.x; const int vcu = (G % 8 == 0) ? (bx % 8) * (G / 8) + bx / 8 : bx;
    unsigned char* ws = args.ws;
    float* RS = (float*)(ws + WS_RS); float* FOXC = (float*)(ws + WS_FOXC); float* DEC = (float*)(ws + WS_DEC);
    bf16* XB = (bf16*)(ws + WS_XB); bf16* HACT = (bf16*)(ws + WS_HACT); bf16* Y = (bf16*)(ws + WS_Y); float* HST = (float*)(ws + WS_HST);
    const float* x_in = args.in[0]; float* out = args.out;

    {
        LAS float* scr = (LAS float*)(lds + wave * 16384);
        const int gw = vcu * NWAVES + wave, NGW = G * NWAVES;
        constexpr int I_FI = 16 * 176, I_FO = 44 * 32, I_MI = 16 * 112, I_MO = 16 * 32, I_L = 2 * I_FI + 2 * I_FO + I_MI + I_MO;
        for (int it = gw; it < DEPTH * I_L; it += NGW) {
            const int l = it / I_L; int r = it - l * I_L; unsigned char* wl = ws + WS_W + (size_t)l * W_LAYER;
            if (r < I_FI) { tr_item(args.in[2] + (size_t)l * DM * NFF, DM, NFF, 176, args.in[1] + l * DM, (bf16*)(wl + WO_1IN), 1, scr, r, lane); continue; } r -= I_FI;
            if (r < I_FO) { tr_item(args.in[3] + (size_t)l * DFF * DM, DFF, DM, 32, nullptr, (bf16*)(wl + WO_1OUT), 0, scr, r, lane); continue; } r -= I_FO;
            if (r < I_MI) { tr_item(args.in[5] + (size_t)l * DM * NMIX, DM, NMIX, 112, args.in[4] + l * DM, (bf16*)(wl + WO_MIX), 2, scr, r, lane); continue; } r -= I_MI;
            if (r < I_MO) { tr_item(args.in[12] + (size_t)l * DM * DM, DM, DM, 32, nullptr, (bf16*)(wl + WO_MO), 0, scr, r, lane); continue; } r -= I_MO;
            if (r < I_FI) { tr_item(args.in[14] + (size_t)l * DM * NFF, DM, NFF, 176, args.in[13] + l * DM, (bf16*)(wl + WO_2IN), 1, scr, r, lane); continue; } r -= I_FI;
            tr_item(args.in[15] + (size_t)l * DFF * DM, DFF, DM, 32, nullptr, (bf16*)(wl + WO_2OUT), 0, scr, r, lane);
        }
        for (int m = gw; m < M; m += NGW) {
            const f32x4* xr = (const f32x4*)(x_in + (size_t)m * DM) + lane; f32x4 v[4]; float s = 0.f;
#pragma unroll
            for (int j = 0; j < 4; ++j) { v[j] = xr[64 * j]; s += (v[j][0] * v[j][0] + v[j][1] * v[j][1]) + (v[j][2] * v[j][2] + v[j][3] * v[j][3]); }
            s = wave_sum(s); if (lane == 0) RS[m] = s;
            unsigned long long* o8 = (unsigned long long*)(XB + (size_t)m * DM) + lane;
#pragma unroll
            for (int j = 0; j < 4; ++j) o8[64 * j] = (unsigned long long)pk2(v[j][0], v[j][1]) | ((unsigned long long)pk2(v[j][2], v[j][3]) << 32);
        }
        for (int i = bx * (NWAVES * 64) + tid; i < 5 * M; i += G * NWAVES * 64) RS[M + i] = 0.f;
    }
    grid.sync();

#pragma unroll 1
    for (int step = 0; step < 3 * DEPTH; ++step) {
        const int l = step / 3, kind = step - 3 * l; unsigned char* wl = ws + WS_W + (size_t)l * W_LAYER;
        int tid = threadIdx.x; asm volatile("" : "+v"(tid));
        float* rs_in = RS + (size_t)step * M; float* rs_out = (step + 1 < 3 * DEPTH) ? RS + (size_t)(step + 1) * M : nullptr;
        const float* xres = (step == 0) ? x_in : out;
        if (kind != 1) {
            const bf16* w_in = (const bf16*)(wl + (kind == 0 ? WO_1IN : WO_2IN)); const bf16* w_out = (const bf16*)(wl + (kind == 0 ? WO_1OUT : WO_2OUT));
            { pg8::Gemm g{XB, w_in, M, NFF, DM}; pg8::StaticOrder S; S.init(M, NFF, G, bx);
              pg8::EpiGlu E{HACT, DFF, rs_in};
              if (EN_G1) pg8::gemm_phase<pg8::EpiGlu, pg8::StaticOrder, true, true>(lds, g, S, E); }
            grid.sync();
            { pg8::Gemm g{HACT, w_out, M, DM, DFF}; pg8::StaticOrder S; S.init(M, DM, G, bx);
              pg8::EpiResid E{xres, out, rs_out ? XB : nullptr, rs_out, 0.5f};
              if (EN_G2) pg8::gemm_phase<pg8::EpiResid, pg8::StaticOrder, true, true>(lds, g, S, E); }
            grid.sync();
        } else {
            { pg8::Gemm g{XB, (const bf16*)(wl + WO_MIX), M, HPITCH, DM}; pg8::StaticOrder S; S.init(M, HPITCH, G, bx);
              pg8::EpiMix E{HACT, rs_in, args.in[9] + l * 64, args.in[10] + l * 64, args.in[11] + l * 8, FOXC};
              if (EN_G3) pg8::gemm_phase<pg8::EpiMix, pg8::StaticOrder, true, true>(lds, g, S, E); }
            grid.sync();
            for (int u = bx; u < 2048 + 512 + 32; u += G) {
                if (u < 2048) { if (EN_MA) hgrn_local(lds, HACT, args.in[7], l, HST, DEC, u, tid); }
                else if (u < 2560) conv_unit(HACT, args.in[6] + l * 768, Y, u - 2048, tid);
                else cumsum_unit(lds, FOXC, u - 2560, tid);
            }
            grid.sync();
            for (int u = bx; u < 128; u += G) hgrn_scan(HST, DEC, u, tid);
            { const attn_body::AttnTensors AT{(const attn_body::bf16*)(HACT + 1792), (const attn_body::bf16*)(HACT + 2304), (const attn_body::bf16*)(HACT + 2816), (attn_body::bf16*)(Y + 512), FOXC};
              const attn_body::StaticOrder S(G, bx);
              if (EN_ATT) attn_body::attn_phase<attn_body::StaticOrder>((char*)lds_raw, AT, S); }
            grid.sync();
            if (EN_MC) for (int u = bx; u < 2048; u += G) hgrn_out(lds, HACT, args.in[7], l, HST, args.in[8] + l * 64, Y, u, tid);
            grid.sync();
            { pg8::Gemm g{Y, (const bf16*)(wl + WO_MO), M, DM, DM}; pg8::StaticOrder S; S.init(M, DM, G, bx);
              pg8::EpiResid E{out, out, XB, rs_out, 1.0f};
              if (EN_G5) pg8::gemm_phase<pg8::EpiResid, pg8::StaticOrder, true, true>(lds, g, S, E); }
            grid.sync();
        }
    }
}

extern "C" void kernel_launch(void* const* d_in, const int* in_sizes, int n_in, void* d_out, int out_size, void* d_ws, size_t ws_size, hipStream_t stream) {
    static int grid = 0;
    if (grid == 0) {
        if (n_in != 16 || out_size != M * DM || ws_size < WS_END) { fprintf(stderr, "kernel_launch: unexpected shapes (n_in %d out %d ws %zu)\n", n_in, out_size, ws_size); grid = -1; return; }
        int dev = 0, cus = 0, per_cu = 0;
        hipGetDevice(&dev); hipDeviceGetAttribute(&cus, hipDeviceAttributeMultiprocessorCount, dev);
        hipFuncSetAttribute((const void*)fwd_mega, hipFuncAttributeMaxDynamicSharedMemorySize, LDS_BYTES);
        if (hipOccupancyMaxActiveBlocksPerMultiprocessor(&per_cu, (const void*)fwd_mega, NWAVES * 64, LDS_BYTES) != hipSuccess || per_cu < 1) { fprintf(stderr, "kernel_launch: occupancy query failed (%d)\n", per_cu); per_cu = 1; }
        (void)hipGetLastError();
        grid = cus * 1;
    }
    if (grid < 0) return;
    Args a{};
    for (int i = 0; i < 16; ++i) a.in[i] = (const float*)d_in[i];
    a.out = (float*)d_out; a.ws = (unsigned char*)d_ws;
    void* kargs[] = {&a};
    hipError_t e = hipLaunchCooperativeKernel((const void*)fwd_mega, dim3(grid), dim3(NWAVES * 64), kargs, LDS_BYTES, stream);
    if (e != hipSuccess) fprintf(stderr, "cooperative launch failed: %s (grid %d)\n", hipGetErrorString(e), grid);
}
```

```cpp
#include <hip/hip_runtime.h>
#include <cstdio>
#include <cstdint>
namespace pg8 {
#define PG8_LAS __attribute__((address_space(3)))
typedef unsigned short bf16_t;
typedef short bf16x8 __attribute__((ext_vector_type(8)));
typedef float f32x4 __attribute__((ext_vector_type(4)));
typedef unsigned u32x4 __attribute__((ext_vector_type(4)));
constexpr int BM = 256, BK = 64, HALF = 128, HTB = HALF * BK * 2  , STAGE_BYTES = 8 * HTB, NXCD = 8, WGM = 8;

__host__ __device__ __forceinline__ int lds_byte(int r, int c) { const int st = (r >> 4) * 2 + (c >> 5), rr = r & 15, cc = c & 31, ob = rr * 64 + cc * 2; return st * 1024 + (ob ^ (((ob >> 9) & 1) << 5)); }
__host__ __device__ __forceinline__ void stage_rc(int b, int& R, int& C) { const int st = b / 1024, sb = b % 1024, swz = sb ^ (((sb >> 9) & 1) << 5); R = (st >> 1) * 16 + swz / 64; C = (st & 1) * 32 + (swz % 64) / 2; }
__host__ __device__ __forceinline__ int perm32(int rho) { const int n = rho >> 4, i = rho & 15; return 8 * (i >> 2) + 4 * n + (i & 3); }

struct Unit { int pm, pn; };
struct Gemm { const bf16_t* A; const bf16_t* Bt; int M, N, K; };

struct StaticOrder {
    int nM, nN, nwg, G, c;
    __host__ __device__ void init(int M, int N, int G_, int c_) { nM = M / BM; nN = N / BM; nwg = nM * nN; G = G_; c = c_; }
    __host__ __device__ bool next(int i, Unit& u) const {
        const long L = (long)i * G + c; if (L >= nwg) return false;
        int wgid = (int)L; { const int q = nwg / NXCD, r = nwg % NXCD, xcd = wgid % NXCD, off = wgid / NXCD; wgid = (xcd < r ? xcd * (q + 1) : r * (q + 1) + (xcd - r) * q) + off; }
        const int nig = WGM * nN, gid = wgid / nig, fm = gid * WGM, gsz = (nM - fm) < WGM ? (nM - fm) : WGM;
        u.pm = fm + ((wgid % nig) % gsz); u.pn = (wgid % nig) / gsz; return true;
    }
    __device__ __forceinline__ void a_ready(const Unit&) const {}
    __device__ __forceinline__ void done(const Unit&) const {}
};

__device__ __forceinline__ unsigned cvt_pk_bf16(float lo, float hi) { unsigned r; asm volatile("v_cvt_pk_bf16_f32 %0, %1, %2" : "=v"(r) : "v"(lo), "v"(hi)); return r; }
typedef float f32x2 __attribute__((ext_vector_type(2)));
constexpr float RMS_EPS = 1e-6f;
__device__ __forceinline__ float silu_f(float g) { return g * __builtin_amdgcn_rcpf(1.0f + __builtin_amdgcn_exp2f(-1.4426950408889634f * g)); }
struct EpiGlu {
    static constexpr bool PERM = true, AFTER_DRAIN = false;
    bf16_t* O; int ldc; const unsigned long long* rss;
    __device__ __forceinline__ void operator()(const f32x4 (&acc)[2][2][4][2], const Unit& u, int wr, int wc, int fr, int fq) const {
        const int row0 = u.pm * BM + wr * 64 + fr, col0 = u.pn * HALF + wc * 32 + 8 * fq;
        unsigned long long rv[2][4];
#pragma unroll
        for (int ai = 0; ai < 2; ++ai)
#pragma unroll
            for (int m = 0; m < 4; ++m) rv[ai][m] = rss[row0 + ai * HALF + m * 16];
#pragma unroll
        for (int ai = 0; ai < 2; ++ai)
#pragma unroll
            for (int m = 0; m < 4; ++m) { const int row = row0 + ai * HALF + m * 16; const float inv = rsqrtf((float)rv[ai][m] * (1.0f / (1024.0f * 16777216.0f)) + RMS_EPS);
                const f32x4 g0 = acc[ai][0][m][0] * inv, g1 = acc[ai][0][m][1] * inv, u0 = acc[ai][1][m][0] * inv, u1 = acc[ai][1][m][1] * inv;
                u32x4 w; w.x = cvt_pk_bf16(silu_f(g0[0]) * u0[0], silu_f(g0[1]) * u0[1]); w.y = cvt_pk_bf16(silu_f(g0[2]) * u0[2], silu_f(g0[3]) * u0[3]);
                w.z = cvt_pk_bf16(silu_f(g1[0]) * u1[0], silu_f(g1[1]) * u1[1]); w.w = cvt_pk_bf16(silu_f(g1[2]) * u1[2], silu_f(g1[3]) * u1[3]);
                *(u32x4*)(O + (size_t)row * ldc + col0) = w; }
    }
};
typedef unsigned u32x2 __attribute__((ext_vector_type(2)));
struct EpiResid {
    static constexpr bool PERM = true, AFTER_DRAIN = false;
    bf16_t* xb; float* outf; unsigned long long* rss_next; float alpha;
    __device__ __forceinline__ void operator()(const f32x4 (&acc)[2][2][4][2], const Unit& u, int wr, int wc, int fr, int fq) const {
        const int row0 = u.pm * BM + wr * 64 + fr, col0 = u.pn * BM + wc * 32 + 8 * fq;
        u32x4 xall[2][4][2];
#pragma unroll
        for (int ai = 0; ai < 2; ++ai)
#pragma unroll
            for (int m = 0; m < 4; ++m)
#pragma unroll
                for (int bj = 0; bj < 2; ++bj) xall[ai][m][bj] = *(const u32x4*)(xb + (size_t)(row0 + ai * HALF + m * 16) * 1024 + col0 + bj * HALF);
#pragma unroll
        for (int ai = 0; ai < 2; ++ai)
#pragma unroll
            for (int m = 0; m < 4; ++m) { const int row = row0 + ai * HALF + m * 16; const size_t off = (size_t)row * 1024 + col0; float ss = 0.f;
                const u32x4 (&xin)[2] = xall[ai][m];
#pragma unroll
                for (int bj = 0; bj < 2; ++bj) {
                    const f32x4 x0 = (f32x4){__builtin_bit_cast(float, xin[bj].x << 16), __builtin_bit_cast(float, xin[bj].x & 0xffff0000u), __builtin_bit_cast(float, xin[bj].y << 16), __builtin_bit_cast(float, xin[bj].y & 0xffff0000u)};
                    const f32x4 x1 = (f32x4){__builtin_bit_cast(float, xin[bj].z << 16), __builtin_bit_cast(float, xin[bj].z & 0xffff0000u), __builtin_bit_cast(float, xin[bj].w << 16), __builtin_bit_cast(float, xin[bj].w & 0xffff0000u)};
                    const f32x4 o0 = x0 + acc[ai][bj][m][0] * alpha, o1 = x1 + acc[ai][bj][m][1] * alpha;
                    ss += (o0[0] * o0[0] + o0[1] * o0[1]) + (o0[2] * o0[2] + o0[3] * o0[3]) + (o1[0] * o1[0] + o1[1] * o1[1]) + (o1[2] * o1[2] + o1[3] * o1[3]);
                    if (outf) { __builtin_nontemporal_store(o0, (f32x4*)(outf + off + bj * HALF)); __builtin_nontemporal_store(o1, (f32x4*)(outf + off + bj * HALF + 4)); }
                    else { u32x4 w; w.x = cvt_pk_bf16(o0[0], o0[1]); w.y = cvt_pk_bf16(o0[2], o0[3]); w.z = cvt_pk_bf16(o1[0], o1[1]); w.w = cvt_pk_bf16(o1[2], o1[3]); *(u32x4*)(xb + off + bj * HALF) = w; } }
                if (rss_next) { ss += __shfl_xor(ss, 16); ss += __shfl_xor(ss, 32); if (fq == 0) atomicAdd(rss_next + row, (unsigned long long)(ss * 16777216.0f)); } }
    }
};
struct EpiMix {
    static constexpr bool PERM = true, AFTER_DRAIN = false;
    bf16_t* H; const unsigned long long* rss; const float* qgain; const float* kgain; const float* fbias; float* foxlf;
    __device__ __forceinline__ void operator()(const f32x4 (&acc)[2][2][4][2], const Unit& u, int wr, int wc, int fr, int fq) const {
        const int row0 = u.pm * BM + wr * 64 + fr, col0 = u.pn * BM + wc * 64 + 8 * fq;
        const int mode = (u.pn == 7 || u.pn == 8) ? 1 : (u.pn == 9 || u.pn == 10) ? 2 : (u.pn == 13) ? 3 : 0;
        f32x4 gv[2][2];
#pragma unroll
        for (int bj = 0; bj < 2; ++bj)
#pragma unroll
            for (int n = 0; n < 2; ++n) gv[bj][n] = (f32x4){1.f, 1.f, 1.f, 1.f};
        if (mode == 1 || mode == 2) { const float* gp = (mode == 1 ? qgain : kgain) + 8 * fq; const float sc = (mode == 1) ? 0.125f * 1.4426950408889634f : 1.0f;
#pragma unroll
            for (int bj = 0; bj < 2; ++bj)
#pragma unroll
                for (int n = 0; n < 2; ++n) gv[bj][n] = *(const f32x4*)(gp + 32 * bj + 4 * n) * sc; }
        unsigned long long rv[2][4];
#pragma unroll
        for (int ai = 0; ai < 2; ++ai)
#pragma unroll
            for (int m = 0; m < 4; ++m) rv[ai][m] = rss[row0 + ai * HALF + m * 16];
#pragma unroll
        for (int ai = 0; ai < 2; ++ai)
#pragma unroll
            for (int m = 0; m < 4; ++m) { const int row = row0 + ai * HALF + m * 16; float inv = rsqrtf((float)rv[ai][m] * (1.0f / (1024.0f * 16777216.0f)) + RMS_EPS);
                f32x4 v[2][2];
#pragma unroll
                for (int bj = 0; bj < 2; ++bj)
#pragma unroll
                    for (int n = 0; n < 2; ++n) v[bj][n] = acc[ai][bj][m][n] * inv;
                if (mode == 1 || mode == 2) { float ss = 0.f;
#pragma unroll
                    for (int bj = 0; bj < 2; ++bj)
#pragma unroll
                        for (int n = 0; n < 2; ++n) ss += (v[bj][n][0] * v[bj][n][0] + v[bj][n][1] * v[bj][n][1]) + (v[bj][n][2] * v[bj][n][2] + v[bj][n][3] * v[bj][n][3]);
                    ss += __shfl_xor(ss, 16); ss += __shfl_xor(ss, 32);
                    const float hinv = rsqrtf(ss * (1.0f / 64.0f) + RMS_EPS);
#pragma unroll
                    for (int bj = 0; bj < 2; ++bj)
#pragma unroll
                        for (int n = 0; n < 2; ++n) v[bj][n] = v[bj][n] * hinv * gv[bj][n]; }
                if (mode == 3 && wc == 0 && fq == 0) { const int b = row >> 13, t = row & 8191;
#pragma unroll
                    for (int n = 0; n < 2; ++n)
#pragma unroll
                        for (int i = 0; i < 4; ++i) { const int h = 4 * n + i; const float a = v[0][n][i] + fbias[h];
                            const float a2 = a * 1.4426950408889634f;
                            foxlf[(size_t)(b * 8 + h) * 8192 + t] = fminf(a2, 0.f) - __builtin_amdgcn_logf(1.0f + __builtin_amdgcn_exp2f(-fabsf(a2))); } }
                if (mode == 3) continue;
#pragma unroll
                for (int bj = 0; bj < 2; ++bj) { u32x4 w; w.x = cvt_pk_bf16(v[bj][0][0], v[bj][0][1]); w.y = cvt_pk_bf16(v[bj][0][2], v[bj][0][3]); w.z = cvt_pk_bf16(v[bj][1][0], v[bj][1][1]); w.w = cvt_pk_bf16(v[bj][1][2], v[bj][1][3]);
                    *(u32x4*)(H + (size_t)row * 3584 + col0 + 32 * bj) = w; } }
    }
};
template <class Epi, class Sched, bool ALIGN_EPI = false, bool SP2 = false>
__device__ __forceinline__ void gemm_phase(PG8_LAS unsigned char* lds, const Gemm g, const Sched& S, const Epi& E) {
    int tid_l = threadIdx.x; asm volatile("" : "+v"(tid_l));
    const int tid = tid_l, wid = __builtin_amdgcn_readfirstlane(tid >> 6), lane = tid & 63, wr = wid >> 2, wc = wid & 3, fr = lane & 15, fq = lane >> 4;
    const int K = g.K, nt = K / BK;
    unsigned voffA[2], voffB[2];
#pragma unroll
    for (int i = 0; i < 2; ++i) { int R, C; stage_rc(tid * 16 + i * 8192, R, C); const int Rb = Epi::PERM ? ((R & ~31) + perm32(R & 31)) : R;
        voffA[i] = (unsigned)(R * K + C) * 2u; voffB[i] = (unsigned)(Rb * K + C) * 2u; }
    const size_t kstep = (size_t)(BK * 2);
    const size_t hstep = (size_t)HALF * K * 2;
    const size_t tstep = 2 * hstep;
    const unsigned ldsw = (unsigned)wid * 1024u;
    const int aoff = lds_byte(wr * 64 + fr, fq * 8), boff = lds_byte(wc * 32 + fr, fq * 8);
#define PG8_SA(b, h) (((b) * 2 + (h)) * HTB)
#define PG8_SB(b, h) ((4 + (b) * 2 + (h)) * HTB)
#define PG8_STAGE(bufoff, gbase, voff) do { _Pragma("unroll") for (int _i = 0; _i < 2; ++_i) \
        __builtin_amdgcn_global_load_lds((const unsigned*)((const char*)(gbase) + (voff)[_i]), (PG8_LAS unsigned*)(lds + (bufoff) + ldsw + _i * 8192), 16, 0, 0); } while (0)
#define PG8_LDA(dst, b, h) do { _Pragma("unroll") for (int m = 0; m < 4; ++m) _Pragma("unroll") for (int k = 0; k < 2; ++k) dst[m][k] = *(const PG8_LAS bf16x8*)(lds + PG8_SA(b, h) + aoff + m * 2048 + k * 1024); } while (0)
#define PG8_LDB(dst, b, h) do { _Pragma("unroll") for (int n = 0; n < 2; ++n) _Pragma("unroll") for (int k = 0; k < 2; ++k) dst[n][k] = *(const PG8_LAS bf16x8*)(lds + PG8_SB(b, h) + boff + n * 2048 + k * 1024); } while (0)
#define PG8_MMA(ai, bj, At, Bt) do { __builtin_amdgcn_s_setprio(1); _Pragma("unroll") for (int m = 0; m < 4; ++m) _Pragma("unroll") for (int n = 0; n < 2; ++n) _Pragma("unroll") for (int k = 0; k < 2; ++k) \
        acc[ai][bj][m][n] = __builtin_amdgcn_mfma_f32_16x16x32_bf16(Bt[n][k], At[m][k], acc[ai][bj][m][n], 0, 0, 0); __builtin_amdgcn_s_setprio(0); } while (0)
#define PG8_WAIT_V(n) asm volatile("s_waitcnt vmcnt(" #n ")" ::: "memory")
#define PG8_WAIT_L(n) asm volatile("s_waitcnt lgkmcnt(" #n ")" ::: "memory")
#define PG8_BAR __builtin_amdgcn_s_barrier()
#define PG8_SCHED __builtin_amdgcn_sched_barrier(0)
    Unit cur, nxt; int ui = 0;
    if (!S.next(0, cur)) return;
    f32x4 acc[2][2][4][2];
#pragma unroll
    for (int a = 0; a < 2; ++a)
#pragma unroll
        for (int b = 0; b < 2; ++b)
#pragma unroll
            for (int m = 0; m < 4; ++m)
#pragma unroll
                for (int n = 0; n < 2; ++n) acc[a][b][m][n] = (f32x4){0.f, 0.f, 0.f, 0.f};
    bf16x8 At[4][2], B0[2][2], B1[2][2];
    const char* cA = (const char*)g.A + (size_t)cur.pm * tstep; const char* cB = (const char*)g.Bt + (size_t)cur.pn * tstep;
    S.a_ready(cur);
    if constexpr (SP2) {
        PG8_STAGE(PG8_SB(0, 0), cB, voffB); PG8_STAGE(PG8_SB(0, 1), cB + hstep, voffB); PG8_STAGE(PG8_SA(0, 0), cA, voffA); PG8_STAGE(PG8_SA(0, 1), cA + hstep, voffA);
        if (wr == 1) PG8_BAR;
        PG8_WAIT_V(2); PG8_BAR;
        PG8_STAGE(PG8_SB(1, 0), cB + kstep, voffB); PG8_STAGE(PG8_SA(1, 0), cA + kstep, voffA); PG8_STAGE(PG8_SB(1, 1), cB + hstep + kstep, voffB);
        PG8_WAIT_V(6); PG8_BAR;
    } else {
        PG8_STAGE(PG8_SB(0, 0), cB, voffB); PG8_STAGE(PG8_SA(0, 0), cA, voffA); PG8_STAGE(PG8_SB(0, 1), cB + hstep, voffB); PG8_STAGE(PG8_SA(0, 1), cA + hstep, voffA);
        if (wr == 1) PG8_BAR;
        PG8_WAIT_V(4); PG8_BAR;
        PG8_STAGE(PG8_SB(1, 0), cB + kstep, voffB); PG8_STAGE(PG8_SA(1, 0), cA + kstep, voffA); PG8_STAGE(PG8_SB(1, 1), cB + hstep + kstep, voffB);
        PG8_WAIT_V(6); PG8_BAR;
    }
    for (;;) {
        const bool has_next = S.next(ui + 1, nxt);
        const char* nA = has_next ? (const char*)g.A + (size_t)nxt.pm * tstep : cA; const char* nB = has_next ? (const char*)g.Bt + (size_t)nxt.pn * tstep : cB;
        for (int t = 0; t < nt; t += 2) {
            const bool last = (t == nt - 2);
            const char* a1 = cA + (size_t)(t + 1) * kstep;
            const char* a2 = last ? nA : cA + (size_t)(t + 2) * kstep; const char* b2 = last ? nB : cB + (size_t)(t + 2) * kstep;
            const char* a3 = a2 + kstep; const char* b3 = b2 + kstep;
            if (last && has_next) S.a_ready(nxt);
            if constexpr (SP2) {
            PG8_LDB(B0, 0, 0); PG8_LDB(B1, 0, 1); PG8_SCHED; PG8_LDA(At, 0, 0); PG8_STAGE(PG8_SA(1, 1), a1 + hstep, voffA);
            PG8_WAIT_V(8); PG8_WAIT_L(0); PG8_BAR; PG8_MMA(0, 0, At, B0); PG8_MMA(0, 1, At, B1); PG8_BAR; PG8_SCHED;
            PG8_LDA(At, 0, 1); PG8_STAGE(PG8_SB(0, 0), b2, voffB); PG8_STAGE(PG8_SB(0, 1), b2 + hstep, voffB); PG8_STAGE(PG8_SA(0, 0), a2, voffA);
            PG8_WAIT_V(8); PG8_WAIT_L(0); PG8_BAR; PG8_MMA(1, 0, At, B0); PG8_MMA(1, 1, At, B1); PG8_BAR; PG8_SCHED;
            PG8_LDB(B0, 1, 0); PG8_LDB(B1, 1, 1); PG8_SCHED; PG8_LDA(At, 1, 0); PG8_STAGE(PG8_SA(0, 1), a2 + hstep, voffA);
            PG8_WAIT_V(8); PG8_WAIT_L(0); PG8_BAR; PG8_MMA(0, 0, At, B0); PG8_MMA(0, 1, At, B1); PG8_BAR; PG8_SCHED;
            PG8_LDA(At, 1, 1); PG8_STAGE(PG8_SB(1, 0), b3, voffB); PG8_STAGE(PG8_SB(1, 1), b3 + hstep, voffB); PG8_STAGE(PG8_SA(1, 0), a3, voffA);
            PG8_WAIT_V(8); PG8_WAIT_L(0); PG8_BAR; PG8_MMA(1, 0, At, B0); PG8_MMA(1, 1, At, B1); PG8_BAR; PG8_SCHED;
            } else {
            PG8_LDB(B0, 0, 0); PG8_SCHED; PG8_LDA(At, 0, 0); PG8_STAGE(PG8_SA(1, 1), a1 + hstep, voffA);
            PG8_WAIT_L(8); PG8_BAR; PG8_WAIT_L(0); PG8_MMA(0, 0, At, B0); PG8_BAR; PG8_SCHED;
            PG8_LDB(B1, 0, 1); PG8_STAGE(PG8_SB(0, 0), b2, voffB);
            PG8_BAR; PG8_WAIT_L(0); PG8_MMA(0, 1, At, B1); PG8_BAR;
            PG8_LDA(At, 0, 1); PG8_STAGE(PG8_SA(0, 0), a2, voffA);
            PG8_BAR; PG8_WAIT_L(0); PG8_MMA(1, 0, At, B0); PG8_BAR; PG8_SCHED;
            PG8_STAGE(PG8_SB(0, 1), b2 + hstep, voffB);
            PG8_WAIT_V(6); PG8_BAR; PG8_MMA(1, 1, At, B1); PG8_BAR;
            PG8_LDB(B0, 1, 0); PG8_SCHED; PG8_LDA(At, 1, 0); PG8_STAGE(PG8_SA(0, 1), a2 + hstep, voffA);
            PG8_WAIT_L(8); PG8_BAR; PG8_WAIT_L(0); PG8_MMA(0, 0, At, B0); PG8_BAR; PG8_SCHED;
            PG8_LDB(B1, 1, 1); PG8_STAGE(PG8_SB(1, 0), b3, voffB);
            PG8_BAR; PG8_WAIT_L(0); PG8_MMA(0, 1, At, B1); PG8_BAR;
            PG8_LDA(At, 1, 1); PG8_STAGE(PG8_SA(1, 0), a3, voffA);
            PG8_BAR; PG8_WAIT_L(0); PG8_MMA(1, 0, At, B0); PG8_BAR; PG8_SCHED;
            PG8_STAGE(PG8_SB(1, 1), b3 + hstep, voffB);
            PG8_WAIT_V(6); PG8_BAR; PG8_MMA(1, 1, At, B1); PG8_BAR;
            }
        }
        if constexpr (ALIGN_EPI) { if (wr == 0) PG8_BAR; }
        if constexpr (!Epi::AFTER_DRAIN) { E(acc, cur, wr, wc, fr, fq); S.done(cur); }
        if (!has_next) break;
#pragma unroll
        for (int a = 0; a < 2; ++a)
#pragma unroll
            for (int b = 0; b < 2; ++b)
#pragma unroll
                for (int m = 0; m < 4; ++m)
#pragma unroll
                    for (int n = 0; n < 2; ++n) acc[a][b][m][n] = (f32x4){0.f, 0.f, 0.f, 0.f};
        cur = nxt; cA = nA; cB = nB; ++ui;
        if constexpr (ALIGN_EPI) { if (wr == 1) PG8_BAR; }
    }
    PG8_WAIT_V(0);
    if constexpr (!ALIGN_EPI) { if (wr == 0) PG8_BAR; }
    PG8_BAR;
    if constexpr (Epi::AFTER_DRAIN) { E.fused(acc, cur, wr, wc, fr, fq, lds, wid, lane); S.done(cur); }
#undef PG8_SA
#undef PG8_SB
#undef PG8_STAGE
#undef PG8_LDA
#undef PG8_LDB
#undef PG8_MMA
#undef PG8_WAIT_V
#undef PG8_WAIT_L
#undef PG8_BAR
#undef PG8_SCHED
}
}
#include <hip/hip_bf16.h>
#include <cmath>
namespace attn_body {
using bf16=__hip_bfloat16;
using bf16x8=__attribute__((ext_vector_type(8)))short;
using s16x4=__attribute__((ext_vector_type(4)))short;
using f32x16=__attribute__((ext_vector_type(16)))float;
using u32x4=__attribute__((ext_vector_type(4)))unsigned;
constexpr int BATCH=4,NHEAD=8,SEQ=8192,D=64,HP=3584,OP=1024;
constexpr int NW=8,QBLK=32,QB=QBLK*NW,KVBLK=64,NQB=SEQ/QB;
constexpr int ATTN_UNIT_ROWS=QB;
__device__ __forceinline__ int crow(int r,int hi){return (r&3)+8*(r>>2)+4*hi;}
#define SBAR() __builtin_amdgcn_sched_barrier(0)
__device__ __forceinline__ void cmask(f32x16&p0,f32x16&p1,int jb,int qrel,int hi){
  const float NEG=-INFINITY; int kb=64*jb+4*hi;
  #pragma unroll
  for(int r=0;r<16;++r){int kv=kb+(r&3)+8*(r>>2); if(kv>qrel)p0[r]=NEG; if(kv+32>qrel)p1[r]=NEG;}
}

constexpr int NSLOT=3, SLOTB=8192;
constexpr int LDS_K=0, LDS_V=NSLOT*SLOTB, LDS_WS=2*NSLOT*SLOTB, LDS_OST=LDS_WS+NW*64*4, LDS_BIAS=LDS_OST+NW*4096, LDS_BYTES=LDS_BIAS+SEQ*4;
constexpr float C2=0.125f*1.4426950408889634f;
__device__ __forceinline__ void glds16(const void*gsrc,unsigned lds_dst){unsigned keep;
  asm volatile("s_mov_b32 %0, m0\n\ts_mov_b32 m0, %2\n\ts_nop 0\n\tglobal_load_lds_dwordx4 %1, off\n\ts_mov_b32 m0, %0":"=&s"(keep):"v"(gsrc),"s"(lds_dst):"memory");}
__device__ __forceinline__ float max3f(float a,float b,float c){float r;asm("v_max3_f32 %0, %1, %2, %3":"=v"(r):"v"(a),"v"(b),"v"(c));return r;}
__device__ __forceinline__ float max2f(float a,float b){float r;asm("v_max_f32_e32 %0, %1, %2":"=v"(r):"v"(a),"v"(b));return r;}
__device__ __forceinline__ float fadd_s(float a,float b){float r;asm("v_add_f32_e32 %0, %1, %2":"=v"(r):"v"(a),"v"(b));return r;}
__device__ __forceinline__ float fsub_s(float a,float b){float r;asm("v_sub_f32_e32 %0, %1, %2":"=v"(r):"v"(a),"v"(b));return r;}
typedef float f32x2_t __attribute__((ext_vector_type(2))); typedef __bf16 bf16x2_t __attribute__((ext_vector_type(2)));
__device__ __forceinline__ unsigned cvtpk_s(float lo,float hi){f32x2_t v={lo,hi};bf16x2_t b=__builtin_convertvector(v,bf16x2_t);return __builtin_bit_cast(unsigned,b);}
#define WAIT_BAR(N) asm volatile("s_waitcnt vmcnt(" #N ") lgkmcnt(0)\n\ts_barrier":::"memory")

__device__ __forceinline__ void qkt(f32x16&p0,f32x16&p1,const char*Kslot,const bf16x8*qr,const f32x16&negm,int r32,int hi){
  const char*kb=Kslot+hi*1024+r32*16;
  #pragma unroll
  for(int d0=0;d0<4;++d0){
    const bf16x8 b0=*reinterpret_cast<const bf16x8*>(kb+d0*2048);
    const bf16x8 b1=*reinterpret_cast<const bf16x8*>(kb+d0*2048+512);
    if(d0==0){p0=__builtin_amdgcn_mfma_f32_32x32x16_bf16(b0,qr[0],negm,0,0,0);p1=__builtin_amdgcn_mfma_f32_32x32x16_bf16(b1,qr[0],negm,0,0,0);}
    else{p0=__builtin_amdgcn_mfma_f32_32x32x16_bf16(b0,qr[d0],p0,0,0,0);p1=__builtin_amdgcn_mfma_f32_32x32x16_bf16(b1,qr[d0],p1,0,0,0);}}
}
typedef __attribute__((address_space(3))) const char* lds_cptr;
typedef short v4i16_t __attribute__((ext_vector_type(4)));
__device__ __forceinline__ void kload8(bf16x8*kf,lds_cptr kp){
  kf[0]=*(const __attribute__((address_space(3))) bf16x8*)(kp);      kf[1]=*(const __attribute__((address_space(3))) bf16x8*)(kp+512);
  kf[2]=*(const __attribute__((address_space(3))) bf16x8*)(kp+2048); kf[3]=*(const __attribute__((address_space(3))) bf16x8*)(kp+2560);
  kf[4]=*(const __attribute__((address_space(3))) bf16x8*)(kp+4096); kf[5]=*(const __attribute__((address_space(3))) bf16x8*)(kp+4608);
  kf[6]=*(const __attribute__((address_space(3))) bf16x8*)(kp+6144); kf[7]=*(const __attribute__((address_space(3))) bf16x8*)(kp+6656);
}
__device__ __forceinline__ void kload2(bf16x8*kf,lds_cptr kp,int j){ kf[2*j]=*(const __attribute__((address_space(3))) bf16x8*)(kp+j*2048); kf[2*j+1]=*(const __attribute__((address_space(3))) bf16x8*)(kp+j*2048+512); }
__device__ __forceinline__ s16x4 vtr(lds_cptr p){ return __builtin_bit_cast(s16x4,__builtin_amdgcn_ds_read_tr16_b64_v4i16((__attribute__((address_space(3))) v4i16_t*)p)); }
__device__ __forceinline__ float rowmax(const f32x16&p0,const f32x16&p1){
  float a=max3f(p0[0],p0[1],p1[0]),b=max3f(p0[2],p0[3],p1[1]);a=max3f(a,p1[2],p1[3]);
  #pragma unroll
  for(int r=4;r<16;r+=4){a=max3f(a,p0[r],p0[r+1]);b=max3f(b,p0[r+2],p0[r+3]);a=max3f(a,p1[r],p1[r+1]);b=max3f(b,p1[r+2],p1[r+3]);}
  const float m=max2f(a,b);
  auto rr=__builtin_amdgcn_permlane32_swap(__float_as_uint(m),__float_as_uint(m),false,false);
  return max2f(__uint_as_float(rr[0]),__uint_as_float(rr[1]));
}
__device__ __forceinline__ void pv(f32x16*o,int vb,bf16x8 pa0,bf16x8 pa1,bf16x8 pa2,bf16x8 pa3){
  #pragma unroll
  for(int d0=0;d0<2;++d0){s16x4 lo[4],hi[4];
    #pragma unroll
    for(int ks=0;ks<4;++ks){
      asm volatile("ds_read_b64_tr_b16 %0,%1 offset:%c2":"=&v"(lo[ks]):"v"(vb),"i"(d0*4096+ks*1024):"memory");
      asm volatile("ds_read_b64_tr_b16 %0,%1 offset:%c2":"=&v"(hi[ks]):"v"(vb),"i"(d0*4096+ks*1024+512):"memory");}
    asm volatile("s_waitcnt lgkmcnt(0)":::"memory");SBAR();
    #define PK(k) (bf16x8){lo[k][0],lo[k][1],lo[k][2],lo[k][3],hi[k][0],hi[k][1],hi[k][2],hi[k][3]}
    o[d0]=__builtin_amdgcn_mfma_f32_32x32x16_bf16(pa0,PK(0),o[d0],0,0,0);
    o[d0]=__builtin_amdgcn_mfma_f32_32x32x16_bf16(pa1,PK(1),o[d0],0,0,0);
    o[d0]=__builtin_amdgcn_mfma_f32_32x32x16_bf16(pa2,PK(2),o[d0],0,0,0);
    o[d0]=__builtin_amdgcn_mfma_f32_32x32x16_bf16(pa3,PK(3),o[d0],0,0,0);
    #undef PK
  }
}

#ifndef ATTN_STORE16
#define ATTN_STORE16(p,v) (*(u32x4*)(p)=(v))
#endif
constexpr float ATT_SKIP_LOG2=44.0f;
template<int THRL> __device__ __forceinline__ void attn_unit(int b,int h,int qb,const bf16*Q,const bf16*__restrict__ K,const bf16*__restrict__ V,bf16*O,const float*__restrict__ cum2,const float*__restrict__ qg,const float*__restrict__ kg,char*shm){
  int tid_l=threadIdx.x; asm volatile("":"+v"(tid_l)); const int tid=tid_l,lane=tid&63,r32=lane&31,hi=lane>>5; const int wid=__builtin_amdgcn_readfirstlane(tid>>6);
  const long rowbase=(long)b*SEQ; const int q0=qb*QB;
  const bf16*Qw=Q+(rowbase+q0+wid*QBLK)*HP+h*D;
  typedef float f32x4b __attribute__((ext_vector_type(4)));
  const float* cb=cum2+(long)(b*NHEAD+h)*SEQ; const float cref=cb[q0];
  f32x4b cpre[4];
  #pragma unroll
  for(int k_=0;k_<4;++k_){ const int i=tid*4+k_*NW*64*4; cpre[k_]=(i<q0+QB)?*(const f32x4b*)(cb+i):(f32x4b){0.f,0.f,0.f,0.f}; }
  bf16x8 qr[4];
  #pragma unroll
  for(int d0=0;d0<4;++d0)qr[d0]=*reinterpret_cast<const bf16x8*>(&Qw[(long)r32*HP+d0*16+hi*8]);
  int T0;
  { float gq=fabsf(qg[lane]),gk=fabsf(kg[lane]);
    #pragma unroll
    for(int o=1;o<64;o<<=1){gq=fmaxf(gq,__shfl_xor(gq,o));gk=fmaxf(gk,__shfl_xor(gk,o));}
    const float thresh=2.0f*(8.0f*1.4426950408889634f*1.02f*gq*gk)+ATT_SKIP_LOG2;
    const int ntf=(q0+QB)/KVBLK; const int j0=lane,j1=lane+64;
    const bool s0=(j0<ntf-4)&&(cref-cb[64*j0+63]<-thresh); const bool s1=(j1<ntf-4)&&(cref-cb[64*j1+63]<-thresh);
    const int nskip=__popcll(__ballot(s0))+__popcll(__ballot(s1));
    T0=__builtin_amdgcn_readfirstlane(nskip&~1); }
  const bf16*Kh=K+(rowbase+(long)T0*KVBLK)*HP+h*D,*Vh=V+(rowbase+(long)T0*KVBLK)*HP+h*D;
  const lds_cptr shm3=(lds_cptr)shm; const unsigned lds0=(unsigned)(uintptr_t)shm;
  float*wsf=(float*)(shm+LDS_WS)+wid*64;
  const bf16*ksrc=Kh+(long)lane*HP+wid*8;
  const bf16*vsrc=Vh+(long)(16*(wid&3)+(lane>>2))*HP+(wid>>2)*32+(lane&3)*8;
  const unsigned kdst=lds0+LDS_K+wid*1024, vdst=lds0+LDS_V+wid*1024;
  #define DMA_K(t,slot) glds16(ksrc+(long)(t)*KVBLK*HP,(unsigned)__builtin_amdgcn_readfirstlane(kdst+(slot)))
  #define DMA_V(t,slot) glds16(vsrc+(long)(t)*KVBLK*HP,(unsigned)__builtin_amdgcn_readfirstlane(vdst+(slot)))
  const int vb0=(int)(lds0+LDS_V)+((lane>>4)&1)*32+(lane&3)*8+(4*hi+((lane&15)>>2))*64;
  const char*Kbase=shm+LDS_K; bf16x8 kf[8];
  const lds_cptr kp0=shm3+LDS_K+hi*1024+r32*16; const lds_cptr vp0=shm3+LDS_V+((lane>>4)&1)*32+(lane&3)*8+(4*hi+((lane&15)>>2))*64;
  const int NT=(q0+QB)/KVBLK-T0;
  { __attribute__((address_space(3))) float* bl=(__attribute__((address_space(3))) float*)(shm3+LDS_BIAS);
    #pragma unroll
    for(int k_=0;k_<4;++k_){ const int i=tid*4+k_*NW*64*4; if(i<q0+QB){ const f32x4b c=cpre[k_]; *(__attribute__((address_space(3))) f32x4b*)(bl+i)=(f32x4b){cref-c[0],cref-c[1],cref-c[2],cref-c[3]}; } }
    asm volatile("s_waitcnt vmcnt(0) lgkmcnt(0)":::"memory"); }
  const __attribute__((address_space(3))) float* biasL=(const __attribute__((address_space(3))) float*)(shm3+LDS_BIAS)+T0*KVBLK+4*hi;
  #define BIASADD(C0,C1,t) do{ const __attribute__((address_space(3))) float* bp_=biasL+64*(t); \
    _Pragma("unroll") for(int j_=0;j_<4;++j_){ const f32x4b b0_=*(const __attribute__((address_space(3))) f32x4b*)(bp_+8*j_); const f32x4b b1_=*(const __attribute__((address_space(3))) f32x4b*)(bp_+32+8*j_); \
      C0[4*j_]+=b0_[0];C0[4*j_+1]+=b0_[1];C0[4*j_+2]+=b0_[2];C0[4*j_+3]+=b0_[3]; C1[4*j_]+=b1_[0];C1[4*j_+1]+=b1_[1];C1[4*j_+2]+=b1_[2];C1[4*j_+3]+=b1_[3]; SBAR(); } }while(0)
  DMA_K(0,0);DMA_V(0,0);DMA_K(1,SLOTB);
  const __attribute__((address_space(3))) bf16x8* qst=(const __attribute__((address_space(3))) bf16x8*)(shm3+LDS_OST+wid*4096+lane*16);
  #pragma unroll
  for(int d0=0;d0<4;++d0)*(__attribute__((address_space(3))) bf16x8*)(shm3+LDS_OST+wid*4096+lane*16+d0*1024)=qr[d0];
  #define QLD(d) (qst[(d)*64])
  float mhat=0.f,l_reg=0.f;f32x16 o[2];o[0]=f32x16{};o[1]=f32x16{};f32x16 negm=f32x16{};asm volatile("":"+v"(negm));
  const int qrel=wid*QBLK+r32;
  #define CMASK(P0,P1,t) do{int jb_=(t)-(NT-4); if(jb_>=0)cmask(P0,P1,jb_,qrel,hi);}while(0)
  bool resc=false;
  #define START(P0,P1) do{ const float rm=*(const __attribute__((address_space(3))) float*)(shm3+LDS_BIAS+4*(q0+qrel)); resc=false; \
    { const float dl=rm; mhat=fadd_s(mhat,dl); \
      _Pragma("unroll") for(int r=0;r<16;++r){P0[r]=fsub_s(P0[r],dl);P1[r]=fsub_s(P1[r],dl);} \
      _Pragma("unroll") for(int r=0;r<16;++r)negm[r]=-mhat; asm volatile("":"+v"(negm)); } \
    _Pragma("unroll") for(int r=0;r<16;++r)P0[r]=__builtin_amdgcn_exp2f(P0[r]); }while(0)
  #define RESC() do{ if(resc){ asm volatile("s_waitcnt lgkmcnt(0)":::"memory"); \
      _Pragma("unroll") for(int d_=0;d_<2;++d_) _Pragma("unroll") for(int r=0;r<16;++r)o[d_][r]*=wsf[crow(r,hi)]; } }while(0)
  f32x16 pA0,pA1,pB0,pB1;
  int sl_prev=0,sl_cur=0,sl_next=SLOTB;
  #define ROT() do{sl_prev=sl_cur;sl_cur=sl_next;sl_next=(sl_next==(NSLOT-1)*SLOTB)?0:sl_next+SLOTB;}while(0)
  DMA_K(2,2*SLOTB);
  WAIT_BAR(3);
  qkt(pA0,pA1,Kbase,qr,negm,r32,hi);asm volatile("s_nop 15\n\ts_nop 7":"+v"(pA0),"+v"(pA1));BIASADD(pA0,pA1,0);CMASK(pA0,pA1,0);
  START(pA0,pA1);
  _Pragma("unroll") for(int r=0;r<16;++r)pA1[r]=__builtin_amdgcn_exp2f(pA1[r]);
  WAIT_BAR(0);
  DMA_K(3,0);DMA_V(1,SLOTB);
  ROT();
  kload8(kf,kp0+sl_cur);
  WAIT_BAR(2);
  s16x4 vlo[8],vhi[8]; u32x4 pw0,pw1,pw2,pw3;
  #define PKW(P,B) cvtpk_s(P[B],P[B+1])
  #define PAF(k) __builtin_bit_cast(bf16x8,pw##k)
  #define VFR(i) (bf16x8){vlo[i][0],vlo[i][1],vlo[i][2],vlo[i][3],vhi[i][0],vhi[i][1],vhi[i][2],vhi[i][3]}
  #define PIN(x) asm volatile("":"+v"(x))
  #define MX3(a,b,c) __builtin_fmaxf(__builtin_fmaxf((a),(b)),(c))
  #define GAPA(MF,A0,A1,A2,A3,W0,W1,PW) do{ MF; sacc+=A0; sacc+=A1; sacc+=A2; sacc+=A3; PIN(sacc); W0; W1; PIN(PW); SBAR(); }while(0)
  #define EX(v) __builtin_amdgcn_exp2f(v)
  #define GAPB(MF,X,B) do{ MF; X[B]=EX(X[B]); X[B+1]=EX(X[B+1]); X[B+2]=EX(X[B+2]); X[B+3]=EX(X[B+3]); PIN(X); SBAR(); }while(0)
  #define VRD(i) do{ vlo[i]=vtr(vp_+(((i)>>2)*4096+((i)&3)*1024)); vhi[i]=vtr(vp_+(((i)>>2)*4096+((i)&3)*1024+512)); }while(0)
  #define KRD(G,j) do{ if(G){ kload2(kf,kp0+sl_next,j); SBAR(); } }while(0)
  #define STEP(C0,C1,P0,P1,t,GK,GV,GL) do{ SBAR(); \
    const lds_cptr vp_=vp0+sl_prev; \
    bf16x8 qa_=QLD(0), qb_=QLD(1); VRD(0); SBAR(); float sacc=(P0[0]+P0[1]); \
    GAPA(C0=__builtin_amdgcn_mfma_f32_32x32x16_bf16(kf[0],qa_,negm,0,0,0), P0[2],P0[3],P0[4],P0[5],     pw0[0]=PKW(P0,0), pw0[1]=PKW(P0,2), pw0); \
    VRD(4); SBAR(); GAPA(C1=__builtin_amdgcn_mfma_f32_32x32x16_bf16(kf[1],qa_,negm,0,0,0), P0[6],P0[7],P0[8],P0[9],     pw0[2]=PKW(P0,4), pw0[3]=PKW(P0,6), pw0); \
    qa_=QLD(2); VRD(1); SBAR(); GAPA(C0=__builtin_amdgcn_mfma_f32_32x32x16_bf16(kf[2],qb_,C0,0,0,0),   P0[10],P0[11],P0[12],P0[13], pw1[0]=PKW(P0,8), pw1[1]=PKW(P0,10), pw1); \
    VRD(5); SBAR(); GAPA(C1=__builtin_amdgcn_mfma_f32_32x32x16_bf16(kf[3],qb_,C1,0,0,0),   P0[14],P0[15],P1[0],P1[1],   pw1[2]=PKW(P0,12),pw1[3]=PKW(P0,14), pw1); \
    qb_=QLD(3); VRD(2); SBAR(); GAPA(C0=__builtin_amdgcn_mfma_f32_32x32x16_bf16(kf[4],qa_,C0,0,0,0),   P1[2],P1[3],P1[4],P1[5],     pw2[0]=PKW(P1,0), pw2[1]=PKW(P1,2), pw2); \
    VRD(6); SBAR(); GAPA(C1=__builtin_amdgcn_mfma_f32_32x32x16_bf16(kf[5],qa_,C1,0,0,0),   P1[6],P1[7],P1[8],P1[9],     pw2[2]=PKW(P1,4), pw2[3]=PKW(P1,6), pw2); \
    VRD(3); SBAR(); GAPA(C0=__builtin_amdgcn_mfma_f32_32x32x16_bf16(kf[6],qb_,C0,0,0,0),   P1[10],P1[11],P1[12],P1[13], pw3[0]=PKW(P1,8), pw3[1]=PKW(P1,10), pw3); \
    VRD(7); SBAR(); GAPA(C1=__builtin_amdgcn_mfma_f32_32x32x16_bf16(kf[7],qb_,C1,0,0,0),   P1[14],P1[15],0.f,0.f,       pw3[2]=PKW(P1,12),pw3[3]=PKW(P1,14), pw3); \
    l_reg+=sacc; \
    if(GK){DMA_K((t)+3,sl_cur);} if(GV){DMA_V((t)+1,sl_next);} \
    BIASADD(C0,C1,t); CMASK(C0,C1,t); \
    { float a=MX3(C0[0],C0[1],C1[0]),b=MX3(C0[2],C0[3],C1[1]); a=MX3(a,C1[2],C1[3]); \
      _Pragma("unroll") for(int r=4;r<16;r+=4){a=MX3(a,C0[r],C0[r+1]);b=MX3(b,C0[r+2],C0[r+3]);a=MX3(a,C1[r],C1[r+1]);b=MX3(b,C1[r+2],C1[r+3]);} \
      float rm=__builtin_fmaxf(a,b); { auto rr=__builtin_amdgcn_permlane32_swap(__float_as_uint(rm),__float_as_uint(rm),false,false); rm=__builtin_fmaxf(__uint_as_float(rr[0]),__uint_as_float(rr[1])); } \
      resc=false; \
      if(__builtin_expect(__any(rm>(float)THRL),0)){ const float dl=__builtin_fmaxf(rm,0.f); mhat+=dl; \
        _Pragma("unroll") for(int r=0;r<16;++r){C0[r]-=dl;C1[r]-=dl;} \
        _Pragma("unroll") for(int r=0;r<16;++r)negm[r]=-mhat; asm volatile("":"+v"(negm)); \
        const float f=__builtin_amdgcn_exp2f(-dl); l_reg*=f; if(hi==0)wsf[r32]=f; resc=true; } } \
    SBAR(); \
    GAPB(o[0]=__builtin_amdgcn_mfma_f32_32x32x16_bf16(PAF(0),VFR(0),o[0],0,0,0), C0,0); \
    GAPB(o[1]=__builtin_amdgcn_mfma_f32_32x32x16_bf16(PAF(0),VFR(4),o[1],0,0,0), C0,4); \
    KRD(GL,0); GAPB(o[0]=__builtin_amdgcn_mfma_f32_32x32x16_bf16(PAF(1),VFR(1),o[0],0,0,0), C0,8); \
    KRD(GL,1); GAPB(o[1]=__builtin_amdgcn_mfma_f32_32x32x16_bf16(PAF(1),VFR(5),o[1],0,0,0), C0,12); \
    KRD(GL,2); GAPB(o[0]=__builtin_amdgcn_mfma_f32_32x32x16_bf16(PAF(2),VFR(2),o[0],0,0,0), C1,0); \
    KRD(GL,3); GAPB(o[1]=__builtin_amdgcn_mfma_f32_32x32x16_bf16(PAF(2),VFR(6),o[1],0,0,0), C1,4); \
    GAPB(o[0]=__builtin_amdgcn_mfma_f32_32x32x16_bf16(PAF(3),VFR(3),o[0],0,0,0), C1,8); \
    GAPB(o[1]=__builtin_amdgcn_mfma_f32_32x32x16_bf16(PAF(3),VFR(7),o[1],0,0,0), C1,12); \
    }while(0)
  int t=1;
  #undef CMASK
  #define CMASK(P0,P1,t) do{}while(0)
  for(;t+5<NT;t+=2){
    STEP(pB0,pB1,pA0,pA1,t,true,true,true);     WAIT_BAR(2); RESC(); ROT();
    STEP(pA0,pA1,pB0,pB1,t+1,true,true,true);   WAIT_BAR(2); RESC(); ROT();
  }
  #undef CMASK
  #define CMASK(P0,P1,t) do{int jb_=(t)-(NT-4); if(jb_>=0)cmask(P0,P1,jb_,qrel,hi);}while(0)
  #define ENDW(tt) do{ if((tt)+3<NT){WAIT_BAR(2);} else if((tt)+2<NT){WAIT_BAR(1);} else {WAIT_BAR(0);} }while(0)
  for(;t+1<NT;t+=2){
    STEP(pB0,pB1,pA0,pA1,t,(t+3<NT),(t+1<NT),(t+1<NT));       ENDW(t);   RESC(); ROT();
    STEP(pA0,pA1,pB0,pB1,t+1,(t+4<NT),(t+2<NT),(t+2<NT));     ENDW(t+1); RESC(); ROT();
  }
  STEP(pB0,pB1,pA0,pA1,NT-1,false,false,false); RESC();
  { float sacc=pB0[0]+pB0[1]; _Pragma("unroll") for(int r=2;r<16;++r)sacc+=pB0[r]; _Pragma("unroll") for(int r=0;r<16;++r)sacc+=pB1[r]; l_reg+=sacc;
    pw0=(u32x4){PKW(pB0,0),PKW(pB0,2),PKW(pB0,4),PKW(pB0,6)};pw1=(u32x4){PKW(pB0,8),PKW(pB0,10),PKW(pB0,12),PKW(pB0,14)};pw2=(u32x4){PKW(pB1,0),PKW(pB1,2),PKW(pB1,4),PKW(pB1,6)};pw3=(u32x4){PKW(pB1,8),PKW(pB1,10),PKW(pB1,12),PKW(pB1,14)};
    SBAR(); pv(o,vb0+sl_cur,PAF(0),PAF(1),PAF(2),PAF(3)); }
  #undef PKW
  #undef PAF
  #undef VFR
  #undef PIN
  #undef MX3
  #undef GAPA
  #undef GAPB
  #undef EX
  #undef VRD
  #undef KRD
  #undef STEP
  #undef ENDW
  {auto rr=__builtin_amdgcn_permlane32_swap(__float_as_uint(l_reg),__float_as_uint(l_reg),false,false);l_reg=__uint_as_float(rr[0])+__uint_as_float(rr[1]);}
  if(hi==0)wsf[32+r32]=l_reg;asm volatile("s_waitcnt lgkmcnt(0)":::"memory");
  float rli[16];
  #pragma unroll
  for(int r=0;r<16;++r)rli[r]=__builtin_amdgcn_rcpf(wsf[32+crow(r,hi)]);
  bf16*Ow=O+(rowbase+q0+wid*QBLK)*OP+h*D;
  { bf16*stg=(bf16*)(shm+LDS_OST)+wid*2048;
    #pragma unroll
    for(int r=0;r<16;++r){const int orow=crow(r,hi);
      #pragma unroll
      for(int d0=0;d0<2;++d0)stg[orow*64+d0*32+r32]=__float2bfloat16(o[d0][r]*rli[r]);}
    asm volatile("s_waitcnt lgkmcnt(0)":::"memory");
    #pragma unroll
    for(int i=0;i<4;++i){const int row=i*8+(lane>>3),ch=lane&7; const u32x4 v=*(const u32x4*)(stg+row*64+ch*8); ATTN_STORE16(Ow+(long)row*OP+ch*8,v);} }
  asm volatile("s_waitcnt lgkmcnt(0)\n\ts_barrier":::"memory");
  #undef DMA_K
  #undef DMA_V
  #undef BIASADD
  #undef QLD
  #undef CMASK
  #undef START
  #undef RESC
  #undef ROT
}
constexpr int ATTN_LDS_BYTES=LDS_BYTES;
struct AttnTensors { const bf16* Q; const bf16* K; const bf16* V; bf16* O; const float* cum2; const float* qg; const float* kg; };
struct AttnUnit { int bh; int qb; };
struct StaticOrder {
  int vcu, G;
  __device__ __forceinline__ explicit StaticOrder(int grid,int block):vcu((grid%8==0)?(block%8)*(grid/8)+block/8:block),G(grid){}
  __device__ __forceinline__ bool next(int i,AttnUnit&u)const{
    if(G==256){ if(i>=4)return false; const int s=vcu&7; u.bh=vcu>>3; u.qb=(i==0)?s:(i==1)?15-s:(i==2)?16+s:31-s; return true; }
    const int j=vcu+i*G; if(j>=BATCH*NHEAD*NQB)return false; u.bh=j/NQB; const int q=j%NQB; u.qb=(q&1)?(NQB-1-(q>>1)):(q>>1); return true; }
  __device__ __forceinline__ void a_ready(const AttnUnit&)const{}
  __device__ __forceinline__ void done(const AttnUnit&)const{}
};
template<class Sched,int THRL=8> __device__ __forceinline__ void attn_phase(char*lds,const AttnTensors&T,const Sched&S){
  AttnUnit u;
  for(int i=0;S.next(i,u);++i){ S.a_ready(u); attn_unit<THRL>(u.bh/NHEAD,u.bh%NHEAD,u.qb,T.Q,T.K,T.V,T.O,T.cum2,T.qg,T.kg,lds); S.done(u); }
}
#undef SBAR
#undef WAIT_BAR
}
#include <hip/hip_cooperative_groups.h>
namespace cg = cooperative_groups;
#define LAS __attribute__((address_space(3)))
typedef unsigned short bf16;
typedef unsigned v4u __attribute__((ext_vector_type(4)));
typedef float f32x4 __attribute__((ext_vector_type(4)));
typedef short bf16x8 __attribute__((ext_vector_type(8)));
typedef unsigned short u16x8 __attribute__((ext_vector_type(8)));
constexpr int NWAVES = 8;
constexpr int M = 32768, DM = 1024, SEQL = 8192, DFF = 2816, NFF = 5632, NMIX = 3336, HPITCH = 3584, DEPTH = 2;
constexpr size_t MiB = 1u << 20;
constexpr size_t WS_QCTR = 3 * MiB, WS_BAR = 3 * MiB + 65536, WS_CTL_ZERO = 131072, WS_FOXC = 1 * MiB, WS_DEC = 2 * MiB, WS_W = 4 * MiB, W_LAYER = 42 * MiB;
constexpr size_t WO_1IN = 0, WO_1OUT = 11 * MiB, WO_MIX = 16 * MiB + MiB / 2, WO_MO = 23 * MiB + MiB / 2, WO_2IN = 25 * MiB + MiB / 2, WO_2OUT = 36 * MiB + MiB / 2;
constexpr size_t WS_XB = 88 * MiB, WS_HACT = 152 * MiB, WS_Y = 376 * MiB, WS_HST = 440 * MiB, WS_RS = 472 * MiB, WS_END = 474 * MiB;
constexpr int LDS_BYTES = 147456;
static_assert(attn_body::LDS_BYTES <= 131072, "attention LDS");

__device__ __forceinline__ unsigned f2bf(float f) { unsigned u = __builtin_bit_cast(unsigned, f); return (u + 0x7fffu + ((u >> 16) & 1u)) >> 16; }
__device__ __forceinline__ unsigned pk2(float lo, float hi) { return f2bf(lo) | (f2bf(hi) << 16); }
__device__ __forceinline__ float bf2f(unsigned short b) { return __builtin_bit_cast(float, (unsigned)b << 16); }
__device__ __forceinline__ float wave_sum(float v) {
#pragma unroll
    for (int o = 1; o < 64; o <<= 1) v += __shfl_xor(v, o);
    return v;
}
#define LDS_WAIT() asm volatile("s_waitcnt lgkmcnt(0)" ::: "memory")

__device__ __forceinline__ int dst_row(int mode, int c) {
    if (mode == 1) { const int half = c / DFF, j = c - half * DFF; return 256 * (j >> 7) + 128 * half + (j & 127); }
    if (mode == 2) { const int pn = c >> 8, w = c & 255; return 256 * pn + 128 * ((w & 63) >> 5) + 32 * (w >> 6) + (w & 31); }
    return c;
}
__device__ __forceinline__ void tr_item(const float* W, int K, int N, int nblk, const float* gain, bf16* WT, int mode, LAS float* scr, int item, int lane) {
    const int kb = item / nblk, nb = item % nblk, k0 = 64 * kb, n0 = 32 * nb;
    const int c = n0 + (lane & 31);
    float wv[32];
#pragma unroll
    for (int i = 0; i < 32; ++i) { const int kk = 2 * i + (lane >> 5); wv[i] = (c < N) ? __builtin_nontemporal_load(W + (size_t)(k0 + kk) * N + c) : 0.f;     }
    if (gain) {
#pragma unroll
        for (int i = 0; i < 32; ++i) wv[i] *= gain[k0 + 2 * i + (lane >> 5)]; }
#pragma unroll
    for (int i = 0; i < 32; ++i) scr[(2 * i + (lane >> 5)) * 33 + (lane & 31)] = wv[i];
    LDS_WAIT(); asm volatile("" ::: "memory");
    const int c8 = lane & 7;
#pragma unroll
    for (int j = 0; j < 4; ++j) { const int n = (lane >> 3) + 8 * j; const LAS float* s = scr + (8 * c8) * 33 + n;
        v4u o; o.x = pk2(s[0 * 33], s[1 * 33]); o.y = pk2(s[2 * 33], s[3 * 33]); o.z = pk2(s[4 * 33], s[5 * 33]); o.w = pk2(s[6 * 33], s[7 * 33]);
        *(v4u*)(WT + (size_t)dst_row(mode, n0 + n) * K + k0 + 8 * c8) = o; }
    LDS_WAIT(); asm volatile("" ::: "memory");
}

#define XB_TMO      128
#define XB_XCNT(j)  (256  + 64 * (j))
#define XB_XSUB(j)  (1280 + 64 * (j))
#define XB_XGEN(j)  (2304 + 64 * (j))
#define XB_TOP      3328
#define XB_TOPGEN   3392
#define XCD_BAR_WORDS 3456
#define XB_SPIN_CAP (1u << 18)

__device__ __forceinline__ unsigned xb_ld(unsigned* p)              { return __hip_atomic_load(p, __ATOMIC_RELAXED, __HIP_MEMORY_SCOPE_AGENT); }
__device__ __forceinline__ unsigned xb_add(unsigned* p, unsigned v) { return __hip_atomic_fetch_add(p, v, __ATOMIC_RELAXED, __HIP_MEMORY_SCOPE_AGENT); }
__device__ __forceinline__ unsigned xb_xcc_id() { return (unsigned)__builtin_amdgcn_s_getreg((3 << 11) | 20) & 0xFu; }
#define XB_SPIN(cond, bar) do { unsigned _sp = 0; while (cond) { __builtin_amdgcn_s_sleep(1); \
    if ((++_sp & 255u) == 0u) { if (xb_ld(&(bar)[XB_TMO])) break; if (_sp > XB_SPIN_CAP) { atomicAdd(&(bar)[XB_TMO], 1u); break; } } } } while (0)

struct XcdBarrier {
    unsigned* bar; unsigned x;
    volatile LAS unsigned* st;
};

__device__ __forceinline__ XcdBarrier xcd_barrier_post(unsigned* bar, volatile LAS unsigned* st) {
    XcdBarrier b; b.bar = bar; b.x = xb_xcc_id(); b.st = st;
    if (threadIdx.x == 0) (void)xb_add(&bar[XB_XCNT(b.x)], 1u);
    return b;
}
__device__ __forceinline__ void xcd_barrier_complete(unsigned* bar, unsigned x, unsigned& nloc, unsigned& nx) {
    const unsigned G = gridDim.x * gridDim.y * gridDim.z;
    unsigned sum, cnt, mine, sp = 0u;
    for (;;) {
        sum = 0u; cnt = 0u; mine = 0u;
#pragma unroll
        for (unsigned j = 0; j < 16; ++j) { const unsigned c = xb_ld(&bar[XB_XCNT(j)]); sum += c; cnt += (c > 0u) ? 1u : 0u; mine = (j == x) ? c : mine; }
        if (sum == G) break;
        __builtin_amdgcn_s_sleep(1);
        if ((++sp & 255u) == 0u) { if (xb_ld(&bar[XB_TMO])) break; if (sp > XB_SPIN_CAP) { atomicAdd(&bar[XB_TMO], 1u); break; } }
    }
    nloc = mine > 0u ? mine : 1u; nx = cnt > 0u ? cnt : 1u;
}

__device__ __forceinline__ void xcd_barrier(const XcdBarrier& b) {
    asm volatile("s_waitcnt vmcnt(0)" ::: "memory");
    __syncthreads();
    if (threadIdx.x == 0) {
        unsigned* bar = b.bar;
        __builtin_amdgcn_s_waitcnt(0);
        unsigned nloc = b.st[0], nx = b.st[1];
        if (nloc == 0u) { xcd_barrier_complete(bar, b.x, nloc, nx); b.st[0] = nloc; b.st[1] = nx; }
        const unsigned old = xb_add(&bar[XB_XSUB(b.x)], 1u);
        const unsigned gen = old / nloc;
        if (old + 1u == (gen + 1u) * nloc) {
            __builtin_amdgcn_fence(__ATOMIC_RELEASE, "agent");
            asm volatile("s_waitcnt vmcnt(0)" ::: "memory");
            const unsigned og = xb_add(&bar[XB_TOP], 1u);
            const unsigned tg = og / nx;
            if (og + 1u == (tg + 1u) * nx) xb_add(&bar[XB_TOPGEN], 1u);
            else XB_SPIN(xb_ld(&bar[XB_TOPGEN]) == tg, bar);
            __builtin_amdgcn_fence(__ATOMIC_ACQUIRE, "agent");
            xb_add(&bar[XB_XGEN(b.x)], 1u);
            asm volatile("s_waitcnt vmcnt(0)" ::: "memory");
        } else {
            XB_SPIN(xb_ld(&bar[XB_XGEN(b.x)]) == gen, bar);
            __builtin_amdgcn_fence(__ATOMIC_ACQUIRE, "agent");
            asm volatile("s_waitcnt vmcnt(0)" ::: "memory");
        }
    }
    __syncthreads();
}


struct Args { const float* in[16]; float* out; unsigned char* ws; };
#ifndef PROBE_MASK
#define PROBE_MASK 0
#endif
#define STAMP(k) do { if (PROBE_MASK && bx == 0 && threadIdx.x == 0) ((LAS unsigned long long*)(lds + 135168))[k] = __builtin_amdgcn_s_memrealtime(); } while (0)
#ifndef XSYNC
#define XSYNC 0
#endif
#ifndef HG_REP
#define HG_REP 1
#endif
#ifndef EN_G1
#define EN_G1 1
#endif
#ifndef EN_G2
#define EN_G2 1
#endif
#ifndef EN_G3
#define EN_G3 1
#endif
#ifndef EN_MA
#define EN_MA 1
#endif
#ifndef EN_ATT
#define EN_ATT 1
#endif
#ifndef EN_MC
#define EN_MC 1
#endif
#ifndef EN_G5
#define EN_G5 1
#endif

constexpr int HL_SEG = 0, HL_B = 4096, HL_BS = 9216, HL_OL = HL_B + 7 * HL_BS, HL_TOT = HL_OL + 64 * 68 * 4, HP72 = 72;
typedef float f32x2v __attribute__((ext_vector_type(2)));
__device__ __forceinline__ float hgrn_lb(const float* logits, int l, int ch) {
    if (l == 0) return 0.f;
    const float x0 = logits[ch], x1 = logits[256 + ch], mx = fmaxf(x0, x1), e0 = __expf(x0 - mx), e1 = __expf(x1 - mx);
    return fminf(fmaxf(e1 / (e0 + e1), 0.f), 1.f);
}
__device__ __forceinline__ f32x4 mfma16(bf16x8 a, bf16x8 b, f32x4 c) { return __builtin_amdgcn_mfma_f32_16x16x32_bf16(a, b, c, 0, 0, 0); }
__device__ __forceinline__ void hgrn_front(LAS unsigned char* lds, const unsigned (&z2)[4], float lb0, float lb1, float (&lf)[2][4], float (&kk)[2][4], float (&tot)[2], float (&ref)[2], int dp, int sg) {
    LAS f32x2v* SEG = (LAS f32x2v*)(lds + HL_SEG);
#pragma unroll
    for (int j = 0; j < 4; ++j)
#pragma unroll
        for (int c = 0; c < 2; ++c) { const float lb = c ? lb1 : lb0; const float z = fmaxf(__builtin_bit_cast(float, c ? (z2[j] & 0xffff0000u) : (z2[j] << 16)), -80.f);
            const float e = __builtin_amdgcn_exp2f(-1.4426950408889634f * z), sgm = __builtin_amdgcn_rcpf(1.0f + e), f = lb + (1.0f - lb) * sgm;
            lf[c][j] = __builtin_amdgcn_logf(f); kk[c][j] = (1.0f - lb) * e * sgm; }
#pragma unroll
    for (int c = 0; c < 2; ++c) { lf[c][1] += lf[c][0]; lf[c][2] += lf[c][1]; lf[c][3] += lf[c][2]; }
    SEG[sg * 32 + dp] = (f32x2v){lf[0][3], lf[1][3]};
    __syncthreads();
    f32x2v off = (f32x2v){0.f, 0.f}, tt = off, rr = off;
#pragma unroll
    for (int q = 0; q < 16; ++q) { const f32x2v v = SEG[q * 32 + dp]; tt += v; if (q < sg) off += v; if (q < 8) rr += v; }
#pragma unroll
    for (int j = 0; j < 4; ++j) { lf[0][j] += off[0]; lf[1][j] += off[1]; }
    tot[0] = tt[0]; tot[1] = tt[1]; ref[0] = rr[0]; ref[1] = rr[1];
}
__device__ __forceinline__ void hgrn_seg_local(LAS unsigned char* lds, const bf16* H, const float* lbl, int l, float* HSEG, float* SEGDEC, int unit, int tid) {
    const int bh = unit >> 4, seg = unit & 15, b = bh >> 2, h = bh & 3, dp = tid & 31, sg = tid >> 5, lane = tid & 63, w = tid >> 6;
    const int mi = w >> 1, nj0 = 2 * (w & 1), lr = lane & 15, lq = lane >> 4;
    const bf16* hb = H + ((size_t)b * SEQL + seg * 512) * HPITCH + h * 64 + 2 * dp;
    LAS bf16* B0 = (LAS bf16*)(lds + HL_B); LAS bf16* B1 = B0 + HL_BS / 2; LAS float* TOTL = (LAS float*)(lds + HL_TOT);
    const float lb0 = hgrn_lb(lbl, l, h * 64 + 2 * dp), lb1 = hgrn_lb(lbl, l, h * 64 + 2 * dp + 1);
    unsigned z2[4], v2[4];
#pragma unroll
    for (int j = 0; j < 4; ++j) { const bf16* r = hb + (size_t)(4 * sg + j) * HPITCH; z2[j] = *(const unsigned*)(r + 1024); v2[j] = *(const unsigned*)(r + 1280); }
    f32x4 S[2] = {(f32x4){0.f, 0.f, 0.f, 0.f}, (f32x4){0.f, 0.f, 0.f, 0.f}}; float dsum0 = 0.f, dsum1 = 0.f;
#pragma unroll 1
    for (int c = 0; c < 8; ++c) {
        unsigned zn[4], vn[4];
        { const int cn = (c < 7) ? c + 1 : c;
#pragma unroll
          for (int j = 0; j < 4; ++j) { const bf16* r = hb + (size_t)(cn * 64 + 4 * sg + j) * HPITCH; zn[j] = *(const unsigned*)(r + 1024); vn[j] = *(const unsigned*)(r + 1280); } }
        float lf[2][4], kk[2][4], tot[2], ref[2];
        hgrn_front(lds, z2, lb0, lb1, lf, kk, tot, ref, dp, sg);
#pragma unroll
        for (int cc = 0; cc < 2; ++cc) { float kh[4];
#pragma unroll
            for (int j = 0; j < 4; ++j) kh[j] = kk[cc][j] * __builtin_amdgcn_exp2f(tot[cc] - lf[cc][j]);
            *(LAS pg8::u32x2*)(B0 + (2 * dp + cc) * HP72 + 4 * sg) = (pg8::u32x2){pk2(kh[0], kh[1]), pk2(kh[2], kh[3])}; }
        *(LAS pg8::u32x2*)(B1 + (2 * dp) * HP72 + 4 * sg) = (pg8::u32x2){(v2[0] & 0xffffu) | (v2[1] << 16), (v2[2] & 0xffffu) | (v2[3] << 16)};
        *(LAS pg8::u32x2*)(B1 + (2 * dp + 1) * HP72 + 4 * sg) = (pg8::u32x2){(v2[0] >> 16) | (v2[1] & 0xffff0000u), (v2[2] >> 16) | (v2[3] & 0xffff0000u)};
        if (sg == 0) { *(LAS f32x2v*)(TOTL + 2 * dp) = (f32x2v){tot[0], tot[1]}; dsum0 += tot[0]; dsum1 += tot[1]; }
        __syncthreads();
        f32x4 acc[2] = {(f32x4){0.f, 0.f, 0.f, 0.f}, (f32x4){0.f, 0.f, 0.f, 0.f}};
#pragma unroll
        for (int ks = 0; ks < 2; ++ks) { const bf16x8 a = *(const LAS bf16x8*)(B0 + (16 * mi + lr) * HP72 + 32 * ks + 8 * lq);
#pragma unroll
            for (int jn = 0; jn < 2; ++jn) { const bf16x8 bb = *(const LAS bf16x8*)(B1 + (16 * (nj0 + jn) + lr) * HP72 + 32 * ks + 8 * lq); acc[jn] = mfma16(a, bb, acc[jn]); } }
        const f32x4 tl = *(const LAS f32x4*)(TOTL + 16 * mi + 4 * lq);
        const f32x4 dec = (f32x4){__builtin_amdgcn_exp2f(tl[0]), __builtin_amdgcn_exp2f(tl[1]), __builtin_amdgcn_exp2f(tl[2]), __builtin_amdgcn_exp2f(tl[3])};
        S[0] = S[0] * dec + acc[0]; S[1] = S[1] * dec + acc[1];
#pragma unroll
        for (int j = 0; j < 4; ++j) { z2[j] = zn[j]; v2[j] = vn[j]; }
    }
    float* out = HSEG + (size_t)unit * 4096 + tid;
#pragma unroll
    for (int jn = 0; jn < 2; ++jn)
#pragma unroll
        for (int r = 0; r < 4; ++r) out[(jn * 4 + r) * 512] = S[jn][r];
    if (sg == 0) *(f32x2v*)(SEGDEC + (size_t)unit * 64 + 2 * dp) = (f32x2v){__builtin_amdgcn_exp2f(dsum0), __builtin_amdgcn_exp2f(dsum1)};
    __syncthreads();
}
__device__ __forceinline__ void hgrn_seg_out(LAS unsigned char* lds, const bf16* H, const float* lbl, int l, const float* HSEG, const float* SEGDEC, const float* ogain, bf16* Y, int unit, int tid) {
    const int bh = unit >> 4, seg = unit & 15, b = bh >> 2, h = bh & 3, dp = tid & 31, sg = tid >> 5, lane = tid & 63, w = tid >> 6, t8 = tid >> 3, cg8 = tid & 7;
    const int mi = w >> 1, nj0 = 2 * (w & 1), lr = lane & 15, lq = lane >> 4;
    const size_t row0 = (size_t)b * SEQL + seg * 512;
    const bf16* hb = H + row0 * HPITCH + h * 64;
    LAS bf16* B0 = (LAS bf16*)(lds + HL_B); LAS bf16* B1 = B0 + HL_BS / 2; LAS bf16* B2 = B1 + HL_BS / 2; LAS bf16* B3 = B2 + HL_BS / 2; LAS bf16* B4 = B3 + HL_BS / 2; LAS bf16* B5 = B4 + HL_BS / 2; LAS bf16* B6 = B5 + HL_BS / 2;
    LAS float* OL = (LAS float*)(lds + HL_OL); LAS float* TOTL = (LAS float*)(lds + HL_TOT);
    const float lb0 = hgrn_lb(lbl, l, h * 64 + 2 * dp), lb1 = hgrn_lb(lbl, l, h * 64 + 2 * dp + 1);
    const f32x4 g0 = *(const f32x4*)(ogain + cg8 * 8), g1 = *(const f32x4*)(ogain + cg8 * 8 + 4);
    unsigned z2[4], q2[4], v2[4];
#pragma unroll
    for (int j = 0; j < 4; ++j) { const bf16* r = hb + (size_t)(4 * sg + j) * HPITCH + 2 * dp; z2[j] = *(const unsigned*)(r + 1024); q2[j] = *(const unsigned*)(r + 768); v2[j] = *(const unsigned*)(r + 1280); }
    u16x8 gr = *(const u16x8*)(hb + (size_t)t8 * HPITCH + 1536 + cg8 * 8);
    f32x4 S[2] = {(f32x4){0.f, 0.f, 0.f, 0.f}, (f32x4){0.f, 0.f, 0.f, 0.f}};
#pragma unroll 2
    for (int j = 0; j < seg; ++j) { const float* Sj = HSEG + (size_t)(bh * 16 + j) * 4096 + tid; const f32x4 dj = *(const f32x4*)(SEGDEC + (size_t)(bh * 16 + j) * 64 + 16 * mi + 4 * lq);
#pragma unroll
        for (int jn = 0; jn < 2; ++jn) { f32x4 u;
#pragma unroll
            for (int r = 0; r < 4; ++r) u[r] = Sj[(jn * 4 + r) * 512];
            S[jn] = S[jn] * dj + u; } }
#pragma unroll 1
    for (int c = 0; c < 8; ++c) {
        unsigned zn[4], qn[4], vn[4]; u16x8 gn;
        { const int cn = (c < 7) ? c + 1 : c;
#pragma unroll
          for (int j = 0; j < 4; ++j) { const bf16* r = hb + (size_t)(cn * 64 + 4 * sg + j) * HPITCH + 2 * dp; zn[j] = *(const unsigned*)(r + 1024); qn[j] = *(const unsigned*)(r + 768); vn[j] = *(const unsigned*)(r + 1280); }
          gn = *(const u16x8*)(hb + (size_t)(cn * 64 + t8) * HPITCH + 1536 + cg8 * 8); }
        float lf[2][4], kk[2][4], tot[2], ref[2];
        hgrn_front(lds, z2, lb0, lb1, lf, kk, tot, ref, dp, sg);
#pragma unroll
        for (int j = 0; j < 4; ++j) { float qt[2], kt[2], qh[2];
#pragma unroll
            for (int cc = 0; cc < 2; ++cc) { const float bc = lf[cc][j], q = __builtin_bit_cast(float, cc ? (q2[j] & 0xffff0000u) : (q2[j] << 16));
                qt[cc] = q * __builtin_amdgcn_exp2f(fminf(bc - ref[cc], 115.f)); kt[cc] = kk[cc][j] * __builtin_amdgcn_exp2f(fminf(ref[cc] - bc, 115.f)); qh[cc] = q * __builtin_amdgcn_exp2f(bc); }
            const int o = (4 * sg + j) * HP72 + 2 * dp;
            *(LAS unsigned*)(B0 + o) = pk2(qt[0], qt[1]); *(LAS unsigned*)(B1 + o) = pk2(kt[0], kt[1]); *(LAS unsigned*)(B2 + o) = pk2(qh[0], qh[1]); }
#pragma unroll
        for (int cc = 0; cc < 2; ++cc) { float kh[4];
#pragma unroll
            for (int j = 0; j < 4; ++j) kh[j] = kk[cc][j] * __builtin_amdgcn_exp2f(tot[cc] - lf[cc][j]);
            *(LAS pg8::u32x2*)(B6 + (2 * dp + cc) * HP72 + 4 * sg) = (pg8::u32x2){pk2(kh[0], kh[1]), pk2(kh[2], kh[3])}; }
        *(LAS pg8::u32x2*)(B3 + (2 * dp) * HP72 + 4 * sg) = (pg8::u32x2){(v2[0] & 0xffffu) | (v2[1] << 16), (v2[2] & 0xffffu) | (v2[3] << 16)};
        *(LAS pg8::u32x2*)(B3 + (2 * dp + 1) * HP72 + 4 * sg) = (pg8::u32x2){(v2[0] >> 16) | (v2[1] & 0xffff0000u), (v2[2] >> 16) | (v2[3] & 0xffff0000u)};
#pragma unroll
        for (int jn = 0; jn < 2; ++jn) *(LAS pg8::u32x2*)(B4 + (16 * (nj0 + jn) + lr) * HP72 + 16 * mi + 4 * lq) = (pg8::u32x2){pk2(S[jn][0], S[jn][1]), pk2(S[jn][2], S[jn][3])};
        if (sg == 0) *(LAS f32x2v*)(TOTL + 2 * dp) = (f32x2v){tot[0], tot[1]};
        __syncthreads();
        f32x4 un[2] = {(f32x4){0.f, 0.f, 0.f, 0.f}, (f32x4){0.f, 0.f, 0.f, 0.f}};
        { f32x4 acc[2] = {(f32x4){0.f, 0.f, 0.f, 0.f}, (f32x4){0.f, 0.f, 0.f, 0.f}};
#pragma unroll
          for (int ks = 0; ks < 2; ++ks) { const bf16x8 a = *(const LAS bf16x8*)(B1 + (16 * mi + lr) * HP72 + 32 * ks + 8 * lq); const bf16x8 a6 = *(const LAS bf16x8*)(B6 + (16 * mi + lr) * HP72 + 32 * ks + 8 * lq);
#pragma unroll
              for (int jn = 0; jn < 2; ++jn) { const bf16x8 bb = *(const LAS bf16x8*)(B0 + (16 * (nj0 + jn) + lr) * HP72 + 32 * ks + 8 * lq); acc[jn] = mfma16(a, bb, acc[jn]);
                  const bf16x8 b3 = *(const LAS bf16x8*)(B3 + (16 * (nj0 + jn) + lr) * HP72 + 32 * ks + 8 * lq); un[jn] = mfma16(a6, b3, un[jn]); } }
#pragma unroll
          for (int jn = 0; jn < 2; ++jn) { const int t = 16 * (nj0 + jn) + lr, sp = 16 * mi + 4 * lq; float m[4];
#pragma unroll
              for (int r = 0; r < 4; ++r) m[r] = (sp + r <= t) ? acc[jn][r] : 0.f;
              *(LAS pg8::u32x2*)(B5 + t * HP72 + sp) = (pg8::u32x2){pk2(m[0], m[1]), pk2(m[2], m[3])}; } }
        const f32x4 tl = *(const LAS f32x4*)(TOTL + 16 * mi + 4 * lq);
        __syncthreads();
        { f32x4 acc[2] = {(f32x4){0.f, 0.f, 0.f, 0.f}, (f32x4){0.f, 0.f, 0.f, 0.f}};
#pragma unroll
          for (int ks = 0; ks < 2; ++ks) { const bf16x8 a = *(const LAS bf16x8*)(B3 + (16 * mi + lr) * HP72 + 32 * ks + 8 * lq);
#pragma unroll
              for (int jn = 0; jn < 2; ++jn) { const bf16x8 bb = *(const LAS bf16x8*)(B5 + (16 * (nj0 + jn) + lr) * HP72 + 32 * ks + 8 * lq); acc[jn] = mfma16(a, bb, acc[jn]); } }
#pragma unroll
          for (int ks = 0; ks < 2; ++ks) { const bf16x8 a = *(const LAS bf16x8*)(B4 + (16 * mi + lr) * HP72 + 32 * ks + 8 * lq);
#pragma unroll
              for (int jn = 0; jn < 2; ++jn) { const bf16x8 bb = *(const LAS bf16x8*)(B2 + (16 * (nj0 + jn) + lr) * HP72 + 32 * ks + 8 * lq); acc[jn] = mfma16(a, bb, acc[jn]); } }
#pragma unroll
          for (int jn = 0; jn < 2; ++jn) *(LAS f32x4*)(OL + (16 * (nj0 + jn) + lr) * 68 + 16 * mi + 4 * lq) = acc[jn]; }
        { const f32x4 dec = (f32x4){__builtin_amdgcn_exp2f(tl[0]), __builtin_amdgcn_exp2f(tl[1]), __builtin_amdgcn_exp2f(tl[2]), __builtin_amdgcn_exp2f(tl[3])};
          S[0] = S[0] * dec + un[0]; S[1] = S[1] * dec + un[1]; }
        __syncthreads();
        { const f32x4 o0 = *(const LAS f32x4*)(OL + t8 * 68 + cg8 * 8), o1 = *(const LAS f32x4*)(OL + t8 * 68 + cg8 * 8 + 4);
          float ss = (o0[0] * o0[0] + o0[1] * o0[1]) + (o0[2] * o0[2] + o0[3] * o0[3]) + (o1[0] * o1[0] + o1[1] * o1[1]) + (o1[2] * o1[2] + o1[3] * o1[3]);
          ss += __shfl_xor(ss, 1); ss += __shfl_xor(ss, 2); ss += __shfl_xor(ss, 4);
          const float rinv = rsqrtf(ss * (1.0f / 64.0f) + 1e-6f);
          float o[8];
#pragma unroll
          for (int i = 0; i < 4; ++i) { o[i] = o0[i] * rinv * g0[i] * pg8::silu_f(bf2f(gr[i])); o[4 + i] = o1[i] * rinv * g1[i] * pg8::silu_f(bf2f(gr[4 + i])); }
          *(v4u*)(Y + (row0 + c * 64 + t8) * DM + 256 + h * 64 + cg8 * 8) = (v4u){pk2(o[0], o[1]), pk2(o[2], o[3]), pk2(o[4], o[5]), pk2(o[6], o[7])}; }
#pragma unroll
        for (int j = 0; j < 4; ++j) { z2[j] = zn[j]; q2[j] = qn[j]; v2[j] = vn[j]; }
        gr = gn;
    }
    __syncthreads();
}
__device__ __forceinline__ void conv_unit(const bf16* H, const float* cw, bf16* Y, int unit, int tid) {
    const int cgp = tid & 31, tl = tid >> 5, ch = cgp * 8;
    float w0[8], w1[8], w2[8];
#pragma unroll
    for (int i = 0; i < 8; ++i) { w0[i] = cw[ch + i]; w1[i] = cw[256 + ch + i]; w2[i] = cw[512 + ch + i]; }
#pragma unroll 2
    for (int p = 0; p < 4; ++p) { const int row = unit * 64 + p * 16 + tl, t = row & (SEQL - 1);
        const bf16* hp = H + (size_t)row * HPITCH + ch;
        const u16x8 x2 = *(const u16x8*)hp, c2 = *(const u16x8*)(hp + 512), bg = *(const u16x8*)(hp + 256);
        u16x8 x1 = (u16x8){0,0,0,0,0,0,0,0}, c1 = x1, x0 = x1, c0 = x1;
        if (t >= 1) { x1 = *(const u16x8*)(hp - HPITCH); c1 = *(const u16x8*)(hp - HPITCH + 512); }
        if (t >= 2) { x0 = *(const u16x8*)(hp - 2 * HPITCH); c0 = *(const u16x8*)(hp - 2 * HPITCH + 512); }
        float o[8];
#pragma unroll
        for (int i = 0; i < 8; ++i) o[i] = bf2f(bg[i]) * (w0[i] * (bf2f(c0[i]) * bf2f(x0[i])) + w1[i] * (bf2f(c1[i]) * bf2f(x1[i])) + w2[i] * (bf2f(c2[i]) * bf2f(x2[i])));
        *(v4u*)(Y + (size_t)row * DM + ch) = (v4u){pk2(o[0], o[1]), pk2(o[2], o[3]), pk2(o[4], o[5]), pk2(o[6], o[7])}; }
}
__device__ __forceinline__ void cumsum_unit(LAS unsigned char* lds, float* C, int unit, int tid) {
    LAS float* WS = (LAS float*)lds; float* p = C + (size_t)unit * SEQL + tid * 16; const int lane = tid & 63, w = tid >> 6;
    float v[16];
#pragma unroll
    for (int j = 0; j < 4; ++j) { const f32x4 x = *(const f32x4*)(p + 4 * j); v[4 * j] = x[0]; v[4 * j + 1] = x[1]; v[4 * j + 2] = x[2]; v[4 * j + 3] = x[3]; }
#pragma unroll
    for (int i = 1; i < 16; ++i) v[i] += v[i - 1];
    const float tot = v[15]; float inc = tot;
#pragma unroll
    for (int o = 1; o < 64; o <<= 1) { const float t = __shfl_up(inc, o); if (lane >= o) inc += t; }
    if (lane == 63) WS[w] = inc;
    __syncthreads();
    float off = inc - tot;
    for (int q = 0; q < w; ++q) off += WS[q];
#pragma unroll
    for (int j = 0; j < 4; ++j) *(f32x4*)(p + 4 * j) = (f32x4){v[4 * j] + off, v[4 * j + 1] + off, v[4 * j + 2] + off, v[4 * j + 3] + off};
    __syncthreads();
}

__global__ void __launch_bounds__(NWAVES * 64, 2) fwd_mega(Args args) {
    extern __shared__ __attribute__((aligned(16))) unsigned char lds_raw[];
    cg::grid_group grid = cg::this_grid();
    LAS unsigned char* lds = (LAS unsigned char*)lds_raw;
    const int tid = threadIdx.x, lane = tid & 63, wave = __builtin_amdgcn_readfirstlane(tid >> 6);
    const int G = gridDim.x, bx = blockIdx.x; const int vcu = (G % 8 == 0) ? (bx % 8) * (G / 8) + bx / 8 : bx;
    unsigned char* ws = args.ws;
    for (int u_ = threadIdx.x; u_ < (LDS_BYTES - 131072) / 4; u_ += NWAVES * 64) ((LAS unsigned*)(lds + 131072))[u_] = 0u;
    __syncthreads();
    const XcdBarrier xbar = xcd_barrier_post((unsigned*)(ws + WS_BAR), (volatile LAS unsigned*)(lds + 140288));
#define SEAM() do { XcdBarrier b_ = xbar; asm volatile("" : "+s"(b_.x)); xcd_barrier(b_); } while (0)
    unsigned long long* RS = (unsigned long long*)(ws + WS_RS); float* FOXC = (float*)(ws + WS_FOXC); float* DEC = (float*)(ws + WS_DEC);
    unsigned* QCTR = (unsigned*)(ws + WS_QCTR);
    bf16* XB = (bf16*)(ws + WS_XB); bf16* HACT = (bf16*)(ws + WS_HACT); bf16* Y = (bf16*)(ws + WS_Y); float* HST = (float*)(ws + WS_HST);
    const float* x_in = args.in[0]; float* out = args.out;

    STAMP(0);
    {
        LAS float* scr = (LAS float*)(lds + wave * 16384);
        const int gw = vcu * NWAVES + wave, NGW = G * NWAVES;
        constexpr int I_FI = 16 * 176, I_FO = 44 * 32, I_MI = 16 * 112, I_MO = 16 * 32, I_L = 2 * I_FI + 2 * I_FO + I_MI + I_MO;
        for (int it = gw; it < DEPTH * I_L; it += NGW) {
            const int l = it / I_L; int r = it - l * I_L; unsigned char* wl = ws + WS_W + (size_t)l * W_LAYER;
            if (r < I_FI) { tr_item(args.in[2] + (size_t)l * DM * NFF, DM, NFF, 176, args.in[1] + l * DM, (bf16*)(wl + WO_1IN), 1, scr, r, lane); continue; } r -= I_FI;
            if (r < I_FO) { tr_item(args.in[3] + (size_t)l * DFF * DM, DFF, DM, 32, nullptr, (bf16*)(wl + WO_1OUT), 0, scr, r, lane); continue; } r -= I_FO;
            if (r < I_MI) { tr_item(args.in[5] + (size_t)l * DM * NMIX, DM, NMIX, 112, args.in[4] + l * DM, (bf16*)(wl + WO_MIX), 2, scr, r, lane); continue; } r -= I_MI;
            if (r < I_MO) { tr_item(args.in[12] + (size_t)l * DM * DM, DM, DM, 32, nullptr, (bf16*)(wl + WO_MO), 0, scr, r, lane); continue; } r -= I_MO;
            if (r < I_FI) { tr_item(args.in[14] + (size_t)l * DM * NFF, DM, NFF, 176, args.in[13] + l * DM, (bf16*)(wl + WO_2IN), 1, scr, r, lane); continue; } r -= I_FI;
            tr_item(args.in[15] + (size_t)l * DFF * DM, DFF, DM, 32, nullptr, (bf16*)(wl + WO_2OUT), 0, scr, r, lane);
        }
#pragma unroll 4
        for (int m = gw; m < M; m += NGW) {
            const f32x4* xr = (const f32x4*)(x_in + (size_t)m * DM) + lane; f32x4 v[4]; float s = 0.f;
#pragma unroll
            for (int j = 0; j < 4; ++j) { v[j] = __builtin_nontemporal_load(xr + 64 * j); s += (v[j][0] * v[j][0] + v[j][1] * v[j][1]) + (v[j][2] * v[j][2] + v[j][3] * v[j][3]); }
            s = wave_sum(s); if (lane == 0) RS[m] = (unsigned long long)(s * 16777216.0f);
            unsigned long long* o8 = (unsigned long long*)(XB + (size_t)m * DM) + lane;
#pragma unroll
            for (int j = 0; j < 4; ++j) o8[64 * j] = (unsigned long long)pk2(v[j][0], v[j][1]) | ((unsigned long long)pk2(v[j][2], v[j][3]) << 32);
        }
        for (int i = bx * (NWAVES * 64) + tid; i < 5 * M; i += G * NWAVES * 64) RS[M + i] = 0ull;
    }
    if (gridDim.x == 0x7fffffffu) grid.sync();
    SEAM(); STAMP(1);

#pragma unroll 1
    for (int step = 0; step < 3 * DEPTH; ++step) {
        const int l = step / 3, kind = step - 3 * l; unsigned char* wl = ws + WS_W + (size_t)l * W_LAYER;
        int tid = threadIdx.x; asm volatile("" : "+v"(tid));
        const unsigned long long* rs_in = RS + (size_t)step * M; unsigned long long* rs_out = (step + 1 < 3 * DEPTH) ? RS + (size_t)(step + 1) * M : nullptr;
        if (kind != 1) {
            const bf16* w_in = (const bf16*)(wl + (kind == 0 ? WO_1IN : WO_2IN)); const bf16* w_out = (const bf16*)(wl + (kind == 0 ? WO_1OUT : WO_2OUT));
            { pg8::Gemm g{XB, w_in, M, NFF, DM}; pg8::StaticOrder S; S.init(M, NFF, G, bx);
              pg8::EpiGlu E{HACT, DFF, rs_in};
              if (EN_G1) pg8::gemm_phase<pg8::EpiGlu, pg8::StaticOrder, true, true>(lds, g, S, E); }
            SEAM(); STAMP(2 + step * 8 + 0);
            { pg8::Gemm g{HACT, w_out, M, DM, DFF}; pg8::StaticOrder S; S.init(M, DM, G, bx);
              pg8::EpiResid E{XB, rs_out ? nullptr : out, rs_out, 0.5f};
              if (EN_G2) pg8::gemm_phase<pg8::EpiResid, pg8::StaticOrder, true, true>(lds, g, S, E); }
            if (step + 1 < 3 * DEPTH || PROBE_MASK) SEAM();
            STAMP(2 + step * 8 + 1);
        } else {
            { pg8::Gemm g{XB, (const bf16*)(wl + WO_MIX), M, HPITCH, DM}; pg8::StaticOrder S; S.init(M, HPITCH, G, bx);
              pg8::EpiMix E{HACT, rs_in, args.in[9] + l * 64, args.in[10] + l * 64, args.in[11] + l * 8, FOXC};
              if (EN_G3) pg8::gemm_phase<pg8::EpiMix, pg8::StaticOrder, true, true>(lds, g, S, E); }
            SEAM(); STAMP(2 + step * 8 + 0);
            for (int u = bx; u < 256 + 32; u += G) {
                if (u < 256) { if (EN_MA) for (int rep_ = 0; rep_ < HG_REP; ++rep_) hgrn_seg_local(lds, HACT, args.in[7], l, HST, DEC, u, tid); }
                else cumsum_unit(lds, FOXC, u - 256, tid);
            }
            SEAM(); STAMP(2 + step * 8 + 1);
            { unsigned* qc = QCTR + 64 * l; LAS unsigned* slot = (LAS unsigned*)(lds + 139264);
              for (;;) {
                  if (threadIdx.x == 0) *slot = atomicAdd(qc, 1u);
                  __syncthreads(); const int u = (int)__builtin_amdgcn_readfirstlane(*slot); __syncthreads();
                  if (u >= 1024 + 256 + 512) break;
                  if (u < 1024) { const int bh = u & 31, qb = 31 - (u >> 5);
                      if (EN_ATT) attn_body::attn_unit<48>(bh >> 3, bh & 7, qb, (const attn_body::bf16*)(HACT + 1792), (const attn_body::bf16*)(HACT + 2304), (const attn_body::bf16*)(HACT + 2816), (attn_body::bf16*)(Y + 512), FOXC, args.in[9] + l * 64, args.in[10] + l * 64, (char*)lds_raw); }
                  else if (u >= 1024 + 256) { int tq = threadIdx.x; asm volatile("" : "+v"(tq)); conv_unit(HACT, args.in[6] + l * 768, Y, u - 1280, tq); }
                  else { int tq = threadIdx.x; asm volatile("" : "+v"(tq));
                      if (EN_MC) for (int rep_ = 0; rep_ < HG_REP; ++rep_) hgrn_seg_out(lds, HACT, args.in[7], l, HST, DEC, args.in[8] + l * 64, Y, u - 1024, tq); }
              } }
            if (PROBE_MASK) { STAMP(2 + step * 8 + 2); }
            SEAM(); STAMP(2 + step * 8 + 3); STAMP(2 + step * 8 + 4);
            { pg8::Gemm g{Y, (const bf16*)(wl + WO_MO), M, DM, DM}; pg8::StaticOrder S; S.init(M, DM, G, bx);
              pg8::EpiResid E{XB, nullptr, rs_out, 1.0f};
              if (EN_G5) pg8::gemm_phase<pg8::EpiResid, pg8::StaticOrder, true, true>(lds, g, S, E); }
            SEAM(); STAMP(2 + step * 8 + 5);
        }
    }
    for (int i_ = 0; i_ < XSYNC; ++i_) SEAM();
    if (PROBE_MASK && bx == 0 && threadIdx.x == 0) {
        const LAS unsigned long long* T = (const LAS unsigned long long*)(lds + 135168);
        unsigned long long X = 0, prev = T[1];
        if (PROBE_MASK & 1) X += T[1] - T[0];
        for (int st = 0; st < 3 * DEPTH; ++st) { const LAS unsigned long long* q = T + 2 + st * 8;
            if (st % 3 != 1) { if (PROBE_MASK & 2) X += q[0] - prev; if (PROBE_MASK & 4) X += q[1] - q[0]; prev = q[1]; }
            else { if (PROBE_MASK & 8) X += q[0] - prev; if (PROBE_MASK & 16) X += q[1] - q[0]; if (PROBE_MASK & 32) X += q[2] - q[1]; if (PROBE_MASK & 64) X += q[3] - q[2];
                   if (PROBE_MASK & 128) X += q[4] - q[3]; if (PROBE_MASK & 256) X += q[5] - q[4]; prev = q[5]; } }
        const unsigned long long t0 = __builtin_amdgcn_s_memrealtime();
        while (__builtin_amdgcn_s_memrealtime() - t0 < X) __builtin_amdgcn_s_sleep(16);
    }
}

extern "C" void kernel_launch(void* const* d_in, const int* in_sizes, int n_in, void* d_out, int out_size, void* d_ws, size_t ws_size, hipStream_t stream) {
    static int grid = 0;
    if (grid == 0) {
        if (n_in != 16 || out_size != M * DM || ws_size < WS_END) { fprintf(stderr, "kernel_launch: unexpected shapes (n_in %d out %d ws %zu)\n", n_in, out_size, ws_size); grid = -1; return; }
        int dev = 0, cus = 0, per_cu = 0;
        hipGetDevice(&dev); hipDeviceGetAttribute(&cus, hipDeviceAttributeMultiprocessorCount, dev);
        hipFuncSetAttribute((const void*)fwd_mega, hipFuncAttributeMaxDynamicSharedMemorySize, LDS_BYTES);
        if (hipOccupancyMaxActiveBlocksPerMultiprocessor(&per_cu, (const void*)fwd_mega, NWAVES * 64, LDS_BYTES) != hipSuccess || per_cu < 1) { fprintf(stderr, "kernel_launch: occupancy query failed (%d)\n", per_cu); per_cu = 1; }
        (void)hipGetLastError();
        grid = cus * 1;
    }
    if (grid < 0) return;
    if (hipMemsetAsync((char*)d_ws + WS_QCTR, 0, WS_CTL_ZERO, stream) != hipSuccess) { fprintf(stderr, "kernel_launch: memset of the control words failed\n"); return; }
    Args a{};
    for (int i = 0; i < 16; ++i) a.in[i] = (const float*)d_in[i];
    a.out = (float*)d_out; a.ws = (unsigned char*)d_ws;
    void* kargs[] = {&a};
    hipError_t e = hipLaunchCooperativeKernel((const void*)fwd_mega, dim3(grid), dim3(NWAVES * 64), kargs, LDS_BYTES, stream);
    if (e != hipSuccess) fprintf(stderr, "cooperative launch failed: %s (grid %d)\n", hipGetErrorString(e), grid);
}
```

```cpp
#include <hip/hip_runtime.h>
#include <cstdio>
#include <cstdint>
namespace pg8 {
#define PG8_LAS __attribute__((address_space(3)))
typedef unsigned short bf16_t;
typedef short bf16x8 __attribute__((ext_vector_type(8)));
typedef float f32x4 __attribute__((ext_vector_type(4)));
typedef unsigned u32x4 __attribute__((ext_vector_type(4)));
constexpr int BM = 256, BK = 64, HALF = 128, HTB = HALF * BK * 2  , STAGE_BYTES = 8 * HTB, NXCD = 8, WGM = 8;

__host__ __device__ __forceinline__ int lds_byte(int r, int c) { const int st = (r >> 4) * 2 + (c >> 5), rr = r & 15, cc = c & 31, ob = rr * 64 + cc * 2; return st * 1024 + (ob ^ (((ob >> 9) & 1) << 5)); }
__host__ __device__ __forceinline__ void stage_rc(int b, int& R, int& C) { const int st = b / 1024, sb = b % 1024, swz = sb ^ (((sb >> 9) & 1) << 5); R = (st >> 1) * 16 + swz / 64; C = (st & 1) * 32 + (swz % 64) / 2; }
__host__ __device__ __forceinline__ int perm32(int rho) { const int n = rho >> 4, i = rho & 15; return 8 * (i >> 2) + 4 * n + (i & 3); }

struct Unit { int pm, pn; };
struct Gemm { const bf16_t* A; const bf16_t* Bt; int M, N, K; };

struct StaticOrder {
    int nM, nN, nwg, G, c;
    __host__ __device__ void init(int M, int N, int G_, int c_) { nM = M / BM; nN = N / BM; nwg = nM * nN; G = G_; c = c_; }
    __host__ __device__ bool next(int i, Unit& u) const {
        const long L = (long)i * G + c; if (L >= nwg) return false;
        int wgid = (int)L; { const int q = nwg / NXCD, r = nwg % NXCD, xcd = wgid % NXCD, off = wgid / NXCD; wgid = (xcd < r ? xcd * (q + 1) : r * (q + 1) + (xcd - r) * q) + off; }
        const int nig = WGM * nN, gid = wgid / nig, fm = gid * WGM, gsz = (nM - fm) < WGM ? (nM - fm) : WGM;
        u.pm = fm + ((wgid % nig) % gsz); u.pn = (wgid % nig) / gsz; return true;
    }
    __device__ __forceinline__ void a_ready(const Unit&) const {}
    __device__ __forceinline__ void done(const Unit&) const {}
};

__device__ __forceinline__ unsigned cvt_pk_bf16(float lo, float hi) { unsigned r; asm volatile("v_cvt_pk_bf16_f32 %0, %1, %2" : "=v"(r) : "v"(lo), "v"(hi)); return r; }
typedef float f32x2 __attribute__((ext_vector_type(2)));
constexpr float RMS_EPS = 1e-6f;
__device__ __forceinline__ float silu_f(float g) { return g * __builtin_amdgcn_rcpf(1.0f + __builtin_amdgcn_exp2f(-1.4426950408889634f * g)); }
struct EpiGlu {
    static constexpr bool PERM = true, AFTER_DRAIN = false;
    bf16_t* O; int ldc; const unsigned long long* rss;
    __device__ __forceinline__ void operator()(const f32x4 (&acc)[2][2][4][2], const Unit& u, int wr, int wc, int fr, int fq) const {
        const int row0 = u.pm * BM + wr * 64 + fr, col0 = u.pn * HALF + wc * 32 + 8 * fq;
        unsigned long long rv[2][4];
#pragma unroll
        for (int ai = 0; ai < 2; ++ai)
#pragma unroll
            for (int m = 0; m < 4; ++m) rv[ai][m] = rss[row0 + ai * HALF + m * 16];
#pragma unroll
        for (int ai = 0; ai < 2; ++ai)
#pragma unroll
            for (int m = 0; m < 4; ++m) { const int row = row0 + ai * HALF + m * 16; const float inv = rsqrtf((float)rv[ai][m] * (1.0f / (1024.0f * 16777216.0f)) + RMS_EPS);
                const float cexp = -1.4426950408889634f * inv, inv2 = inv * inv; u32x4 w;
#pragma unroll
                for (int n = 0; n < 2; ++n) { const f32x4 g = acc[ai][0][m][n], uu = acc[ai][1][m][n]; const f32x4 t = g * cexp;
                    const f32x4 e = (f32x4){__builtin_amdgcn_exp2f(t[0]), __builtin_amdgcn_exp2f(t[1]), __builtin_amdgcn_exp2f(t[2]), __builtin_amdgcn_exp2f(t[3])};
                    const f32x4 d = e + 1.0f;
                    const f32x4 r = (f32x4){__builtin_amdgcn_rcpf(d[0]), __builtin_amdgcn_rcpf(d[1]), __builtin_amdgcn_rcpf(d[2]), __builtin_amdgcn_rcpf(d[3])};
                    const f32x4 o = (g * uu) * (r * inv2);
                    if (n == 0) { w.x = cvt_pk_bf16(o[0], o[1]); w.y = cvt_pk_bf16(o[2], o[3]); } else { w.z = cvt_pk_bf16(o[0], o[1]); w.w = cvt_pk_bf16(o[2], o[3]); } }
                *(u32x4*)(O + (size_t)row * ldc + col0) = w; }
    }
};
typedef unsigned u32x2 __attribute__((ext_vector_type(2)));
struct EpiResid {
    static constexpr bool PERM = true, AFTER_DRAIN = false;
    bf16_t* xb; float* outf; unsigned long long* rss_next; float alpha;
    __device__ __forceinline__ void operator()(const f32x4 (&acc)[2][2][4][2], const Unit& u, int wr, int wc, int fr, int fq) const {
        const int row0 = u.pm * BM + wr * 64 + fr, col0 = u.pn * BM + wc * 32 + 8 * fq;
        u32x4 xall[2][4][2];
#pragma unroll
        for (int ai = 0; ai < 2; ++ai)
#pragma unroll
            for (int m = 0; m < 4; ++m)
#pragma unroll
                for (int bj = 0; bj < 2; ++bj) xall[ai][m][bj] = *(const u32x4*)(xb + (size_t)(row0 + ai * HALF + m * 16) * 1024 + col0 + bj * HALF);
#pragma unroll
        for (int ai = 0; ai < 2; ++ai)
#pragma unroll
            for (int m = 0; m < 4; ++m) { const int row = row0 + ai * HALF + m * 16; const size_t off = (size_t)row * 1024 + col0; float ss = 0.f;
                const u32x4 (&xin)[2] = xall[ai][m];
#pragma unroll
                for (int bj = 0; bj < 2; ++bj) {
                    const f32x4 x0 = (f32x4){__builtin_bit_cast(float, xin[bj].x << 16), __builtin_bit_cast(float, xin[bj].x & 0xffff0000u), __builtin_bit_cast(float, xin[bj].y << 16), __builtin_bit_cast(float, xin[bj].y & 0xffff0000u)};
                    const f32x4 x1 = (f32x4){__builtin_bit_cast(float, xin[bj].z << 16), __builtin_bit_cast(float, xin[bj].z & 0xffff0000u), __builtin_bit_cast(float, xin[bj].w << 16), __builtin_bit_cast(float, xin[bj].w & 0xffff0000u)};
                    const f32x4 o0 = x0 + acc[ai][bj][m][0] * alpha, o1 = x1 + acc[ai][bj][m][1] * alpha;
                    ss += (o0[0] * o0[0] + o0[1] * o0[1]) + (o0[2] * o0[2] + o0[3] * o0[3]) + (o1[0] * o1[0] + o1[1] * o1[1]) + (o1[2] * o1[2] + o1[3] * o1[3]);
                    if (outf) { __builtin_nontemporal_store(o0, (f32x4*)(outf + off + bj * HALF)); __builtin_nontemporal_store(o1, (f32x4*)(outf + off + bj * HALF + 4)); }
                    else { u32x4 w; w.x = cvt_pk_bf16(o0[0], o0[1]); w.y = cvt_pk_bf16(o0[2], o0[3]); w.z = cvt_pk_bf16(o1[0], o1[1]); w.w = cvt_pk_bf16(o1[2], o1[3]); *(u32x4*)(xb + off + bj * HALF) = w; } }
                if (rss_next) { ss += __shfl_xor(ss, 16); ss += __shfl_xor(ss, 32); if (fq == 0) atomicAdd(rss_next + row, (unsigned long long)(ss * 16777216.0f)); } }
    }
};
struct EpiMix {
    static constexpr bool PERM = true, AFTER_DRAIN = false;
    bf16_t* H; const unsigned long long* rss; const float* qgain; const float* kgain; const float* fbias; float* foxlf;
    __device__ __forceinline__ void operator()(const f32x4 (&acc)[2][2][4][2], const Unit& u, int wr, int wc, int fr, int fq) const {
        const int row0 = u.pm * BM + wr * 64 + fr, col0 = u.pn * BM + wc * 64 + 8 * fq;
        const int mode = (u.pn == 7 || u.pn == 8) ? 1 : (u.pn == 9 || u.pn == 10) ? 2 : (u.pn == 13) ? 3 : 0;
        f32x4 gv[2][2];
#pragma unroll
        for (int bj = 0; bj < 2; ++bj)
#pragma unroll
            for (int n = 0; n < 2; ++n) gv[bj][n] = (f32x4){1.f, 1.f, 1.f, 1.f};
        if (mode == 1 || mode == 2) { const float* gp = (mode == 1 ? qgain : kgain) + 8 * fq; const float sc = (mode == 1) ? 0.125f * 1.4426950408889634f : 1.0f;
#pragma unroll
            for (int bj = 0; bj < 2; ++bj)
#pragma unroll
                for (int n = 0; n < 2; ++n) gv[bj][n] = *(const f32x4*)(gp + 32 * bj + 4 * n) * sc; }
        unsigned long long rv[2][4];
#pragma unroll
        for (int ai = 0; ai < 2; ++ai)
#pragma unroll
            for (int m = 0; m < 4; ++m) rv[ai][m] = rss[row0 + ai * HALF + m * 16];
#pragma unroll
        for (int ai = 0; ai < 2; ++ai)
#pragma unroll
            for (int m = 0; m < 4; ++m) { const int row = row0 + ai * HALF + m * 16; float inv = rsqrtf((float)rv[ai][m] * (1.0f / (1024.0f * 16777216.0f)) + RMS_EPS);
                f32x4 v[2][2];
#pragma unroll
                for (int bj = 0; bj < 2; ++bj)
#pragma unroll
                    for (int n = 0; n < 2; ++n) v[bj][n] = acc[ai][bj][m][n] * inv;
                if (mode == 1 || mode == 2) { float ss = 0.f;
#pragma unroll
                    for (int bj = 0; bj < 2; ++bj)
#pragma unroll
                        for (int n = 0; n < 2; ++n) ss += (v[bj][n][0] * v[bj][n][0] + v[bj][n][1] * v[bj][n][1]) + (v[bj][n][2] * v[bj][n][2] + v[bj][n][3] * v[bj][n][3]);
                    ss += __shfl_xor(ss, 16); ss += __shfl_xor(ss, 32);
                    const float hinv = rsqrtf(ss * (1.0f / 64.0f) + RMS_EPS);
#pragma unroll
                    for (int bj = 0; bj < 2; ++bj)
#pragma unroll
                        for (int n = 0; n < 2; ++n) v[bj][n] = v[bj][n] * hinv * gv[bj][n]; }
                if (mode == 3 && wc == 0 && fq == 0) { const int b = row >> 13, t = row & 8191;
#pragma unroll
                    for (int n = 0; n < 2; ++n)
#pragma unroll
                        for (int i = 0; i < 4; ++i) { const int h = 4 * n + i; const float a = v[0][n][i] + fbias[h];
                            const float a2 = a * 1.4426950408889634f;
                            foxlf[(size_t)(b * 8 + h) * 8192 + t] = fminf(a2, 0.f) - __builtin_amdgcn_logf(1.0f + __builtin_amdgcn_exp2f(-fabsf(a2))); } }
                if (mode == 3) continue;
#pragma unroll
                for (int bj = 0; bj < 2; ++bj) { u32x4 w; w.x = cvt_pk_bf16(v[bj][0][0], v[bj][0][1]); w.y = cvt_pk_bf16(v[bj][0][2], v[bj][0][3]); w.z = cvt_pk_bf16(v[bj][1][0], v[bj][1][1]); w.w = cvt_pk_bf16(v[bj][1][2], v[bj][1][3]);
                    *(u32x4*)(H + (size_t)row * 3584 + col0 + 32 * bj) = w; } }
    }
};
template <class Epi, class Sched, bool ALIGN_EPI = false, bool SP2 = false>
__device__ __forceinline__ void gemm_phase(PG8_LAS unsigned char* lds, const Gemm g, const Sched& S, const Epi& E) {
    int tid_l = threadIdx.x; asm volatile("" : "+v"(tid_l));
    const int tid = tid_l, wid = __builtin_amdgcn_readfirstlane(tid >> 6), lane = tid & 63, wr = wid >> 2, wc = wid & 3, fr = lane & 15, fq = lane >> 4;
    const int K = g.K, nt = K / BK;
    unsigned voffA[2], voffB[2];
#pragma unroll
    for (int i = 0; i < 2; ++i) { int R, C; stage_rc(tid * 16 + i * 8192, R, C); const int Rb = Epi::PERM ? ((R & ~31) + perm32(R & 31)) : R;
        voffA[i] = (unsigned)(R * K + C) * 2u; voffB[i] = (unsigned)(Rb * K + C) * 2u; }
    const size_t kstep = (size_t)(BK * 2);
    const size_t hstep = (size_t)HALF * K * 2;
    const size_t tstep = 2 * hstep;
    const unsigned ldsw = (unsigned)wid * 1024u;
    const int aoff = lds_byte(wr * 64 + fr, fq * 8), boff = lds_byte(wc * 32 + fr, fq * 8);
#define PG8_SA(b, h) (((b) * 2 + (h)) * HTB)
#define PG8_SB(b, h) ((4 + (b) * 2 + (h)) * HTB)
#define PG8_STAGE(bufoff, gbase, voff) do { _Pragma("unroll") for (int _i = 0; _i < 2; ++_i) \
        __builtin_amdgcn_global_load_lds((const unsigned*)((const char*)(gbase) + (voff)[_i]), (PG8_LAS unsigned*)(lds + (bufoff) + ldsw + _i * 8192), 16, 0, 0); } while (0)
#define PG8_LDA(dst, b, h) do { _Pragma("unroll") for (int m = 0; m < 4; ++m) _Pragma("unroll") for (int k = 0; k < 2; ++k) dst[m][k] = *(const PG8_LAS bf16x8*)(lds + PG8_SA(b, h) + aoff + m * 2048 + k * 1024); } while (0)
#define PG8_LDB(dst, b, h) do { _Pragma("unroll") for (int n = 0; n < 2; ++n) _Pragma("unroll") for (int k = 0; k < 2; ++k) dst[n][k] = *(const PG8_LAS bf16x8*)(lds + PG8_SB(b, h) + boff + n * 2048 + k * 1024); } while (0)
#define PG8_MMA(ai, bj, At, Bt) do { __builtin_amdgcn_s_setprio(1); _Pragma("unroll") for (int m = 0; m < 4; ++m) _Pragma("unroll") for (int n = 0; n < 2; ++n) _Pragma("unroll") for (int k = 0; k < 2; ++k) \
        acc[ai][bj][m][n] = __builtin_amdgcn_mfma_f32_16x16x32_bf16(Bt[n][k], At[m][k], acc[ai][bj][m][n], 0, 0, 0); __builtin_amdgcn_s_setprio(0); } while (0)
#define PG8_WAIT_V(n) asm volatile("s_waitcnt vmcnt(" #n ")" ::: "memory")
#define PG8_WAIT_L(n) asm volatile("s_waitcnt lgkmcnt(" #n ")" ::: "memory")
#define PG8_BAR __builtin_amdgcn_s_barrier()
#define PG8_SCHED __builtin_amdgcn_sched_barrier(0)
    Unit cur, nxt; int ui = 0;
    if (!S.next(0, cur)) return;
    f32x4 acc[2][2][4][2];
#pragma unroll
    for (int a = 0; a < 2; ++a)
#pragma unroll
        for (int b = 0; b < 2; ++b)
#pragma unroll
            for (int m = 0; m < 4; ++m)
#pragma unroll
                for (int n = 0; n < 2; ++n) acc[a][b][m][n] = (f32x4){0.f, 0.f, 0.f, 0.f};
    bf16x8 At[4][2], B0[2][2], B1[2][2];
    const char* cA = (const char*)g.A + (size_t)cur.pm * tstep; const char* cB = (const char*)g.Bt + (size_t)cur.pn * tstep;
    S.a_ready(cur);
    if constexpr (SP2) {
        PG8_STAGE(PG8_SB(0, 0), cB, voffB); PG8_STAGE(PG8_SB(0, 1), cB + hstep, voffB); PG8_STAGE(PG8_SA(0, 0), cA, voffA); PG8_STAGE(PG8_SA(0, 1), cA + hstep, voffA);
        if (wr == 1) PG8_BAR;
        PG8_WAIT_V(2); PG8_BAR;
        PG8_STAGE(PG8_SB(1, 0), cB + kstep, voffB); PG8_STAGE(PG8_SA(1, 0), cA + kstep, voffA); PG8_STAGE(PG8_SB(1, 1), cB + hstep + kstep, voffB);
        PG8_WAIT_V(6); PG8_BAR;
    } else {
        PG8_STAGE(PG8_SB(0, 0), cB, voffB); PG8_STAGE(PG8_SA(0, 0), cA, voffA); PG8_STAGE(PG8_SB(0, 1), cB + hstep, voffB); PG8_STAGE(PG8_SA(0, 1), cA + hstep, voffA);
        if (wr == 1) PG8_BAR;
        PG8_WAIT_V(4); PG8_BAR;
        PG8_STAGE(PG8_SB(1, 0), cB + kstep, voffB); PG8_STAGE(PG8_SA(1, 0), cA + kstep, voffA); PG8_STAGE(PG8_SB(1, 1), cB + hstep + kstep, voffB);
        PG8_WAIT_V(6); PG8_BAR;
    }
    for (;;) {
        const bool has_next = S.next(ui + 1, nxt);
        const char* nA = has_next ? (const char*)g.A + (size_t)nxt.pm * tstep : cA; const char* nB = has_next ? (const char*)g.Bt + (size_t)nxt.pn * tstep : cB;
        for (int t = 0; t < nt; t += 2) {
            const bool last = (t == nt - 2);
            const char* a1 = cA + (size_t)(t + 1) * kstep;
            const char* a2 = last ? nA : cA + (size_t)(t + 2) * kstep; const char* b2 = last ? nB : cB + (size_t)(t + 2) * kstep;
            const char* a3 = a2 + kstep; const char* b3 = b2 + kstep;
            if (last && has_next) S.a_ready(nxt);
            if constexpr (SP2) {
            PG8_LDB(B0, 0, 0); PG8_LDB(B1, 0, 1); PG8_SCHED; PG8_LDA(At, 0, 0); PG8_STAGE(PG8_SA(1, 1), a1 + hstep, voffA);
            PG8_WAIT_V(8); PG8_WAIT_L(0); PG8_BAR; PG8_MMA(0, 0, At, B0); PG8_MMA(0, 1, At, B1); PG8_BAR; PG8_SCHED;
            PG8_LDA(At, 0, 1); PG8_STAGE(PG8_SB(0, 0), b2, voffB); PG8_STAGE(PG8_SB(0, 1), b2 + hstep, voffB); PG8_STAGE(PG8_SA(0, 0), a2, voffA);
            PG8_WAIT_V(8); PG8_WAIT_L(0); PG8_BAR; PG8_MMA(1, 0, At, B0); PG8_MMA(1, 1, At, B1); PG8_BAR; PG8_SCHED;
            PG8_LDB(B0, 1, 0); PG8_LDB(B1, 1, 1); PG8_SCHED; PG8_LDA(At, 1, 0); PG8_STAGE(PG8_SA(0, 1), a2 + hstep, voffA);
            PG8_WAIT_V(8); PG8_WAIT_L(0); PG8_BAR; PG8_MMA(0, 0, At, B0); PG8_MMA(0, 1, At, B1); PG8_BAR; PG8_SCHED;
            PG8_LDA(At, 1, 1); PG8_STAGE(PG8_SB(1, 0), b3, voffB); PG8_STAGE(PG8_SB(1, 1), b3 + hstep, voffB); PG8_STAGE(PG8_SA(1, 0), a3, voffA);
            PG8_WAIT_V(8); PG8_WAIT_L(0); PG8_BAR; PG8_MMA(1, 0, At, B0); PG8_MMA(1, 1, At, B1); PG8_BAR; PG8_SCHED;
            } else {
            PG8_LDB(B0, 0, 0); PG8_SCHED; PG8_LDA(At, 0, 0); PG8_STAGE(PG8_SA(1, 1), a1 + hstep, voffA);
            PG8_WAIT_L(8); PG8_BAR; PG8_WAIT_L(0); PG8_MMA(0, 0, At, B0); PG8_BAR; PG8_SCHED;
            PG8_LDB(B1, 0, 1); PG8_STAGE(PG8_SB(0, 0), b2, voffB);
            PG8_BAR; PG8_WAIT_L(0); PG8_MMA(0, 1, At, B1); PG8_BAR;
            PG8_LDA(At, 0, 1); PG8_STAGE(PG8_SA(0, 0), a2, voffA);
            PG8_BAR; PG8_WAIT_L(0); PG8_MMA(1, 0, At, B0); PG8_BAR; PG8_SCHED;
            PG8_STAGE(PG8_SB(0, 1), b2 + hstep, voffB);
            PG8_WAIT_V(6); PG8_BAR; PG8_MMA(1, 1, At, B1); PG8_BAR;
            PG8_LDB(B0, 1, 0); PG8_SCHED; PG8_LDA(At, 1, 0); PG8_STAGE(PG8_SA(0, 1), a2 + hstep, voffA);
            PG8_WAIT_L(8); PG8_BAR; PG8_WAIT_L(0); PG8_MMA(0, 0, At, B0); PG8_BAR; PG8_SCHED;
            PG8_LDB(B1, 1, 1); PG8_STAGE(PG8_SB(1, 0), b3, voffB);
            PG8_BAR; PG8_WAIT_L(0); PG8_MMA(0, 1, At, B1); PG8_BAR;
            PG8_LDA(At, 1, 1); PG8_STAGE(PG8_SA(1, 0), a3, voffA);
            PG8_BAR; PG8_WAIT_L(0); PG8_MMA(1, 0, At, B0); PG8_BAR; PG8_SCHED;
            PG8_STAGE(PG8_SB(1, 1), b3 + hstep, voffB);
            PG8_WAIT_V(6); PG8_BAR; PG8_MMA(1, 1, At, B1); PG8_BAR;
            }
        }
        if constexpr (ALIGN_EPI) { if (wr == 0) PG8_BAR; }
        if constexpr (!Epi::AFTER_DRAIN) { E(acc, cur, wr, wc, fr, fq); S.done(cur); }
        if (!has_next) break;
#pragma unroll
        for (int a = 0; a < 2; ++a)
#pragma unroll
            for (int b = 0; b < 2; ++b)
#pragma unroll
                for (int m = 0; m < 4; ++m)
#pragma unroll
                    for (int n = 0; n < 2; ++n) acc[a][b][m][n] = (f32x4){0.f, 0.f, 0.f, 0.f};
        cur = nxt; cA = nA; cB = nB; ++ui;
        if constexpr (ALIGN_EPI) { if (wr == 1) PG8_BAR; }
    }
    PG8_WAIT_V(0);
    if constexpr (!ALIGN_EPI) { if (wr == 0) PG8_BAR; }
    PG8_BAR;
    if constexpr (Epi::AFTER_DRAIN) { E.fused(acc, cur, wr, wc, fr, fq, lds, wid, lane); S.done(cur); }
#undef PG8_SA
#undef PG8_SB
#undef PG8_STAGE
#undef PG8_LDA
#undef PG8_LDB
#undef PG8_MMA
#undef PG8_WAIT_V
#undef PG8_WAIT_L
#undef PG8_BAR
#undef PG8_SCHED
}
}
#include <hip/hip_bf16.h>
#include <cmath>
namespace attn_body {
using bf16=__hip_bfloat16;
using bf16x8=__attribute__((ext_vector_type(8)))short;
using s16x4=__attribute__((ext_vector_type(4)))short;
using f32x16=__attribute__((ext_vector_type(16)))float;
using u32x4=__attribute__((ext_vector_type(4)))unsigned;
constexpr int BATCH=4,NHEAD=8,SEQ=8192,D=64,HP=3584,OP=1024;
constexpr int NW=8,QBLK=32,QB=QBLK*NW,KVBLK=64,NQB=SEQ/QB;
constexpr int ATTN_UNIT_ROWS=QB;
__device__ __forceinline__ int crow(int r,int hi){return (r&3)+8*(r>>2)+4*hi;}
#define SBAR() __builtin_amdgcn_sched_barrier(0)
__device__ __forceinline__ void cmask(f32x16&p0,f32x16&p1,int jb,int qrel,int hi){
  const float NEG=-INFINITY; int kb=64*jb+4*hi;
  #pragma unroll
  for(int r=0;r<16;++r){int kv=kb+(r&3)+8*(r>>2); if(kv>qrel)p0[r]=NEG; if(kv+32>qrel)p1[r]=NEG;}
}

constexpr int NSLOT=3, SLOTB=8192;
constexpr int LDS_K=0, LDS_V=NSLOT*SLOTB, LDS_WS=2*NSLOT*SLOTB, LDS_OST=LDS_WS+NW*64*4, LDS_BIAS=LDS_OST+NW*4096, LDS_BYTES=LDS_BIAS+SEQ*4;
constexpr float C2=0.125f*1.4426950408889634f;
__device__ __forceinline__ void glds16(const void*gsrc,unsigned lds_dst){unsigned keep;
  asm volatile("s_mov_b32 %0, m0\n\ts_mov_b32 m0, %2\n\ts_nop 0\n\tglobal_load_lds_dwordx4 %1, off\n\ts_mov_b32 m0, %0":"=&s"(keep):"v"(gsrc),"s"(lds_dst):"memory");}
__device__ __forceinline__ float max3f(float a,float b,float c){float r;asm("v_max3_f32 %0, %1, %2, %3":"=v"(r):"v"(a),"v"(b),"v"(c));return r;}
__device__ __forceinline__ float max2f(float a,float b){float r;asm("v_max_f32_e32 %0, %1, %2":"=v"(r):"v"(a),"v"(b));return r;}
__device__ __forceinline__ float fadd_s(float a,float b){float r;asm("v_add_f32_e32 %0, %1, %2":"=v"(r):"v"(a),"v"(b));return r;}
__device__ __forceinline__ float fsub_s(float a,float b){float r;asm("v_sub_f32_e32 %0, %1, %2":"=v"(r):"v"(a),"v"(b));return r;}
typedef float f32x2_t __attribute__((ext_vector_type(2))); typedef __bf16 bf16x2_t __attribute__((ext_vector_type(2)));
__device__ __forceinline__ unsigned cvtpk_s(float lo,float hi){f32x2_t v={lo,hi};bf16x2_t b=__builtin_convertvector(v,bf16x2_t);return __builtin_bit_cast(unsigned,b);}
#define WAIT_BAR(N) asm volatile("s_waitcnt vmcnt(" #N ") lgkmcnt(0)\n\ts_barrier":::"memory")

__device__ __forceinline__ void qkt(f32x16&p0,f32x16&p1,const char*Kslot,const bf16x8*qr,const f32x16&negm,int r32,int hi){
  const char*kb=Kslot+hi*1024+r32*16;
  #pragma unroll
  for(int d0=0;d0<4;++d0){
    const bf16x8 b0=*reinterpret_cast<const bf16x8*>(kb+d0*2048);
    const bf16x8 b1=*reinterpret_cast<const bf16x8*>(kb+d0*2048+512);
    if(d0==0){p0=__builtin_amdgcn_mfma_f32_32x32x16_bf16(b0,qr[0],negm,0,0,0);p1=__builtin_amdgcn_mfma_f32_32x32x16_bf16(b1,qr[0],negm,0,0,0);}
    else{p0=__builtin_amdgcn_mfma_f32_32x32x16_bf16(b0,qr[d0],p0,0,0,0);p1=__builtin_amdgcn_mfma_f32_32x32x16_bf16(b1,qr[d0],p1,0,0,0);}}
}
typedef __attribute__((address_space(3))) const char* lds_cptr;
typedef short v4i16_t __attribute__((ext_vector_type(4)));
__device__ __forceinline__ void kload8(bf16x8*kf,lds_cptr kp){
  kf[0]=*(const __attribute__((address_space(3))) bf16x8*)(kp);      kf[1]=*(const __attribute__((address_space(3))) bf16x8*)(kp+512);
  kf[2]=*(const __attribute__((address_space(3))) bf16x8*)(kp+2048); kf[3]=*(const __attribute__((address_space(3))) bf16x8*)(kp+2560);
  kf[4]=*(const __attribute__((address_space(3))) bf16x8*)(kp+4096); kf[5]=*(const __attribute__((address_space(3))) bf16x8*)(kp+4608);
  kf[6]=*(const __attribute__((address_space(3))) bf16x8*)(kp+6144); kf[7]=*(const __attribute__((address_space(3))) bf16x8*)(kp+6656);
}
__device__ __forceinline__ void kload2(bf16x8*kf,lds_cptr kp,int j){ kf[2*j]=*(const __attribute__((address_space(3))) bf16x8*)(kp+j*2048); kf[2*j+1]=*(const __attribute__((address_space(3))) bf16x8*)(kp+j*2048+512); }
__device__ __forceinline__ s16x4 vtr(lds_cptr p){ return __builtin_bit_cast(s16x4,__builtin_amdgcn_ds_read_tr16_b64_v4i16((__attribute__((address_space(3))) v4i16_t*)p)); }
__device__ __forceinline__ float rowmax(const f32x16&p0,const f32x16&p1){
  float a=max3f(p0[0],p0[1],p1[0]),b=max3f(p0[2],p0[3],p1[1]);a=max3f(a,p1[2],p1[3]);
  #pragma unroll
  for(int r=4;r<16;r+=4){a=max3f(a,p0[r],p0[r+1]);b=max3f(b,p0[r+2],p0[r+3]);a=max3f(a,p1[r],p1[r+1]);b=max3f(b,p1[r+2],p1[r+3]);}
  const float m=max2f(a,b);
  auto rr=__builtin_amdgcn_permlane32_swap(__float_as_uint(m),__float_as_uint(m),false,false);
  return max2f(__uint_as_float(rr[0]),__uint_as_float(rr[1]));
}
__device__ __forceinline__ void pv(f32x16*o,int vb,bf16x8 pa0,bf16x8 pa1,bf16x8 pa2,bf16x8 pa3){
  #pragma unroll
  for(int d0=0;d0<2;++d0){s16x4 lo[4],hi[4];
    #pragma unroll
    for(int ks=0;ks<4;++ks){
      asm volatile("ds_read_b64_tr_b16 %0,%1 offset:%c2":"=&v"(lo[ks]):"v"(vb),"i"(d0*4096+ks*1024):"memory");
      asm volatile("ds_read_b64_tr_b16 %0,%1 offset:%c2":"=&v"(hi[ks]):"v"(vb),"i"(d0*4096+ks*1024+512):"memory");}
    asm volatile("s_waitcnt lgkmcnt(0)":::"memory");SBAR();
    #define PK(k) (bf16x8){lo[k][0],lo[k][1],lo[k][2],lo[k][3],hi[k][0],hi[k][1],hi[k][2],hi[k][3]}
    o[d0]=__builtin_amdgcn_mfma_f32_32x32x16_bf16(pa0,PK(0),o[d0],0,0,0);
    o[d0]=__builtin_amdgcn_mfma_f32_32x32x16_bf16(pa1,PK(1),o[d0],0,0,0);
    o[d0]=__builtin_amdgcn_mfma_f32_32x32x16_bf16(pa2,PK(2),o[d0],0,0,0);
    o[d0]=__builtin_amdgcn_mfma_f32_32x32x16_bf16(pa3,PK(3),o[d0],0,0,0);
    #undef PK
  }
}

#ifndef ATTN_STORE16
#define ATTN_STORE16(p,v) (*(u32x4*)(p)=(v))
#endif
constexpr float ATT_SKIP_LOG2=44.0f;
template<int THRL> __device__ __forceinline__ void attn_unit(int b,int h,int qb,const bf16*Q,const bf16*__restrict__ K,const bf16*__restrict__ V,bf16*O,const float*__restrict__ cum2,const float*__restrict__ qg,const float*__restrict__ kg,char*shm){
  int tid_l=threadIdx.x; asm volatile("":"+v"(tid_l)); const int tid=tid_l,lane=tid&63,r32=lane&31,hi=lane>>5; const int wid=__builtin_amdgcn_readfirstlane(tid>>6);
  const long rowbase=(long)b*SEQ; const int q0=qb*QB;
  const bf16*Qw=Q+(rowbase+q0+wid*QBLK)*HP+h*D;
  typedef float f32x4b __attribute__((ext_vector_type(4)));
  const float* cb=cum2+(long)(b*NHEAD+h)*SEQ; const float cref=cb[q0];
  f32x4b cpre[4];
  #pragma unroll
  for(int k_=0;k_<4;++k_){ const int i=tid*4+k_*NW*64*4; cpre[k_]=(i<q0+QB)?*(const f32x4b*)(cb+i):(f32x4b){0.f,0.f,0.f,0.f}; }
  bf16x8 qr[4];
  #pragma unroll
  for(int d0=0;d0<4;++d0)qr[d0]=*reinterpret_cast<const bf16x8*>(&Qw[(long)r32*HP+d0*16+hi*8]);
  int T0;
  { float gq=fabsf(qg[lane]),gk=fabsf(kg[lane]);
    #pragma unroll
    for(int o=1;o<64;o<<=1){gq=fmaxf(gq,__shfl_xor(gq,o));gk=fmaxf(gk,__shfl_xor(gk,o));}
    const float thresh=2.0f*(8.0f*1.4426950408889634f*1.02f*gq*gk)+ATT_SKIP_LOG2;
    const int ntf=(q0+QB)/KVBLK; const int j0=lane,j1=lane+64;
    const bool s0=(j0<ntf-4)&&(cref-cb[64*j0+63]<-thresh); const bool s1=(j1<ntf-4)&&(cref-cb[64*j1+63]<-thresh);
    const int nskip=__popcll(__ballot(s0))+__popcll(__ballot(s1));
    T0=__builtin_amdgcn_readfirstlane(nskip&~1); }
  const bf16*Kh=K+(rowbase+(long)T0*KVBLK)*HP+h*D,*Vh=V+(rowbase+(long)T0*KVBLK)*HP+h*D;
  const lds_cptr shm3=(lds_cptr)shm; const unsigned lds0=(unsigned)(uintptr_t)shm;
  float*wsf=(float*)(shm+LDS_WS)+wid*64;
  const bf16*ksrc=Kh+(long)lane*HP+wid*8;
  const bf16*vsrc=Vh+(long)(16*(wid&3)+(lane>>2))*HP+(wid>>2)*32+(lane&3)*8;
  const unsigned kdst=lds0+LDS_K+wid*1024, vdst=lds0+LDS_V+wid*1024;
  #define DMA_K(t,slot) glds16(ksrc+(long)(t)*KVBLK*HP,(unsigned)__builtin_amdgcn_readfirstlane(kdst+(slot)))
  #define DMA_V(t,slot) glds16(vsrc+(long)(t)*KVBLK*HP,(unsigned)__builtin_amdgcn_readfirstlane(vdst+(slot)))
  const int vb0=(int)(lds0+LDS_V)+((lane>>4)&1)*32+(lane&3)*8+(4*hi+((lane&15)>>2))*64;
  const char*Kbase=shm+LDS_K; bf16x8 kf[8];
  const lds_cptr kp0=shm3+LDS_K+hi*1024+r32*16; const lds_cptr vp0=shm3+LDS_V+((lane>>4)&1)*32+(lane&3)*8+(4*hi+((lane&15)>>2))*64;
  const int NT=(q0+QB)/KVBLK-T0;
  { __attribute__((address_space(3))) float* bl=(__attribute__((address_space(3))) float*)(shm3+LDS_BIAS);
    #pragma unroll
    for(int k_=0;k_<4;++k_){ const int i=tid*4+k_*NW*64*4; if(i<q0+QB){ const f32x4b c=cpre[k_]; *(__attribute__((address_space(3))) f32x4b*)(bl+i)=(f32x4b){cref-c[0],cref-c[1],cref-c[2],cref-c[3]}; } }
    asm volatile("s_waitcnt vmcnt(0) lgkmcnt(0)":::"memory"); }
  const __attribute__((address_space(3))) float* biasL=(const __attribute__((address_space(3))) float*)(shm3+LDS_BIAS)+T0*KVBLK+4*hi;
  #define BIASADD(C0,C1,t) do{ const __attribute__((address_space(3))) float* bp_=biasL+64*(t); \
    _Pragma("unroll") for(int j_=0;j_<4;++j_){ const f32x4b b0_=*(const __attribute__((address_space(3))) f32x4b*)(bp_+8*j_); const f32x4b b1_=*(const __attribute__((address_space(3))) f32x4b*)(bp_+32+8*j_); \
      C0[4*j_]+=b0_[0];C0[4*j_+1]+=b0_[1];C0[4*j_+2]+=b0_[2];C0[4*j_+3]+=b0_[3]; C1[4*j_]+=b1_[0];C1[4*j_+1]+=b1_[1];C1[4*j_+2]+=b1_[2];C1[4*j_+3]+=b1_[3]; SBAR(); } }while(0)
  DMA_K(0,0);DMA_V(0,0);DMA_K(1,SLOTB);
  const __attribute__((address_space(3))) bf16x8* qst=(const __attribute__((address_space(3))) bf16x8*)(shm3+LDS_OST+wid*4096+lane*16);
  #pragma unroll
  for(int d0=0;d0<4;++d0)*(__attribute__((address_space(3))) bf16x8*)(shm3+LDS_OST+wid*4096+lane*16+d0*1024)=qr[d0];
  #define QLD(d) (qst[(d)*64])
  float mhat=0.f,l_reg=0.f;f32x16 o[2];o[0]=f32x16{};o[1]=f32x16{};f32x16 negm=f32x16{};asm volatile("":"+v"(negm));
  const int qrel=wid*QBLK+r32;
  #define CMASK(P0,P1,t) do{int jb_=(t)-(NT-4); if(jb_>=0)cmask(P0,P1,jb_,qrel,hi);}while(0)
  bool resc=false;
  #define START(P0,P1) do{ const float rm=*(const __attribute__((address_space(3))) float*)(shm3+LDS_BIAS+4*(q0+qrel)); resc=false; \
    { const float dl=rm; mhat=fadd_s(mhat,dl); \
      _Pragma("unroll") for(int r=0;r<16;++r){P0[r]=fsub_s(P0[r],dl);P1[r]=fsub_s(P1[r],dl);} \
      _Pragma("unroll") for(int r=0;r<16;++r)negm[r]=-mhat; asm volatile("":"+v"(negm)); } \
    _Pragma("unroll") for(int r=0;r<16;++r)P0[r]=__builtin_amdgcn_exp2f(P0[r]); }while(0)
  #define RESC() do{ if(resc){ asm volatile("s_waitcnt lgkmcnt(0)":::"memory"); \
      _Pragma("unroll") for(int d_=0;d_<2;++d_) _Pragma("unroll") for(int r=0;r<16;++r)o[d_][r]*=wsf[crow(r,hi)]; } }while(0)
  f32x16 pA0,pA1,pB0,pB1;
  int sl_prev=0,sl_cur=0,sl_next=SLOTB;
  #define ROT() do{sl_prev=sl_cur;sl_cur=sl_next;sl_next=(sl_next==(NSLOT-1)*SLOTB)?0:sl_next+SLOTB;}while(0)
  DMA_K(2,2*SLOTB);
  WAIT_BAR(3);
  qkt(pA0,pA1,Kbase,qr,negm,r32,hi);asm volatile("s_nop 15\n\ts_nop 7":"+v"(pA0),"+v"(pA1));BIASADD(pA0,pA1,0);CMASK(pA0,pA1,0);
  START(pA0,pA1);
  _Pragma("unroll") for(int r=0;r<16;++r)pA1[r]=__builtin_amdgcn_exp2f(pA1[r]);
  WAIT_BAR(0);
  DMA_K(3,0);DMA_V(1,SLOTB);
  ROT();
  kload8(kf,kp0+sl_cur);
  WAIT_BAR(2);
  s16x4 vlo[8],vhi[8]; u32x4 pw0,pw1,pw2,pw3;
  #define PKW(P,B) cvtpk_s(P[B],P[B+1])
  #define PAF(k) __builtin_bit_cast(bf16x8,pw##k)
  #define VFR(i) (bf16x8){vlo[i][0],vlo[i][1],vlo[i][2],vlo[i][3],vhi[i][0],vhi[i][1],vhi[i][2],vhi[i][3]}
  #define PIN(x) asm volatile("":"+v"(x))
  #define MX3(a,b,c) __builtin_fmaxf(__builtin_fmaxf((a),(b)),(c))
  #define GAPA(MF,A0,A1,A2,A3,W0,W1,PW) do{ MF; sacc+=A0; sacc+=A1; sacc+=A2; sacc+=A3; PIN(sacc); W0; W1; PIN(PW); SBAR(); }while(0)
  #define EX(v) __builtin_amdgcn_exp2f(v)
  #define GAPB(MF,X,B) do{ MF; X[B]=EX(X[B]); X[B+1]=EX(X[B+1]); X[B+2]=EX(X[B+2]); X[B+3]=EX(X[B+3]); PIN(X); SBAR(); }while(0)
  #define VRD(i) do{ vlo[i]=vtr(vp_+(((i)>>2)*4096+((i)&3)*1024)); vhi[i]=vtr(vp_+(((i)>>2)*4096+((i)&3)*1024+512)); }while(0)
  #define KRD(G,j) do{ if(G){ kload2(kf,kp0+sl_next,j); SBAR(); } }while(0)
  #define STEP(C0,C1,P0,P1,t,GK,GV,GL) do{ SBAR(); \
    const lds_cptr vp_=vp0+sl_prev; \
    bf16x8 qa_=QLD(0), qb_=QLD(1); VRD(0); SBAR(); float sacc=(P0[0]+P0[1]); \
    GAPA(C0=__builtin_amdgcn_mfma_f32_32x32x16_bf16(kf[0],qa_,negm,0,0,0), P0[2],P0[3],P0[4],P0[5],     pw0[0]=PKW(P0,0), pw0[1]=PKW(P0,2), pw0); \
    VRD(4); SBAR(); GAPA(C1=__builtin_amdgcn_mfma_f32_32x32x16_bf16(kf[1],qa_,negm,0,0,0), P0[6],P0[7],P0[8],P0[9],     pw0[2]=PKW(P0,4), pw0[3]=PKW(P0,6), pw0); \
    qa_=QLD(2); VRD(1); SBAR(); GAPA(C0=__builtin_amdgcn_mfma_f32_32x32x16_bf16(kf[2],qb_,C0,0,0,0),   P0[10],P0[11],P0[12],P0[13], pw1[0]=PKW(P0,8), pw1[1]=PKW(P0,10), pw1); \
    VRD(5); SBAR(); GAPA(C1=__builtin_amdgcn_mfma_f32_32x32x16_bf16(kf[3],qb_,C1,0,0,0),   P0[14],P0[15],P1[0],P1[1],   pw1[2]=PKW(P0,12),pw1[3]=PKW(P0,14), pw1); \
    qb_=QLD(3); VRD(2); SBAR(); GAPA(C0=__builtin_amdgcn_mfma_f32_32x32x16_bf16(kf[4],qa_,C0,0,0,0),   P1[2],P1[3],P1[4],P1[5],     pw2[0]=PKW(P1,0), pw2[1]=PKW(P1,2), pw2); \
    VRD(6); SBAR(); GAPA(C1=__builtin_amdgcn_mfma_f32_32x32x16_bf16(kf[5],qa_,C1,0,0,0),   P1[6],P1[7],P1[8],P1[9],     pw2[2]=PKW(P1,4), pw2[3]=PKW(P1,6), pw2); \
    VRD(3); SBAR(); GAPA(C0=__builtin_amdgcn_mfma_f32_32x32x16_bf16(kf[6],qb_,C0,0,0,0),   P1[10],P1[11],P1[12],P1[13], pw3[0]=PKW(P1,8), pw3[1]=PKW(P1,10), pw3); \
    VRD(7); SBAR(); GAPA(C1=__builtin_amdgcn_mfma_f32_32x32x16_bf16(kf[7],qb_,C1,0,0,0),   P1[14],P1[15],0.f,0.f,       pw3[2]=PKW(P1,12),pw3[3]=PKW(P1,14), pw3); \
    l_reg+=sacc; \
    if(GK){DMA_K((t)+3,sl_cur);} if(GV){DMA_V((t)+1,sl_next);} \
    BIASADD(C0,C1,t); CMASK(C0,C1,t); \
    { float a=MX3(C0[0],C0[1],C1[0]),b=MX3(C0[2],C0[3],C1[1]); a=MX3(a,C1[2],C1[3]); \
      _Pragma("unroll") for(int r=4;r<16;r+=4){a=MX3(a,C0[r],C0[r+1]);b=MX3(b,C0[r+2],C0[r+3]);a=MX3(a,C1[r],C1[r+1]);b=MX3(b,C1[r+2],C1[r+3]);} \
      float rm=__builtin_fmaxf(a,b); { auto rr=__builtin_amdgcn_permlane32_swap(__float_as_uint(rm),__float_as_uint(rm),false,false); rm=__builtin_fmaxf(__uint_as_float(rr[0]),__uint_as_float(rr[1])); } \
      resc=false; \
      if(__builtin_expect(__any(rm>(float)THRL),0)){ const float dl=__builtin_fmaxf(rm,0.f); mhat+=dl; \
        _Pragma("unroll") for(int r=0;r<16;++r){C0[r]-=dl;C1[r]-=dl;} \
        _Pragma("unroll") for(int r=0;r<16;++r)negm[r]=-mhat; asm volatile("":"+v"(negm)); \
        const float f=__builtin_amdgcn_exp2f(-dl); l_reg*=f; if(hi==0)wsf[r32]=f; resc=true; } } \
    SBAR(); \
    GAPB(o[0]=__builtin_amdgcn_mfma_f32_32x32x16_bf16(PAF(0),VFR(0),o[0],0,0,0), C0,0); \
    GAPB(o[1]=__builtin_amdgcn_mfma_f32_32x32x16_bf16(PAF(0),VFR(4),o[1],0,0,0), C0,4); \
    KRD(GL,0); GAPB(o[0]=__builtin_amdgcn_mfma_f32_32x32x16_bf16(PAF(1),VFR(1),o[0],0,0,0), C0,8); \
    KRD(GL,1); GAPB(o[1]=__builtin_amdgcn_mfma_f32_32x32x16_bf16(PAF(1),VFR(5),o[1],0,0,0), C0,12); \
    KRD(GL,2); GAPB(o[0]=__builtin_amdgcn_mfma_f32_32x32x16_bf16(PAF(2),VFR(2),o[0],0,0,0), C1,0); \
    KRD(GL,3); GAPB(o[1]=__builtin_amdgcn_mfma_f32_32x32x16_bf16(PAF(2),VFR(6),o[1],0,0,0), C1,4); \
    GAPB(o[0]=__builtin_amdgcn_mfma_f32_32x32x16_bf16(PAF(3),VFR(3),o[0],0,0,0), C1,8); \
    GAPB(o[1]=__builtin_amdgcn_mfma_f32_32x32x16_bf16(PAF(3),VFR(7),o[1],0,0,0), C1,12); \
    }while(0)
  int t=1;
  #undef CMASK
  #define CMASK(P0,P1,t) do{}while(0)
  for(;t+5<NT;t+=2){
    STEP(pB0,pB1,pA0,pA1,t,true,true,true);     WAIT_BAR(2); RESC(); ROT();
    STEP(pA0,pA1,pB0,pB1,t+1,true,true,true);   WAIT_BAR(2); RESC(); ROT();
  }
  #undef CMASK
  #define CMASK(P0,P1,t) do{int jb_=(t)-(NT-4); if(jb_>=0)cmask(P0,P1,jb_,qrel,hi);}while(0)
  #define ENDW(tt) do{ if((tt)+3<NT){WAIT_BAR(2);} else if((tt)+2<NT){WAIT_BAR(1);} else {WAIT_BAR(0);} }while(0)
  for(;t+1<NT;t+=2){
    STEP(pB0,pB1,pA0,pA1,t,(t+3<NT),(t+1<NT),(t+1<NT));       ENDW(t);   RESC(); ROT();
    STEP(pA0,pA1,pB0,pB1,t+1,(t+4<NT),(t+2<NT),(t+2<NT));     ENDW(t+1); RESC(); ROT();
  }
  STEP(pB0,pB1,pA0,pA1,NT-1,false,false,false); RESC();
  { float sacc=pB0[0]+pB0[1]; _Pragma("unroll") for(int r=2;r<16;++r)sacc+=pB0[r]; _Pragma("unroll") for(int r=0;r<16;++r)sacc+=pB1[r]; l_reg+=sacc;
    pw0=(u32x4){PKW(pB0,0),PKW(pB0,2),PKW(pB0,4),PKW(pB0,6)};pw1=(u32x4){PKW(pB0,8),PKW(pB0,10),PKW(pB0,12),PKW(pB0,14)};pw2=(u32x4){PKW(pB1,0),PKW(pB1,2),PKW(pB1,4),PKW(pB1,6)};pw3=(u32x4){PKW(pB1,8),PKW(pB1,10),PKW(pB1,12),PKW(pB1,14)};
    SBAR(); pv(o,vb0+sl_cur,PAF(0),PAF(1),PAF(2),PAF(3)); }
  #undef PKW
  #undef PAF
  #undef VFR
  #undef PIN
  #undef MX3
  #undef GAPA
  #undef GAPB
  #undef EX
  #undef VRD
  #undef KRD
  #undef STEP
  #undef ENDW
  {auto rr=__builtin_amdgcn_permlane32_swap(__float_as_uint(l_reg),__float_as_uint(l_reg),false,false);l_reg=__uint_as_float(rr[0])+__uint_as_float(rr[1]);}
  if(hi==0)wsf[32+r32]=l_reg;asm volatile("s_waitcnt lgkmcnt(0)":::"memory");
  float rli[16];
  #pragma unroll
  for(int r=0;r<16;++r)rli[r]=__builtin_amdgcn_rcpf(wsf[32+crow(r,hi)]);
  bf16*Ow=O+(rowbase+q0+wid*QBLK)*OP+h*D;
  { bf16*stg=(bf16*)(shm+LDS_OST)+wid*2048;
    #pragma unroll
    for(int r=0;r<16;++r){const int orow=crow(r,hi);
      #pragma unroll
      for(int d0=0;d0<2;++d0)stg[orow*64+d0*32+r32]=__float2bfloat16(o[d0][r]*rli[r]);}
    asm volatile("s_waitcnt lgkmcnt(0)":::"memory");
    #pragma unroll
    for(int i=0;i<4;++i){const int row=i*8+(lane>>3),ch=lane&7; const u32x4 v=*(const u32x4*)(stg+row*64+ch*8); ATTN_STORE16(Ow+(long)row*OP+ch*8,v);} }
  asm volatile("s_waitcnt lgkmcnt(0)\n\ts_barrier":::"memory");
  #undef DMA_K
  #undef DMA_V
  #undef BIASADD
  #undef QLD
  #undef CMASK
  #undef START
  #undef RESC
  #undef ROT
}
constexpr int ATTN_LDS_BYTES=LDS_BYTES;
struct AttnTensors { const bf16* Q; const bf16* K; const bf16* V; bf16* O; const float* cum2; const float* qg; const float* kg; };
struct AttnUnit { int bh; int qb; };
struct StaticOrder {
  int vcu, G;
  __device__ __forceinline__ explicit StaticOrder(int grid,int block):vcu((grid%8==0)?(block%8)*(grid/8)+block/8:block),G(grid){}
  __device__ __forceinline__ bool next(int i,AttnUnit&u)const{
    if(G==256){ if(i>=4)return false; const int s=vcu&7; u.bh=vcu>>3; u.qb=(i==0)?s:(i==1)?15-s:(i==2)?16+s:31-s; return true; }
    const int j=vcu+i*G; if(j>=BATCH*NHEAD*NQB)return false; u.bh=j/NQB; const int q=j%NQB; u.qb=(q&1)?(NQB-1-(q>>1)):(q>>1); return true; }
  __device__ __forceinline__ void a_ready(const AttnUnit&)const{}
  __device__ __forceinline__ void done(const AttnUnit&)const{}
};
template<class Sched,int THRL=8> __device__ __forceinline__ void attn_phase(char*lds,const AttnTensors&T,const Sched&S){
  AttnUnit u;
  for(int i=0;S.next(i,u);++i){ S.a_ready(u); attn_unit<THRL>(u.bh/NHEAD,u.bh%NHEAD,u.qb,T.Q,T.K,T.V,T.O,T.cum2,T.qg,T.kg,lds); S.done(u); }
}
#undef SBAR
#undef WAIT_BAR
}
#include <hip/hip_cooperative_groups.h>
namespace cg = cooperative_groups;
#define LAS __attribute__((address_space(3)))
typedef unsigned short bf16;
typedef unsigned v4u __attribute__((ext_vector_type(4)));
typedef float f32x4 __attribute__((ext_vector_type(4)));
typedef short bf16x8 __attribute__((ext_vector_type(8)));
typedef unsigned short u16x8 __attribute__((ext_vector_type(8)));
constexpr int NWAVES = 8;
constexpr int M = 32768, DM = 1024, SEQL = 8192, DFF = 2816, NFF = 5632, NMIX = 3336, HPITCH = 3584, DEPTH = 2;
constexpr size_t MiB = 1u << 20;
constexpr size_t WS_QCTR = 3 * MiB, WS_BAR = 3 * MiB + 65536, WS_CTL_ZERO = 131072, WS_FOXC = 1 * MiB, WS_DEC = 2 * MiB, WS_W = 4 * MiB, W_LAYER = 42 * MiB;
constexpr size_t WO_1IN = 0, WO_1OUT = 11 * MiB, WO_MIX = 16 * MiB + MiB / 2, WO_MO = 23 * MiB + MiB / 2, WO_2IN = 25 * MiB + MiB / 2, WO_2OUT = 36 * MiB + MiB / 2;
constexpr size_t WS_XB = 88 * MiB, WS_HACT = 152 * MiB, WS_Y = 376 * MiB, WS_HST = 440 * MiB, WS_RS = 472 * MiB, WS_END = 474 * MiB;
constexpr int LDS_BYTES = 147456;
static_assert(attn_body::LDS_BYTES <= 131072, "attention LDS");

__device__ __forceinline__ unsigned f2bf(float f) { unsigned u = __builtin_bit_cast(unsigned, f); return (u + 0x7fffu + ((u >> 16) & 1u)) >> 16; }
__device__ __forceinline__ unsigned pk2(float lo, float hi) { return f2bf(lo) | (f2bf(hi) << 16); }
__device__ __forceinline__ float bf2f(unsigned short b) { return __builtin_bit_cast(float, (unsigned)b << 16); }
__device__ __forceinline__ float wave_sum(float v) {
#pragma unroll
    for (int o = 1; o < 64; o <<= 1) v += __shfl_xor(v, o);
    return v;
}
#define LDS_WAIT() asm volatile("s_waitcnt lgkmcnt(0)" ::: "memory")

__device__ __forceinline__ int dst_row(int mode, int c) {
    if (mode == 1) { const int half = c / DFF, j = c - half * DFF; return 256 * (j >> 7) + 128 * half + (j & 127); }
    if (mode == 2) { const int pn = c >> 8, w = c & 255; return 256 * pn + 128 * ((w & 63) >> 5) + 32 * (w >> 6) + (w & 31); }
    return c;
}
__device__ __forceinline__ void tr_item(const float* W, int K, int N, int nblk, const float* gain, bf16* WT, int mode, LAS float* scr, int item, int lane) {
    const int kb = item / nblk, nb = item % nblk, k0 = 64 * kb, n0 = 32 * nb;
    const int c = n0 + (lane & 31);
    float wv[32];
#pragma unroll
    for (int i = 0; i < 32; ++i) { const int kk = 2 * i + (lane >> 5); wv[i] = (c < N) ? __builtin_nontemporal_load(W + (size_t)(k0 + kk) * N + c) : 0.f;     }
    if (gain) {
#pragma unroll
        for (int i = 0; i < 32; ++i) wv[i] *= gain[k0 + 2 * i + (lane >> 5)]; }
#pragma unroll
    for (int i = 0; i < 32; ++i) scr[(2 * i + (lane >> 5)) * 33 + (lane & 31)] = wv[i];
    LDS_WAIT(); asm volatile("" ::: "memory");
    const int c8 = lane & 7;
#pragma unroll
    for (int j = 0; j < 4; ++j) { const int n = (lane >> 3) + 8 * j; const LAS float* s = scr + (8 * c8) * 33 + n;
        v4u o; o.x = pk2(s[0 * 33], s[1 * 33]); o.y = pk2(s[2 * 33], s[3 * 33]); o.z = pk2(s[4 * 33], s[5 * 33]); o.w = pk2(s[6 * 33], s[7 * 33]);
        *(v4u*)(WT + (size_t)dst_row(mode, n0 + n) * K + k0 + 8 * c8) = o; }
    LDS_WAIT(); asm volatile("" ::: "memory");
}

#define XB_TMO      128
#define XB_XCNT(j)  (256  + 64 * (j))
#define XB_XSUB(j)  (1280 + 64 * (j))
#define XB_XGEN(j)  (2304 + 64 * (j))
#define XB_TOP      3328
#define XB_TOPGEN   3392
#define XCD_BAR_WORDS 3456
#define XB_SPIN_CAP (1u << 18)

__device__ __forceinline__ unsigned xb_ld(unsigned* p)              { return __hip_atomic_load(p, __ATOMIC_RELAXED, __HIP_MEMORY_SCOPE_AGENT); }
__device__ __forceinline__ unsigned xb_add(unsigned* p, unsigned v) { return __hip_atomic_fetch_add(p, v, __ATOMIC_RELAXED, __HIP_MEMORY_SCOPE_AGENT); }
__device__ __forceinline__ unsigned xb_xcc_id() { return (unsigned)__builtin_amdgcn_s_getreg((3 << 11) | 20) & 0xFu; }
#define XB_SPIN(cond, bar) do { unsigned _sp = 0; while (cond) { __builtin_amdgcn_s_sleep(1); \
    if ((++_sp & 255u) == 0u) { if (xb_ld(&(bar)[XB_TMO])) break; if (_sp > XB_SPIN_CAP) { atomicAdd(&(bar)[XB_TMO], 1u); break; } } } } while (0)

struct XcdBarrier {
    unsigned* bar; unsigned x;
    volatile LAS unsigned* st;
};

__device__ __forceinline__ XcdBarrier xcd_barrier_post(unsigned* bar, volatile LAS unsigned* st) {
    XcdBarrier b; b.bar = bar; b.x = xb_xcc_id(); b.st = st;
    if (threadIdx.x == 0) (void)xb_add(&bar[XB_XCNT(b.x)], 1u);
    return b;
}
__device__ __forceinline__ void xcd_barrier_complete(unsigned* bar, unsigned x, unsigned& nloc, unsigned& nx) {
    const unsigned G = gridDim.x * gridDim.y * gridDim.z;
    unsigned sum, cnt, mine, sp = 0u;
    for (;;) {
        sum = 0u; cnt = 0u; mine = 0u;
#pragma unroll
        for (unsigned j = 0; j < 16; ++j) { const unsigned c = xb_ld(&bar[XB_XCNT(j)]); sum += c; cnt += (c > 0u) ? 1u : 0u; mine = (j == x) ? c : mine; }
        if (sum == G) break;
        __builtin_amdgcn_s_sleep(1);
        if ((++sp & 255u) == 0u) { if (xb_ld(&bar[XB_TMO])) break; if (sp > XB_SPIN_CAP) { atomicAdd(&bar[XB_TMO], 1u); break; } }
    }
    nloc = mine > 0u ? mine : 1u; nx = cnt > 0u ? cnt : 1u;
}

__device__ __forceinline__ void xcd_barrier(const XcdBarrier& b) {
    asm volatile("s_waitcnt vmcnt(0)" ::: "memory");
    __syncthreads();
    if (threadIdx.x == 0) {
        unsigned* bar = b.bar;
        __builtin_amdgcn_s_waitcnt(0);
        unsigned nloc = b.st[0], nx = b.st[1];
        if (nloc == 0u) { xcd_barrier_complete(bar, b.x, nloc, nx); b.st[0] = nloc; b.st[1] = nx; }
        const unsigned old = xb_add(&bar[XB_XSUB(b.x)], 1u);
        const unsigned gen = old / nloc;
        if (old + 1u == (gen + 1u) * nloc) {
            __builtin_amdgcn_fence(__ATOMIC_RELEASE, "agent");
            asm volatile("s_waitcnt vmcnt(0)" ::: "memory");
            const unsigned og = xb_add(&bar[XB_TOP], 1u);
            const unsigned tg = og / nx;
            if (og + 1u == (tg + 1u) * nx) xb_add(&bar[XB_TOPGEN], 1u);
            else XB_SPIN(xb_ld(&bar[XB_TOPGEN]) == tg, bar);
            __builtin_amdgcn_fence(__ATOMIC_ACQUIRE, "agent");
            xb_add(&bar[XB_XGEN(b.x)], 1u);
            asm volatile("s_waitcnt vmcnt(0)" ::: "memory");
        } else {
            XB_SPIN(xb_ld(&bar[XB_XGEN(b.x)]) == gen, bar);
            __builtin_amdgcn_fence(__ATOMIC_ACQUIRE, "agent");
            asm volatile("s_waitcnt vmcnt(0)" ::: "memory");
        }
    }
    __syncthreads();
}


struct Args { const float* in[16]; float* out; unsigned char* ws; };
#ifndef PROBE_MASK
#define PROBE_MASK 0
#endif
#define STAMP(k) do { if (PROBE_MASK && bx == 0 && threadIdx.x == 0) ((LAS unsigned long long*)(lds + 135168))[k] = __builtin_amdgcn_s_memrealtime(); } while (0)
#ifndef XSYNC
#define XSYNC 0
#endif
#ifndef HG_REP
#define HG_REP 1
#endif
#ifndef EN_G1
#define EN_G1 1
#endif
#ifndef EN_G2
#define EN_G2 1
#endif
#ifndef EN_G3
#define EN_G3 1
#endif
#ifndef EN_MA
#define EN_MA 1
#endif
#ifndef EN_ATT
#define EN_ATT 1
#endif
#ifndef EN_MC
#define EN_MC 1
#endif
#ifndef EN_G5
#define EN_G5 1
#endif

constexpr int HL_SEG = 0, HL_B = 4096, HL_BS = 9216, HL_OL = HL_B + 7 * HL_BS, HL_TOT = HL_OL + 64 * 68 * 4, HP72 = 72;
typedef float f32x2v __attribute__((ext_vector_type(2)));
__device__ __forceinline__ float hgrn_lb(const float* logits, int l, int ch) {
    if (l == 0) return 0.f;
    const float x0 = logits[ch], x1 = logits[256 + ch], mx = fmaxf(x0, x1), e0 = __expf(x0 - mx), e1 = __expf(x1 - mx);
    return fminf(fmaxf(e1 / (e0 + e1), 0.f), 1.f);
}
__device__ __forceinline__ f32x4 mfma16(bf16x8 a, bf16x8 b, f32x4 c) { return __builtin_amdgcn_mfma_f32_16x16x32_bf16(a, b, c, 0, 0, 0); }
__device__ __forceinline__ void hgrn_front(LAS unsigned char* lds, const unsigned (&z2)[4], float lb0, float lb1, float (&lf)[2][4], float (&kk)[2][4], float (&tot)[2], float (&ref)[2], int dp, int sg) {
    LAS f32x2v* SEG = (LAS f32x2v*)(lds + HL_SEG);
#pragma unroll
    for (int j = 0; j < 4; ++j)
#pragma unroll
        for (int c = 0; c < 2; ++c) { const float lb = c ? lb1 : lb0; const float z = fmaxf(__builtin_bit_cast(float, c ? (z2[j] & 0xffff0000u) : (z2[j] << 16)), -80.f);
            const float e = __builtin_amdgcn_exp2f(-1.4426950408889634f * z), sgm = __builtin_amdgcn_rcpf(1.0f + e), f = lb + (1.0f - lb) * sgm;
            lf[c][j] = __builtin_amdgcn_logf(f); kk[c][j] = (1.0f - lb) * e * sgm; }
#pragma unroll
    for (int c = 0; c < 2; ++c) { lf[c][1] += lf[c][0]; lf[c][2] += lf[c][1]; lf[c][3] += lf[c][2]; }
    SEG[sg * 32 + dp] = (f32x2v){lf[0][3], lf[1][3]};
    __syncthreads();
    f32x2v off = (f32x2v){0.f, 0.f}, tt = off, rr = off;
#pragma unroll
    for (int q = 0; q < 16; ++q) { const f32x2v v = SEG[q * 32 + dp]; tt += v; if (q < sg) off += v; if (q < 8) rr += v; }
#pragma unroll
    for (int j = 0; j < 4; ++j) { lf[0][j] += off[0]; lf[1][j] += off[1]; }
    tot[0] = tt[0]; tot[1] = tt[1]; ref[0] = rr[0]; ref[1] = rr[1];
}
__device__ __forceinline__ void hgrn_seg_local(LAS unsigned char* lds, const bf16* H, const float* lbl, int l, float* HSEG, float* SEGDEC, int unit, int tid) {
    const int bh = unit >> 4, seg = unit & 15, b = bh >> 2, h = bh & 3, dp = tid & 31, sg = tid >> 5, lane = tid & 63, w = tid >> 6;
    const int mi = w >> 1, nj0 = 2 * (w & 1), lr = lane & 15, lq = lane >> 4;
    const bf16* hb = H + ((size_t)b * SEQL + seg * 512) * HPITCH + h * 64 + 2 * dp;
    LAS bf16* B0 = (LAS bf16*)(lds + HL_B); LAS bf16* B1 = B0 + HL_BS / 2; LAS float* TOTL = (LAS float*)(lds + HL_TOT);
    const float lb0 = hgrn_lb(lbl, l, h * 64 + 2 * dp), lb1 = hgrn_lb(lbl, l, h * 64 + 2 * dp + 1);
    unsigned z2[4], v2[4];
#pragma unroll
    for (int j = 0; j < 4; ++j) { const bf16* r = hb + (size_t)(4 * sg + j) * HPITCH; z2[j] = *(const unsigned*)(r + 1024); v2[j] = *(const unsigned*)(r + 1280); }
    f32x4 S[2] = {(f32x4){0.f, 0.f, 0.f, 0.f}, (f32x4){0.f, 0.f, 0.f, 0.f}}; float dsum0 = 0.f, dsum1 = 0.f;
#pragma unroll 1
    for (int c = 0; c < 8; ++c) {
        unsigned zn[4], vn[4];
        { const int cn = (c < 7) ? c + 1 : c;
#pragma unroll
          for (int j = 0; j < 4; ++j) { const bf16* r = hb + (size_t)(cn * 64 + 4 * sg + j) * HPITCH; zn[j] = *(const unsigned*)(r + 1024); vn[j] = *(const unsigned*)(r + 1280); } }
        float lf[2][4], kk[2][4], tot[2], ref[2];
        hgrn_front(lds, z2, lb0, lb1, lf, kk, tot, ref, dp, sg);
#pragma unroll
        for (int cc = 0; cc < 2; ++cc) { float kh[4];
#pragma unroll
            for (int j = 0; j < 4; ++j) kh[j] = kk[cc][j] * __builtin_amdgcn_exp2f(tot[cc] - lf[cc][j]);
            *(LAS pg8::u32x2*)(B0 + (2 * dp + cc) * HP72 + 4 * sg) = (pg8::u32x2){pk2(kh[0], kh[1]), pk2(kh[2], kh[3])}; }
        *(LAS pg8::u32x2*)(B1 + (2 * dp) * HP72 + 4 * sg) = (pg8::u32x2){(v2[0] & 0xffffu) | (v2[1] << 16), (v2[2] & 0xffffu) | (v2[3] << 16)};
        *(LAS pg8::u32x2*)(B1 + (2 * dp + 1) * HP72 + 4 * sg) = (pg8::u32x2){(v2[0] >> 16) | (v2[1] & 0xffff0000u), (v2[2] >> 16) | (v2[3] & 0xffff0000u)};
        if (sg == 0) { *(LAS f32x2v*)(TOTL + 2 * dp) = (f32x2v){tot[0], tot[1]}; dsum0 += tot[0]; dsum1 += tot[1]; }
        __syncthreads();
        f32x4 acc[2] = {(f32x4){0.f, 0.f, 0.f, 0.f}, (f32x4){0.f, 0.f, 0.f, 0.f}};
#pragma unroll
        for (int ks = 0; ks < 2; ++ks) { const bf16x8 a = *(const LAS bf16x8*)(B0 + (16 * mi + lr) * HP72 + 32 * ks + 8 * lq);
#pragma unroll
            for (int jn = 0; jn < 2; ++jn) { const bf16x8 bb = *(const LAS bf16x8*)(B1 + (16 * (nj0 + jn) + lr) * HP72 + 32 * ks + 8 * lq); acc[jn] = mfma16(a, bb, acc[jn]); } }
        const f32x4 tl = *(const LAS f32x4*)(TOTL + 16 * mi + 4 * lq);
        const f32x4 dec = (f32x4){__builtin_amdgcn_exp2f(tl[0]), __builtin_amdgcn_exp2f(tl[1]), __builtin_amdgcn_exp2f(tl[2]), __builtin_amdgcn_exp2f(tl[3])};
        S[0] = S[0] * dec + acc[0]; S[1] = S[1] * dec + acc[1];
#pragma unroll
        for (int j = 0; j < 4; ++j) { z2[j] = zn[j]; v2[j] = vn[j]; }
    }
    float* out = HSEG + (size_t)unit * 4096 + tid;
#pragma unroll
    for (int jn = 0; jn < 2; ++jn)
#pragma unroll
        for (int r = 0; r < 4; ++r) out[(jn * 4 + r) * 512] = S[jn][r];
    if (sg == 0) *(f32x2v*)(SEGDEC + (size_t)unit * 64 + 2 * dp) = (f32x2v){__builtin_amdgcn_exp2f(dsum0), __builtin_amdgcn_exp2f(dsum1)};
    __syncthreads();
}
__device__ __forceinline__ void hgrn_seg_out(LAS unsigned char* lds, const bf16* H, const float* lbl, int l, const float* HSEG, const float* SEGDEC, const float* ogain, bf16* Y, int unit, int tid) {
    const int bh = unit >> 4, seg = unit & 15, b = bh >> 2, h = bh & 3, dp = tid & 31, sg = tid >> 5, lane = tid & 63, w = tid >> 6, t8 = tid >> 3, cg8 = tid & 7;
    const int mi = w >> 1, nj0 = 2 * (w & 1), lr = lane & 15, lq = lane >> 4;
    const size_t row0 = (size_t)b * SEQL + seg * 512;
    const bf16* hb = H + row0 * HPITCH + h * 64;
    LAS bf16* B0 = (LAS bf16*)(lds + HL_B); LAS bf16* B1 = B0 + HL_BS / 2; LAS bf16* B2 = B1 + HL_BS / 2; LAS bf16* B3 = B2 + HL_BS / 2; LAS bf16* B4 = B3 + HL_BS / 2; LAS bf16* B5 = B4 + HL_BS / 2; LAS bf16* B6 = B5 + HL_BS / 2;
    LAS float* OL = (LAS float*)(lds + HL_OL); LAS float* TOTL = (LAS float*)(lds + HL_TOT);
    const float lb0 = hgrn_lb(lbl, l, h * 64 + 2 * dp), lb1 = hgrn_lb(lbl, l, h * 64 + 2 * dp + 1);
    const f32x4 g0 = *(const f32x4*)(ogain + cg8 * 8), g1 = *(const f32x4*)(ogain + cg8 * 8 + 4);
    unsigned z2[4], q2[4], v2[4];
#pragma unroll
    for (int j = 0; j < 4; ++j) { const bf16* r = hb + (size_t)(4 * sg + j) * HPITCH + 2 * dp; z2[j] = *(const unsigned*)(r + 1024); q2[j] = *(const unsigned*)(r + 768); v2[j] = *(const unsigned*)(r + 1280); }
    u16x8 gr = *(const u16x8*)(hb + (size_t)t8 * HPITCH + 1536 + cg8 * 8);
    f32x4 S[2] = {(f32x4){0.f, 0.f, 0.f, 0.f}, (f32x4){0.f, 0.f, 0.f, 0.f}};
#pragma unroll 2
    for (int j = 0; j < seg; ++j) { const float* Sj = HSEG + (size_t)(bh * 16 + j) * 4096 + tid; const f32x4 dj = *(const f32x4*)(SEGDEC + (size_t)(bh * 16 + j) * 64 + 16 * mi + 4 * lq);
#pragma unroll
        for (int jn = 0; jn < 2; ++jn) { f32x4 u;
#pragma unroll
            for (int r = 0; r < 4; ++r) u[r] = Sj[(jn * 4 + r) * 512];
            S[jn] = S[jn] * dj + u; } }
#pragma unroll 1
    for (int c = 0; c < 8; ++c) {
        unsigned zn[4], qn[4], vn[4]; u16x8 gn;
        { const int cn = (c < 7) ? c + 1 : c;
#pragma unroll
          for (int j = 0; j < 4; ++j) { const bf16* r = hb + (size_t)(cn * 64 + 4 * sg + j) * HPITCH + 2 * dp; zn[j] = *(const unsigned*)(r + 1024); qn[j] = *(const unsigned*)(r + 768); vn[j] = *(const unsigned*)(r + 1280); }
          gn = *(const u16x8*)(hb + (size_t)(cn * 64 + t8) * HPITCH + 1536 + cg8 * 8); }
        float lf[2][4], kk[2][4], tot[2], ref[2];
        hgrn_front(lds, z2, lb0, lb1, lf, kk, tot, ref, dp, sg);
#pragma unroll
        for (int j = 0; j < 4; ++j) { float qt[2], kt[2], qh[2];
#pragma unroll
            for (int cc = 0; cc < 2; ++cc) { const float bc = lf[cc][j], q = __builtin_bit_cast(float, cc ? (q2[j] & 0xffff0000u) : (q2[j] << 16));
                qt[cc] = q * __builtin_amdgcn_exp2f(fminf(bc - ref[cc], 115.f)); kt[cc] = kk[cc][j] * __builtin_amdgcn_exp2f(fminf(ref[cc] - bc, 115.f)); qh[cc] = q * __builtin_amdgcn_exp2f(bc); }
            const int o = (4 * sg + j) * HP72 + 2 * dp;
            *(LAS unsigned*)(B0 + o) = pk2(qt[0], qt[1]); *(LAS unsigned*)(B1 + o) = pk2(kt[0], kt[1]); *(LAS unsigned*)(B2 + o) = pk2(qh[0], qh[1]); }
#pragma unroll
        for (int cc = 0; cc < 2; ++cc) { float kh[4];
#pragma unroll
            for (int j = 0; j < 4; ++j) kh[j] = kk[cc][j] * __builtin_amdgcn_exp2f(tot[cc] - lf[cc][j]);
            *(LAS pg8::u32x2*)(B6 + (2 * dp + cc) * HP72 + 4 * sg) = (pg8::u32x2){pk2(kh[0], kh[1]), pk2(kh[2], kh[3])}; }
        *(LAS pg8::u32x2*)(B3 + (2 * dp) * HP72 + 4 * sg) = (pg8::u32x2){(v2[0] & 0xffffu) | (v2[1] << 16), (v2[2] & 0xffffu) | (v2[3] << 16)};
        *(LAS pg8::u32x2*)(B3 + (2 * dp + 1) * HP72 + 4 * sg) = (pg8::u32x2){(v2[0] >> 16) | (v2[1] & 0xffff0000u), (v2[2] >> 16) | (v2[3] & 0xffff0000u)};
#pragma unroll
        for (int jn = 0; jn < 2; ++jn) *(LAS pg8::u32x2*)(B4 + (16 * (nj0 + jn) + lr) * HP72 + 16 * mi + 4 * lq) = (pg8::u32x2){pk2(S[jn][0], S[jn][1]), pk2(S[jn][2], S[jn][3])};
        if (sg == 0) *(LAS f32x2v*)(TOTL + 2 * dp) = (f32x2v){tot[0], tot[1]};
        __syncthreads();
        f32x4 un[2] = {(f32x4){0.f, 0.f, 0.f, 0.f}, (f32x4){0.f, 0.f, 0.f, 0.f}};
        { f32x4 acc[2] = {(f32x4){0.f, 0.f, 0.f, 0.f}, (f32x4){0.f, 0.f, 0.f, 0.f}};
#pragma unroll
          for (int ks = 0; ks < 2; ++ks) { const bf16x8 a = *(const LAS bf16x8*)(B1 + (16 * mi + lr) * HP72 + 32 * ks + 8 * lq); const bf16x8 a6 = *(const LAS bf16x8*)(B6 + (16 * mi + lr) * HP72 + 32 * ks + 8 * lq);
#pragma unroll
              for (int jn = 0; jn < 2; ++jn) { const bf16x8 bb = *(const LAS bf16x8*)(B0 + (16 * (nj0 + jn) + lr) * HP72 + 32 * ks + 8 * lq); acc[jn] = mfma16(a, bb, acc[jn]);
                  const bf16x8 b3 = *(const LAS bf16x8*)(B3 + (16 * (nj0 + jn) + lr) * HP72 + 32 * ks + 8 * lq); un[jn] = mfma16(a6, b3, un[jn]); } }
#pragma unroll
          for (int jn = 0; jn < 2; ++jn) { const int t = 16 * (nj0 + jn) + lr, sp = 16 * mi + 4 * lq; float m[4];
#pragma unroll
              for (int r = 0; r < 4; ++r) m[r] = (sp + r <= t) ? acc[jn][r] : 0.f;
              *(LAS pg8::u32x2*)(B5 + t * HP72 + sp) = (pg8::u32x2){pk2(m[0], m[1]), pk2(m[2], m[3])}; } }
        const f32x4 tl = *(const LAS f32x4*)(TOTL + 16 * mi + 4 * lq);
        __syncthreads();
        { f32x4 acc[2] = {(f32x4){0.f, 0.f, 0.f, 0.f}, (f32x4){0.f, 0.f, 0.f, 0.f}};
#pragma unroll
          for (int ks = 0; ks < 2; ++ks) { const bf16x8 a = *(const LAS bf16x8*)(B3 + (16 * mi + lr) * HP72 + 32 * ks + 8 * lq);
#pragma unroll
              for (int jn = 0; jn < 2; ++jn) { const bf16x8 bb = *(const LAS bf16x8*)(B5 + (16 * (nj0 + jn) + lr) * HP72 + 32 * ks + 8 * lq); acc[jn] = mfma16(a, bb, acc[jn]); } }
#pragma unroll
          for (int ks = 0; ks < 2; ++ks) { const bf16x8 a = *(const LAS bf16x8*)(B4 + (16 * mi + lr) * HP72 + 32 * ks + 8 * lq);
#pragma unroll
              for (int jn = 0; jn < 2; ++jn) { const bf16x8 bb = *(const LAS bf16x8*)(B2 + (16 * (nj0 + jn) + lr) * HP72 + 32 * ks + 8 * lq); acc[jn] = mfma16(a, bb, acc[jn]); } }
#pragma unroll
          for (int jn = 0; jn < 2; ++jn) *(LAS f32x4*)(OL + (16 * (nj0 + jn) + lr) * 68 + 16 * mi + 4 * lq) = acc[jn]; }
        { const f32x4 dec = (f32x4){__builtin_amdgcn_exp2f(tl[0]), __builtin_amdgcn_exp2f(tl[1]), __builtin_amdgcn_exp2f(tl[2]), __builtin_amdgcn_exp2f(tl[3])};
          S[0] = S[0] * dec + un[0]; S[1] = S[1] * dec + un[1]; }
        __syncthreads();
        { const f32x4 o0 = *(const LAS f32x4*)(OL + t8 * 68 + cg8 * 8), o1 = *(const LAS f32x4*)(OL + t8 * 68 + cg8 * 8 + 4);
          float ss = (o0[0] * o0[0] + o0[1] * o0[1]) + (o0[2] * o0[2] + o0[3] * o0[3]) + (o1[0] * o1[0] + o1[1] * o1[1]) + (o1[2] * o1[2] + o1[3] * o1[3]);
          ss += __shfl_xor(ss, 1); ss += __shfl_xor(ss, 2); ss += __shfl_xor(ss, 4);
          const float rinv = rsqrtf(ss * (1.0f / 64.0f) + 1e-6f);
          float o[8];
#pragma unroll
          for (int i = 0; i < 4; ++i) { o[i] = o0[i] * rinv * g0[i] * pg8::silu_f(bf2f(gr[i])); o[4 + i] = o1[i] * rinv * g1[i] * pg8::silu_f(bf2f(gr[4 + i])); }
          *(v4u*)(Y + (row0 + c * 64 + t8) * DM + 256 + h * 64 + cg8 * 8) = (v4u){pk2(o[0], o[1]), pk2(o[2], o[3]), pk2(o[4], o[5]), pk2(o[6], o[7])}; }
#pragma unroll
        for (int j = 0; j < 4; ++j) { z2[j] = zn[j]; q2[j] = qn[j]; v2[j] = vn[j]; }
        gr = gn;
    }
    __syncthreads();
}
__device__ __forceinline__ void conv_unit(const bf16* H, const float* cw, bf16* Y, int unit, int tid) {
    const int cgp = tid & 31, tl = tid >> 5, ch = cgp * 8;
    float w0[8], w1[8], w2[8];
#pragma unroll
    for (int i = 0; i < 8; ++i) { w0[i] = cw[ch + i]; w1[i] = cw[256 + ch + i]; w2[i] = cw[512 + ch + i]; }
#pragma unroll 2
    for (int p = 0; p < 4; ++p) { const int row = unit * 64 + p * 16 + tl, t = row & (SEQL - 1);
        const bf16* hp = H + (size_t)row * HPITCH + ch;
        const u16x8 x2 = *(const u16x8*)hp, c2 = *(const u16x8*)(hp + 512), bg = *(const u16x8*)(hp + 256);
        u16x8 x1 = (u16x8){0,0,0,0,0,0,0,0}, c1 = x1, x0 = x1, c0 = x1;
        if (t >= 1) { x1 = *(const u16x8*)(hp - HPITCH); c1 = *(const u16x8*)(hp - HPITCH + 512); }
        if (t >= 2) { x0 = *(const u16x8*)(hp - 2 * HPITCH); c0 = *(const u16x8*)(hp - 2 * HPITCH + 512); }
        float o[8];
#pragma unroll
        for (int i = 0; i < 8; ++i) o[i] = bf2f(bg[i]) * (w0[i] * (bf2f(c0[i]) * bf2f(x0[i])) + w1[i] * (bf2f(c1[i]) * bf2f(x1[i])) + w2[i] * (bf2f(c2[i]) * bf2f(x2[i])));
        *(v4u*)(Y + (size_t)row * DM + ch) = (v4u){pk2(o[0], o[1]), pk2(o[2], o[3]), pk2(o[4], o[5]), pk2(o[6], o[7])}; }
}
__device__ __forceinline__ void cumsum_unit(LAS unsigned char* lds, float* C, int unit, int tid) {
    LAS float* WS = (LAS float*)lds; float* p = C + (size_t)unit * SEQL + tid * 16; const int lane = tid & 63, w = tid >> 6;
    float v[16];
#pragma unroll
    for (int j = 0; j < 4; ++j) { const f32x4 x = *(const f32x4*)(p + 4 * j); v[4 * j] = x[0]; v[4 * j + 1] = x[1]; v[4 * j + 2] = x[2]; v[4 * j + 3] = x[3]; }
#pragma unroll
    for (int i = 1; i < 16; ++i) v[i] += v[i - 1];
    const float tot = v[15]; float inc = tot;
#pragma unroll
    for (int o = 1; o < 64; o <<= 1) { const float t = __shfl_up(inc, o); if (lane >= o) inc += t; }
    if (lane == 63) WS[w] = inc;
    __syncthreads();
    float off = inc - tot;
    for (int q = 0; q < w; ++q) off += WS[q];
#pragma unroll
    for (int j = 0; j < 4; ++j) *(f32x4*)(p + 4 * j) = (f32x4){v[4 * j] + off, v[4 * j + 1] + off, v[4 * j + 2] + off, v[4 * j + 3] + off};
    __syncthreads();
}

__global__ void __launch_bounds__(NWAVES * 64, 2) fwd_mega(Args args) {
    extern __shared__ __attribute__((aligned(16))) unsigned char lds_raw[];
    cg::grid_group grid = cg::this_grid();
    LAS unsigned char* lds = (LAS unsigned char*)lds_raw;
    const int tid = threadIdx.x, lane = tid & 63, wave = __builtin_amdgcn_readfirstlane(tid >> 6);
    const int G = gridDim.x, bx = blockIdx.x; const int vcu = (G % 8 == 0) ? (bx % 8) * (G / 8) + bx / 8 : bx;
    unsigned char* ws = args.ws;
    for (int u_ = threadIdx.x; u_ < (LDS_BYTES - 131072) / 4; u_ += NWAVES * 64) ((LAS unsigned*)(lds + 131072))[u_] = 0u;
    __syncthreads();
    const XcdBarrier xbar = xcd_barrier_post((unsigned*)(ws + WS_BAR), (volatile LAS unsigned*)(lds + 140288));
#define SEAM() do { XcdBarrier b_ = xbar; asm volatile("" : "+s"(b_.x)); xcd_barrier(b_); } while (0)
    unsigned long long* RS = (unsigned long long*)(ws + WS_RS); float* FOXC = (float*)(ws + WS_FOXC); float* DEC = (float*)(ws + WS_DEC);
    unsigned* QCTR = (unsigned*)(ws + WS_QCTR);
    bf16* XB = (bf16*)(ws + WS_XB); bf16* HACT = (bf16*)(ws + WS_HACT); bf16* Y = (bf16*)(ws + WS_Y); float* HST = (float*)(ws + WS_HST);
    const float* x_in = args.in[0]; float* out = args.out;

    STAMP(0);
    {
        LAS float* scr = (LAS float*)(lds + wave * 16384);
        const int gw = vcu * NWAVES + wave, NGW = G * NWAVES;
        constexpr int I_FI = 16 * 176, I_FO = 44 * 32, I_MI = 16 * 112, I_MO = 16 * 32, I_L = 2 * I_FI + 2 * I_FO + I_MI + I_MO;
        for (int it = gw; it < DEPTH * I_L; it += NGW) {
            const int l = it / I_L; int r = it - l * I_L; unsigned char* wl = ws + WS_W + (size_t)l * W_LAYER;
            if (r < I_FI) { tr_item(args.in[2] + (size_t)l * DM * NFF, DM, NFF, 176, args.in[1] + l * DM, (bf16*)(wl + WO_1IN), 1, scr, r, lane); continue; } r -= I_FI;
            if (r < I_FO) { tr_item(args.in[3] + (size_t)l * DFF * DM, DFF, DM, 32, nullptr, (bf16*)(wl + WO_1OUT), 0, scr, r, lane); continue; } r -= I_FO;
            if (r < I_MI) { tr_item(args.in[5] + (size_t)l * DM * NMIX, DM, NMIX, 112, args.in[4] + l * DM, (bf16*)(wl + WO_MIX), 2, scr, r, lane); continue; } r -= I_MI;
            if (r < I_MO) { tr_item(args.in[12] + (size_t)l * DM * DM, DM, DM, 32, nullptr, (bf16*)(wl + WO_MO), 0, scr, r, lane); continue; } r -= I_MO;
            if (r < I_FI) { tr_item(args.in[14] + (size_t)l * DM * NFF, DM, NFF, 176, args.in[13] + l * DM, (bf16*)(wl + WO_2IN), 1, scr, r, lane); continue; } r -= I_FI;
            tr_item(args.in[15] + (size_t)l * DFF * DM, DFF, DM, 32, nullptr, (bf16*)(wl + WO_2OUT), 0, scr, r, lane);
        }
#pragma unroll 4
        for (int m = gw; m < M; m += NGW) {
            const f32x4* xr = (const f32x4*)(x_in + (size_t)m * DM) + lane; f32x4 v[4]; float s = 0.f;
#pragma unroll
            for (int j = 0; j < 4; ++j) { v[j] = __builtin_nontemporal_load(xr + 64 * j); s += (v[j][0] * v[j][0] + v[j][1] * v[j][1]) + (v[j][2] * v[j][2] + v[j][3] * v[j][3]); }
            s = wave_sum(s); if (lane == 0) RS[m] = (unsigned long long)(s * 16777216.0f);
            unsigned long long* o8 = (unsigned long long*)(XB + (size_t)m * DM) + lane;
#pragma unroll
            for (int j = 0; j < 4; ++j) o8[64 * j] = (unsigned long long)pk2(v[j][0], v[j][1]) | ((unsigned long long)pk2(v[j][2], v[j][3]) << 32);
        }
        for (int i = bx * (NWAVES * 64) + tid; i < 5 * M; i += G * NWAVES * 64) RS[M + i] = 0ull;
    }
    if (gridDim.x == 0x7fffffffu) grid.sync();
    SEAM(); STAMP(1);

#pragma unroll 1
    for (int step = 0; step < 3 * DEPTH; ++step) {
        const int l = step / 3, kind = step - 3 * l; unsigned char* wl = ws + WS_W + (size_t)l * W_LAYER;
        int tid = threadIdx.x; asm volatile("" : "+v"(tid));
        const unsigned long long* rs_in = RS + (size_t)step * M; unsigned long long* rs_out = (step + 1 < 3 * DEPTH) ? RS + (size_t)(step + 1) * M : nullptr;
        if (kind != 1) {
            const bf16* w_in = (const bf16*)(wl + (kind == 0 ? WO_1IN : WO_2IN)); const bf16* w_out = (const bf16*)(wl + (kind == 0 ? WO_1OUT : WO_2OUT));
            { pg8::Gemm g{XB, w_in, M, NFF, DM}; pg8::StaticOrder S; S.init(M, NFF, G, bx);
              pg8::EpiGlu E{HACT, DFF, rs_in};
              if (EN_G1) pg8::gemm_phase<pg8::EpiGlu, pg8::StaticOrder, true, true>(lds, g, S, E); }
            SEAM(); STAMP(2 + step * 8 + 0);
            { pg8::Gemm g{HACT, w_out, M, DM, DFF}; pg8::StaticOrder S; S.init(M, DM, G, bx);
              pg8::EpiResid E{XB, rs_out ? nullptr : out, rs_out, 0.5f};
              if (EN_G2) pg8::gemm_phase<pg8::EpiResid, pg8::StaticOrder, true, true>(lds, g, S, E); }
            if (step + 1 < 3 * DEPTH || PROBE_MASK) SEAM();
            STAMP(2 + step * 8 + 1);
        } else {
            { pg8::Gemm g{XB, (const bf16*)(wl + WO_MIX), M, HPITCH, DM}; pg8::StaticOrder S; S.init(M, HPITCH, G, bx);
              pg8::EpiMix E{HACT, rs_in, args.in[9] + l * 64, args.in[10] + l * 64, args.in[11] + l * 8, FOXC};
              if (EN_G3) pg8::gemm_phase<pg8::EpiMix, pg8::StaticOrder, true, true>(lds, g, S, E); }
            SEAM(); STAMP(2 + step * 8 + 0);
            for (int u = bx; u < 256 + 32; u += G) {
                if (u < 256) { if (EN_MA) for (int rep_ = 0; rep_ < HG_REP; ++rep_) hgrn_seg_local(lds, HACT, args.in[7], l, HST, DEC, u, tid); }
                else cumsum_unit(lds, FOXC, u - 256, tid);
            }
            SEAM(); STAMP(2 + step * 8 + 1);
            { unsigned* qc = QCTR + 64 * l; LAS unsigned* slot = (LAS unsigned*)(lds + 139264);
              for (;;) {
                  if (threadIdx.x == 0) *slot = atomicAdd(qc, 1u);
                  __syncthreads(); const int u = (int)__builtin_amdgcn_readfirstlane(*slot); __syncthreads();
                  if (u >= 1024 + 256 + 512) break;
                  if (u < 1024) { const int bh = u & 31, qb = 31 - (u >> 5);
                      if (EN_ATT) attn_body::attn_unit<48>(bh >> 3, bh & 7, qb, (const attn_body::bf16*)(HACT + 1792), (const attn_body::bf16*)(HACT + 2304), (const attn_body::bf16*)(HACT + 2816), (attn_body::bf16*)(Y + 512), FOXC, args.in[9] + l * 64, args.in[10] + l * 64, (char*)lds_raw); }
                  else if (u >= 1024 + 256) { int tq = threadIdx.x; asm volatile("" : "+v"(tq)); conv_unit(HACT, args.in[6] + l * 768, Y, u - 1280, tq); }
                  else { int tq = threadIdx.x; asm volatile("" : "+v"(tq));
                      if (EN_MC) for (int rep_ = 0; rep_ < HG_REP; ++rep_) hgrn_seg_out(lds, HACT, args.in[7], l, HST, DEC, args.in[8] + l * 64, Y, u - 1024, tq); }
              } }
            if (PROBE_MASK) { STAMP(2 + step * 8 + 2); }
            SEAM(); STAMP(2 + step * 8 + 3); STAMP(2 + step * 8 + 4);
            { pg8::Gemm g{Y, (const bf16*)(wl + WO_MO), M, DM, DM}; pg8::StaticOrder S; S.init(M, DM, G, bx);
              pg8::EpiResid E{XB, nullptr, rs_out, 1.0f};
              if (EN_G5) pg8::gemm_phase<pg8::EpiResid, pg8::StaticOrder, true, true>(lds, g, S, E); }
            SEAM(); STAMP(2 + step * 8 + 5);
        }
    }
    for (int i_ = 0; i_ < XSYNC; ++i_) SEAM();
    if (PROBE_MASK && bx == 0 && threadIdx.x == 0) {
        const LAS unsigned long long* T = (const LAS unsigned long long*)(lds + 135168);
        unsigned long long X = 0, prev = T[1];
        if (PROBE_MASK & 1) X += T[1] - T[0];
        for (int st = 0; st < 3 * DEPTH; ++st) { const LAS unsigned long long* q = T + 2 + st * 8;
            if (st % 3 != 1) { if (PROBE_MASK & 2) X += q[0] - prev; if (PROBE_MASK & 4) X += q[1] - q[0]; prev = q[1]; }
            else { if (PROBE_MASK & 8) X += q[0] - prev; if (PROBE_MASK & 16) X += q[1] - q[0]; if (PROBE_MASK & 32) X += q[2] - q[1]; if (PROBE_MASK & 64) X += q[3] - q[2];
                   if (PROBE_MASK & 128) X += q[4] - q[3]; if (PROBE_MASK & 256) X += q[5] - q[4]; prev = q[5]; } }
        const unsigned long long t0 = __builtin_amdgcn_s_memrealtime();
        while (__builtin_amdgcn_s_memrealtime() - t0 < X) __builtin_amdgcn_s_sleep(16);
    }
}

extern "C" void kernel_launch(void* const* d_in, const int* in_sizes, int n_in, void* d_out, int out_size, void* d_ws, size_t ws_size, hipStream_t stream) {
    static int grid = 0;
    if (grid == 0) {
        if (n_in != 16 || out_size != M * DM || ws_size < WS_END) { fprintf(stderr, "kernel_launch: unexpected shapes (n_in %d out %d ws %zu)\n", n_in, out_size, ws_size); grid = -1; return; }
        int dev = 0, cus = 0, per_cu = 0;
        hipGetDevice(&dev); hipDeviceGetAttribute(&cus, hipDeviceAttributeMultiprocessorCount, dev);
        hipFuncSetAttribute((const void*)fwd_mega, hipFuncAttributeMaxDynamicSharedMemorySize, LDS_BYTES);
        if (hipOccupancyMaxActiveBlocksPerMultiprocessor(&per_cu, (const void*)fwd_mega, NWAVES * 64, LDS_BYTES) != hipSuccess || per_cu < 1) { fprintf(stderr, "kernel_launch: occupancy query failed (%d)\n", per_cu); per_cu = 1; }
        (void)hipGetLastError();
        grid = cus * 1;
    }
    if (grid < 0) return;
    if (hipMemsetAsync((char*)d_ws + WS_QCTR, 0, WS_CTL_ZERO, stream) != hipSuccess) { fprintf(stderr, "kernel_launch: memset of the control words failed\n"); return; }
    Args a{};
    for (int i = 0; i < 16; ++i) a.in[i] = (const float*)d_in[i];
    a.out = (float*)d_out; a.ws = (unsigned char*)d_ws;
    void* kargs[] = {&a};
    hipError_t e = hipLaunchCooperativeKernel((const void*)fwd_mega, dim3(grid), dim3(NWAVES * 64), kargs, LDS_BYTES, stream);
    if (e != hipSuccess) fprintf(stderr, "cooperative launch failed: %s (grid %d)\n", hipGetErrorString(e), grid);
}
```

```cpp
#include <hip/hip_runtime.h>
#include <cstdio>
#include <cstdint>
namespace pg8 {
#define PG8_LAS __attribute__((address_space(3)))
typedef unsigned short bf16_t;
typedef short bf16x8 __attribute__((ext_vector_type(8)));
typedef float f32x4 __attribute__((ext_vector_type(4)));
typedef unsigned u32x4 __attribute__((ext_vector_type(4)));
constexpr int BM = 256, BK = 64, HALF = 128, HTB = HALF * BK * 2  , STAGE_BYTES = 8 * HTB, NXCD = 8, WGM = 8;

__host__ __device__ __forceinline__ int lds_byte(int r, int c) { const int st = (r >> 4) * 2 + (c >> 5), rr = r & 15, cc = c & 31, ob = rr * 64 + cc * 2; return st * 1024 + (ob ^ (((ob >> 9) & 1) << 5)); }
__host__ __device__ __forceinline__ void stage_rc(int b, int& R, int& C) { const int st = b / 1024, sb = b % 1024, swz = sb ^ (((sb >> 9) & 1) << 5); R = (st >> 1) * 16 + swz / 64; C = (st & 1) * 32 + (swz % 64) / 2; }
__host__ __device__ __forceinline__ int perm32(int rho) { const int n = rho >> 4, i = rho & 15; return 8 * (i >> 2) + 4 * n + (i & 3); }

struct Unit { int pm, pn; };
struct Gemm { const bf16_t* A; const bf16_t* Bt; int M, N, K; };

struct StaticOrder {
    int nM, nN, nwg, G, c;
    __host__ __device__ void init(int M, int N, int G_, int c_) { nM = M / BM; nN = N / BM; nwg = nM * nN; G = G_; c = c_; }
    __host__ __device__ bool next(int i, Unit& u) const {
        const long L = (long)i * G + c; if (L >= nwg) return false;
        int wgid = (int)L; { const int q = nwg / NXCD, r = nwg % NXCD, xcd = wgid % NXCD, off = wgid / NXCD; wgid = (xcd < r ? xcd * (q + 1) : r * (q + 1) + (xcd - r) * q) + off; }
        const int nig = WGM * nN, gid = wgid / nig, fm = gid * WGM, gsz = (nM - fm) < WGM ? (nM - fm) : WGM;
        u.pm = fm + ((wgid % nig) % gsz); u.pn = (wgid % nig) / gsz; return true;
    }
    __device__ __forceinline__ void a_ready(const Unit&) const {}
    __device__ __forceinline__ void done(const Unit&) const {}
};

__device__ __forceinline__ unsigned cvt_pk_bf16(float lo, float hi) { unsigned r; asm volatile("v_cvt_pk_bf16_f32 %0, %1, %2" : "=v"(r) : "v"(lo), "v"(hi)); return r; }
typedef float f32x2 __attribute__((ext_vector_type(2)));
constexpr float RMS_EPS = 1e-6f;
__device__ __forceinline__ float silu_f(float g) { return g * __builtin_amdgcn_rcpf(1.0f + __builtin_amdgcn_exp2f(-1.4426950408889634f * g)); }
struct EpiGlu {
    static constexpr bool PERM = true, AFTER_DRAIN = false;
    bf16_t* O; int ldc; const unsigned long long* rss;
    __device__ __forceinline__ void operator()(const f32x4 (&acc)[2][2][4][2], const Unit& u, int wr, int wc, int fr, int fq) const {
        const int row0 = u.pm * BM + wr * 64 + fr, col0 = u.pn * HALF + wc * 32 + 8 * fq;
        unsigned long long rv[2][4];
#pragma unroll
        for (int ai = 0; ai < 2; ++ai)
#pragma unroll
            for (int m = 0; m < 4; ++m) rv[ai][m] = rss[row0 + ai * HALF + m * 16];
#pragma unroll
        for (int ai = 0; ai < 2; ++ai)
#pragma unroll
            for (int m = 0; m < 4; ++m) { const int row = row0 + ai * HALF + m * 16; const float inv = rsqrtf((float)rv[ai][m] * (1.0f / (1024.0f * 16777216.0f)) + RMS_EPS);
                const float cexp = -1.4426950408889634f * inv, inv2 = inv * inv; u32x4 w;
#pragma unroll
                for (int n = 0; n < 2; ++n) { const f32x4 g = acc[ai][0][m][n], uu = acc[ai][1][m][n]; const f32x4 t = g * cexp;
                    const f32x4 e = (f32x4){__builtin_amdgcn_exp2f(t[0]), __builtin_amdgcn_exp2f(t[1]), __builtin_amdgcn_exp2f(t[2]), __builtin_amdgcn_exp2f(t[3])};
                    const f32x4 d = e + 1.0f;
                    const f32x4 r = (f32x4){__builtin_amdgcn_rcpf(d[0]), __builtin_amdgcn_rcpf(d[1]), __builtin_amdgcn_rcpf(d[2]), __builtin_amdgcn_rcpf(d[3])};
                    const f32x4 o = (g * uu) * (r * inv2);
                    if (n == 0) { w.x = cvt_pk_bf16(o[0], o[1]); w.y = cvt_pk_bf16(o[2], o[3]); } else { w.z = cvt_pk_bf16(o[0], o[1]); w.w = cvt_pk_bf16(o[2], o[3]); } }
                *(u32x4*)(O + (size_t)row * ldc + col0) = w; }
    }
};
typedef unsigned u32x2 __attribute__((ext_vector_type(2)));
struct EpiResid {
    static constexpr bool PERM = true, AFTER_DRAIN = false;
    bf16_t* xb; float* outf; unsigned long long* rss_next; float alpha;
    __device__ __forceinline__ void operator()(const f32x4 (&acc)[2][2][4][2], const Unit& u, int wr, int wc, int fr, int fq) const {
        const int row0 = u.pm * BM + wr * 64 + fr, col0 = u.pn * BM + wc * 32 + 8 * fq;
        u32x4 xall[2][4][2];
#pragma unroll
        for (int ai = 0; ai < 2; ++ai)
#pragma unroll
            for (int m = 0; m < 4; ++m)
#pragma unroll
                for (int bj = 0; bj < 2; ++bj) xall[ai][m][bj] = *(const u32x4*)(xb + (size_t)(row0 + ai * HALF + m * 16) * 1024 + col0 + bj * HALF);
#pragma unroll
        for (int ai = 0; ai < 2; ++ai)
#pragma unroll
            for (int m = 0; m < 4; ++m) { const int row = row0 + ai * HALF + m * 16; const size_t off = (size_t)row * 1024 + col0; float ss = 0.f;
                const u32x4 (&xin)[2] = xall[ai][m];
#pragma unroll
                for (int bj = 0; bj < 2; ++bj) {
                    const f32x4 x0 = (f32x4){__builtin_bit_cast(float, xin[bj].x << 16), __builtin_bit_cast(float, xin[bj].x & 0xffff0000u), __builtin_bit_cast(float, xin[bj].y << 16), __builtin_bit_cast(float, xin[bj].y & 0xffff0000u)};
                    const f32x4 x1 = (f32x4){__builtin_bit_cast(float, xin[bj].z << 16), __builtin_bit_cast(float, xin[bj].z & 0xffff0000u), __builtin_bit_cast(float, xin[bj].w << 16), __builtin_bit_cast(float, xin[bj].w & 0xffff0000u)};
                    const f32x4 o0 = x0 + acc[ai][bj][m][0] * alpha, o1 = x1 + acc[ai][bj][m][1] * alpha;
                    ss += (o0[0] * o0[0] + o0[1] * o0[1]) + (o0[2] * o0[2] + o0[3] * o0[3]) + (o1[0] * o1[0] + o1[1] * o1[1]) + (o1[2] * o1[2] + o1[3] * o1[3]);
                    if (outf) { __builtin_nontemporal_store(o0, (f32x4*)(outf + off + bj * HALF)); __builtin_nontemporal_store(o1, (f32x4*)(outf + off + bj * HALF + 4)); }
                    else { u32x4 w; w.x = cvt_pk_bf16(o0[0], o0[1]); w.y = cvt_pk_bf16(o0[2], o0[3]); w.z = cvt_pk_bf16(o1[0], o1[1]); w.w = cvt_pk_bf16(o1[2], o1[3]); *(u32x4*)(xb + off + bj * HALF) = w; } }
                if (rss_next) { ss += __shfl_xor(ss, 16); ss += __shfl_xor(ss, 32); if (fq == 0) atomicAdd(rss_next + row, (unsigned long long)(ss * 16777216.0f)); } }
    }
};
struct EpiMix {
    static constexpr bool PERM = true, AFTER_DRAIN = false;
    bf16_t* H; const unsigned long long* rss; const float* qgain; const float* kgain; const float* fbias; float* foxlf;
    __device__ __forceinline__ void operator()(const f32x4 (&acc)[2][2][4][2], const Unit& u, int wr, int wc, int fr, int fq) const {
        const int row0 = u.pm * BM + wr * 64 + fr, col0 = u.pn * BM + wc * 64 + 8 * fq;
        const int mode = (u.pn == 7 || u.pn == 8) ? 1 : (u.pn == 9 || u.pn == 10) ? 2 : (u.pn == 13) ? 3 : 0;
        f32x4 gv[2][2];
#pragma unroll
        for (int bj = 0; bj < 2; ++bj)
#pragma unroll
            for (int n = 0; n < 2; ++n) gv[bj][n] = (f32x4){1.f, 1.f, 1.f, 1.f};
        if (mode == 1 || mode == 2) { const float* gp = (mode == 1 ? qgain : kgain) + 8 * fq; const float sc = (mode == 1) ? 0.125f * 1.4426950408889634f : 1.0f;
#pragma unroll
            for (int bj = 0; bj < 2; ++bj)
#pragma unroll
                for (int n = 0; n < 2; ++n) gv[bj][n] = *(const f32x4*)(gp + 32 * bj + 4 * n) * sc; }
        unsigned long long rv[2][4];
#pragma unroll
        for (int ai = 0; ai < 2; ++ai)
#pragma unroll
            for (int m = 0; m < 4; ++m) rv[ai][m] = rss[row0 + ai * HALF + m * 16];
#pragma unroll
        for (int ai = 0; ai < 2; ++ai)
#pragma unroll
            for (int m = 0; m < 4; ++m) { const int row = row0 + ai * HALF + m * 16; float inv = rsqrtf((float)rv[ai][m] * (1.0f / (1024.0f * 16777216.0f)) + RMS_EPS);
                f32x4 v[2][2];
#pragma unroll
                for (int bj = 0; bj < 2; ++bj)
#pragma unroll
                    for (int n = 0; n < 2; ++n) v[bj][n] = acc[ai][bj][m][n] * inv;
                if (mode == 1 || mode == 2) { float ss = 0.f;
#pragma unroll
                    for (int bj = 0; bj < 2; ++bj)
#pragma unroll
                        for (int n = 0; n < 2; ++n) ss += (v[bj][n][0] * v[bj][n][0] + v[bj][n][1] * v[bj][n][1]) + (v[bj][n][2] * v[bj][n][2] + v[bj][n][3] * v[bj][n][3]);
                    ss += __shfl_xor(ss, 16); ss += __shfl_xor(ss, 32);
                    const float hinv = rsqrtf(ss * (1.0f / 64.0f) + RMS_EPS);
#pragma unroll
                    for (int bj = 0; bj < 2; ++bj)
#pragma unroll
                        for (int n = 0; n < 2; ++n) v[bj][n] = v[bj][n] * hinv * gv[bj][n]; }
                if (mode == 3 && wc == 0 && fq == 0) { const int b = row >> 13, t = row & 8191;
#pragma unroll
                    for (int n = 0; n < 2; ++n)
#pragma unroll
                        for (int i = 0; i < 4; ++i) { const int h = 4 * n + i; const float a = v[0][n][i] + fbias[h];
                            const float a2 = a * 1.4426950408889634f;
                            foxlf[(size_t)(b * 8 + h) * 8192 + t] = fminf(a2, 0.f) - __builtin_amdgcn_logf(1.0f + __builtin_amdgcn_exp2f(-fabsf(a2))); } }
                if (mode == 3) continue;
#pragma unroll
                for (int bj = 0; bj < 2; ++bj) { u32x4 w; w.x = cvt_pk_bf16(v[bj][0][0], v[bj][0][1]); w.y = cvt_pk_bf16(v[bj][0][2], v[bj][0][3]); w.z = cvt_pk_bf16(v[bj][1][0], v[bj][1][1]); w.w = cvt_pk_bf16(v[bj][1][2], v[bj][1][3]);
                    *(u32x4*)(H + (size_t)row * 3584 + col0 + 32 * bj) = w; } }
    }
};
template <class Epi, class Sched, bool ALIGN_EPI = false, bool SP2 = false>
__device__ __forceinline__ void gemm_phase(PG8_LAS unsigned char* lds, const Gemm g, const Sched& S, const Epi& E) {
    int tid_l = threadIdx.x; asm volatile("" : "+v"(tid_l));
    const int tid = tid_l, wid = __builtin_amdgcn_readfirstlane(tid >> 6), lane = tid & 63, wr = wid >> 2, wc = wid & 3, fr = lane & 15, fq = lane >> 4;
    const int K = g.K, nt = K / BK;
    unsigned voffA[2], voffB[2];
#pragma unroll
    for (int i = 0; i < 2; ++i) { int R, C; stage_rc(tid * 16 + i * 8192, R, C); const int Rb = Epi::PERM ? ((R & ~31) + perm32(R & 31)) : R;
        voffA[i] = (unsigned)(R * K + C) * 2u; voffB[i] = (unsigned)(Rb * K + C) * 2u; }
    const size_t kstep = (size_t)(BK * 2);
    const size_t hstep = (size_t)HALF * K * 2;
    const size_t tstep = 2 * hstep;
    const unsigned ldsw = (unsigned)wid * 1024u;
    const int aoff = lds_byte(wr * 64 + fr, fq * 8), boff = lds_byte(wc * 32 + fr, fq * 8);
#define PG8_SA(b, h) (((b) * 2 + (h)) * HTB)
#define PG8_SB(b, h) ((4 + (b) * 2 + (h)) * HTB)
#define PG8_STAGE(bufoff, gbase, voff) do { _Pragma("unroll") for (int _i = 0; _i < 2; ++_i) \
        __builtin_amdgcn_global_load_lds((const unsigned*)((const char*)(gbase) + (voff)[_i]), (PG8_LAS unsigned*)(lds + (bufoff) + ldsw + _i * 8192), 16, 0, 0); } while (0)
#define PG8_LDA(dst, b, h) do { _Pragma("unroll") for (int m = 0; m < 4; ++m) _Pragma("unroll") for (int k = 0; k < 2; ++k) dst[m][k] = *(const PG8_LAS bf16x8*)(lds + PG8_SA(b, h) + aoff + m * 2048 + k * 1024); } while (0)
#define PG8_LDB(dst, b, h) do { _Pragma("unroll") for (int n = 0; n < 2; ++n) _Pragma("unroll") for (int k = 0; k < 2; ++k) dst[n][k] = *(const PG8_LAS bf16x8*)(lds + PG8_SB(b, h) + boff + n * 2048 + k * 1024); } while (0)
#define PG8_MMA(ai, bj, At, Bt) do { __builtin_amdgcn_s_setprio(1); _Pragma("unroll") for (int m = 0; m < 4; ++m) _Pragma("unroll") for (int n = 0; n < 2; ++n) _Pragma("unroll") for (int k = 0; k < 2; ++k) \
        acc[ai][bj][m][n] = __builtin_amdgcn_mfma_f32_16x16x32_bf16(Bt[n][k], At[m][k], acc[ai][bj][m][n], 0, 0, 0); __builtin_amdgcn_s_setprio(0); } while (0)
#define PG8_WAIT_V(n) asm volatile("s_waitcnt vmcnt(" #n ")" ::: "memory")
#define PG8_WAIT_L(n) asm volatile("s_waitcnt lgkmcnt(" #n ")" ::: "memory")
#define PG8_BAR __builtin_amdgcn_s_barrier()
#define PG8_SCHED __builtin_amdgcn_sched_barrier(0)
    Unit cur, nxt; int ui = 0;
    if (!S.next(0, cur)) return;
    f32x4 acc[2][2][4][2];
#pragma unroll
    for (int a = 0; a < 2; ++a)
#pragma unroll
        for (int b = 0; b < 2; ++b)
#pragma unroll
            for (int m = 0; m < 4; ++m)
#pragma unroll
                for (int n = 0; n < 2; ++n) acc[a][b][m][n] = (f32x4){0.f, 0.f, 0.f, 0.f};
    bf16x8 At[4][2], B0[2][2], B1[2][2];
    const char* cA = (const char*)g.A + (size_t)cur.pm * tstep; const char* cB = (const char*)g.Bt + (size_t)cur.pn * tstep;
    S.a_ready(cur);
    if constexpr (SP2) {
        PG8_STAGE(PG8_SB(0, 0), cB, voffB); PG8_STAGE(PG8_SB(0, 1), cB + hstep, voffB); PG8_STAGE(PG8_SA(0, 0), cA, voffA); PG8_STAGE(PG8_SA(0, 1), cA + hstep, voffA);
        if (wr == 1) PG8_BAR;
        PG8_WAIT_V(2); PG8_BAR;
        PG8_STAGE(PG8_SB(1, 0), cB + kstep, voffB); PG8_STAGE(PG8_SA(1, 0), cA + kstep, voffA); PG8_STAGE(PG8_SB(1, 1), cB + hstep + kstep, voffB);
        PG8_WAIT_V(6); PG8_BAR;
    } else {
        PG8_STAGE(PG8_SB(0, 0), cB, voffB); PG8_STAGE(PG8_SA(0, 0), cA, voffA); PG8_STAGE(PG8_SB(0, 1), cB + hstep, voffB); PG8_STAGE(PG8_SA(0, 1), cA + hstep, voffA);
        if (wr == 1) PG8_BAR;
        PG8_WAIT_V(4); PG8_BAR;
        PG8_STAGE(PG8_SB(1, 0), cB + kstep, voffB); PG8_STAGE(PG8_SA(1, 0), cA + kstep, voffA); PG8_STAGE(PG8_SB(1, 1), cB + hstep + kstep, voffB);
        PG8_WAIT_V(6); PG8_BAR;
    }
    for (;;) {
        const bool has_next = S.next(ui + 1, nxt);
        const char* nA = has_next ? (const char*)g.A + (size_t)nxt.pm * tstep : cA; const char* nB = has_next ? (const char*)g.Bt + (size_t)nxt.pn * tstep : cB;
        for (int t = 0; t < nt; t += 2) {
            const bool last = (t == nt - 2);
            const char* a1 = cA + (size_t)(t + 1) * kstep;
            const char* a2 = last ? nA : cA + (size_t)(t + 2) * kstep; const char* b2 = last ? nB : cB + (size_t)(t + 2) * kstep;
            const char* a3 = a2 + kstep; const char* b3 = b2 + kstep;
            if (last && has_next) S.a_ready(nxt);
            if constexpr (SP2) {
            PG8_LDB(B0, 0, 0); PG8_LDB(B1, 0, 1); PG8_SCHED; PG8_LDA(At, 0, 0); PG8_STAGE(PG8_SA(1, 1), a1 + hstep, voffA);
            PG8_WAIT_V(8); PG8_WAIT_L(0); PG8_BAR; PG8_MMA(0, 0, At, B0); PG8_MMA(0, 1, At, B1); PG8_BAR; PG8_SCHED;
            PG8_LDA(At, 0, 1); PG8_STAGE(PG8_SB(0, 0), b2, voffB); PG8_STAGE(PG8_SB(0, 1), b2 + hstep, voffB); PG8_STAGE(PG8_SA(0, 0), a2, voffA);
            PG8_WAIT_V(8); PG8_WAIT_L(0); PG8_BAR; PG8_MMA(1, 0, At, B0); PG8_MMA(1, 1, At, B1); PG8_BAR; PG8_SCHED;
            PG8_LDB(B0, 1, 0); PG8_LDB(B1, 1, 1); PG8_SCHED; PG8_LDA(At, 1, 0); PG8_STAGE(PG8_SA(0, 1), a2 + hstep, voffA);
            PG8_WAIT_V(8); PG8_WAIT_L(0); PG8_BAR; PG8_MMA(0, 0, At, B0); PG8_MMA(0, 1, At, B1); PG8_BAR; PG8_SCHED;
            PG8_LDA(At, 1, 1); PG8_STAGE(PG8_SB(1, 0), b3, voffB); PG8_STAGE(PG8_SB(1, 1), b3 + hstep, voffB); PG8_STAGE(PG8_SA(1, 0), a3, voffA);
            PG8_WAIT_V(8); PG8_WAIT_L(0); PG8_BAR; PG8_MMA(1, 0, At, B0); PG8_MMA(1, 1, At, B1); PG8_BAR; PG8_SCHED;
            } else {
            PG8_LDB(B0, 0, 0); PG8_SCHED; PG8_LDA(At, 0, 0); PG8_STAGE(PG8_SA(1, 1), a1 + hstep, voffA);
            PG8_WAIT_L(8); PG8_BAR; PG8_WAIT_L(0); PG8_MMA(0, 0, At, B0); PG8_BAR; PG8_SCHED;
            PG8_LDB(B1, 0, 1); PG8_STAGE(PG8_SB(0, 0), b2, voffB);
            PG8_BAR; PG8_WAIT_L(0); PG8_MMA(0, 1, At, B1); PG8_BAR;
            PG8_LDA(At, 0, 1); PG8_STAGE(PG8_SA(0, 0), a2, voffA);
            PG8_BAR; PG8_WAIT_L(0); PG8_MMA(1, 0, At, B0); PG8_BAR; PG8_SCHED;
            PG8_STAGE(PG8_SB(0, 1), b2 + hstep, voffB);
            PG8_WAIT_V(6); PG8_BAR; PG8_MMA(1, 1, At, B1); PG8_BAR;
            PG8_LDB(B0, 1, 0); PG8_SCHED; PG8_LDA(At, 1, 0); PG8_STAGE(PG8_SA(0, 1), a2 + hstep, voffA);
            PG8_WAIT_L(8); PG8_BAR; PG8_WAIT_L(0); PG8_MMA(0, 0, At, B0); PG8_BAR; PG8_SCHED;
            PG8_LDB(B1, 1, 1); PG8_STAGE(PG8_SB(1, 0), b3, voffB);
            PG8_BAR; PG8_WAIT_L(0); PG8_MMA(0, 1, At, B1); PG8_BAR;
            PG8_LDA(At, 1, 1); PG8_STAGE(PG8_SA(1, 0), a3, voffA);
            PG8_BAR; PG8_WAIT_L(0); PG8_MMA(1, 0, At, B0); PG8_BAR; PG8_SCHED;
            PG8_STAGE(PG8_SB(1, 1), b3 + hstep, voffB);
            PG8_WAIT_V(6); PG8_BAR; PG8_MMA(1, 1, At, B1); PG8_BAR;
            }
        }
        if constexpr (ALIGN_EPI) { if (wr == 0) PG8_BAR; }
        if constexpr (!Epi::AFTER_DRAIN) { E(acc, cur, wr, wc, fr, fq); S.done(cur); }
        if (!has_next) break;
#pragma unroll
        for (int a = 0; a < 2; ++a)
#pragma unroll
            for (int b = 0; b < 2; ++b)
#pragma unroll
                for (int m = 0; m < 4; ++m)
#pragma unroll
                    for (int n = 0; n < 2; ++n) acc[a][b][m][n] = (f32x4){0.f, 0.f, 0.f, 0.f};
        cur = nxt; cA = nA; cB = nB; ++ui;
        if constexpr (ALIGN_EPI) { if (wr == 1) PG8_BAR; }
    }
    PG8_WAIT_V(0);
    if constexpr (!ALIGN_EPI) { if (wr == 0) PG8_BAR; }
    PG8_BAR;
    if constexpr (Epi::AFTER_DRAIN) { E.fused(acc, cur, wr, wc, fr, fq, lds, wid, lane); S.done(cur); }
#undef PG8_SA
#undef PG8_SB
#undef PG8_STAGE
#undef PG8_LDA
#undef PG8_LDB
#undef PG8_MMA
#undef PG8_WAIT_V
#undef PG8_WAIT_L
#undef PG8_BAR
#undef PG8_SCHED
}
}
#include <hip/hip_bf16.h>
#include <cmath>
namespace attn_body {
using bf16=__hip_bfloat16;
using bf16x8=__attribute__((ext_vector_type(8)))short;
using s16x4=__attribute__((ext_vector_type(4)))short;
using f32x16=__attribute__((ext_vector_type(16)))float;
using u32x4=__attribute__((ext_vector_type(4)))unsigned;
constexpr int BATCH=4,NHEAD=8,SEQ=8192,D=64,HP=3584,OP=1024;
constexpr int NW=8,QBLK=32,QB=QBLK*NW,KVBLK=64,NQB=SEQ/QB;
constexpr int ATTN_UNIT_ROWS=QB;
__device__ __forceinline__ int crow(int r,int hi){return (r&3)+8*(r>>2)+4*hi;}
#define SBAR() __builtin_amdgcn_sched_barrier(0)
__device__ __forceinline__ void cmask(f32x16&p0,f32x16&p1,int jb,int qrel,int hi){
  const float NEG=-INFINITY; int kb=64*jb+4*hi;
  #pragma unroll
  for(int r=0;r<16;++r){int kv=kb+(r&3)+8*(r>>2); if(kv>qrel)p0[r]=NEG; if(kv+32>qrel)p1[r]=NEG;}
}

constexpr int NSLOT=3, SLOTB=8192;
constexpr int LDS_K=0, LDS_V=NSLOT*SLOTB, LDS_WS=2*NSLOT*SLOTB, LDS_OST=LDS_WS+NW*64*4, LDS_BIAS=LDS_OST+NW*4096, LDS_BYTES=LDS_BIAS+SEQ*4;
constexpr float C2=0.125f*1.4426950408889634f;
__device__ __forceinline__ void glds16(const void*gsrc,unsigned lds_dst){unsigned keep;
  asm volatile("s_mov_b32 %0, m0\n\ts_mov_b32 m0, %2\n\ts_nop 0\n\tglobal_load_lds_dwordx4 %1, off\n\ts_mov_b32 m0, %0":"=&s"(keep):"v"(gsrc),"s"(lds_dst):"memory");}
__device__ __forceinline__ float max3f(float a,float b,float c){float r;asm("v_max3_f32 %0, %1, %2, %3":"=v"(r):"v"(a),"v"(b),"v"(c));return r;}
__device__ __forceinline__ float max2f(float a,float b){float r;asm("v_max_f32_e32 %0, %1, %2":"=v"(r):"v"(a),"v"(b));return r;}
__device__ __forceinline__ float fadd_s(float a,float b){float r;asm("v_add_f32_e32 %0, %1, %2":"=v"(r):"v"(a),"v"(b));return r;}
__device__ __forceinline__ float fsub_s(float a,float b){float r;asm("v_sub_f32_e32 %0, %1, %2":"=v"(r):"v"(a),"v"(b));return r;}
typedef float f32x2_t __attribute__((ext_vector_type(2))); typedef __bf16 bf16x2_t __attribute__((ext_vector_type(2)));
__device__ __forceinline__ unsigned cvtpk_s(float lo,float hi){f32x2_t v={lo,hi};bf16x2_t b=__builtin_convertvector(v,bf16x2_t);return __builtin_bit_cast(unsigned,b);}
#define WAIT_BAR(N) asm volatile("s_waitcnt vmcnt(" #N ") lgkmcnt(0)\n\ts_barrier":::"memory")

__device__ __forceinline__ void qkt(f32x16&p0,f32x16&p1,const char*Kslot,const bf16x8*qr,const f32x16&negm,int r32,int hi){
  const char*kb=Kslot+hi*1024+r32*16;
  #pragma unroll
  for(int d0=0;d0<4;++d0){
    const bf16x8 b0=*reinterpret_cast<const bf16x8*>(kb+d0*2048);
    const bf16x8 b1=*reinterpret_cast<const bf16x8*>(kb+d0*2048+512);
    if(d0==0){p0=__builtin_amdgcn_mfma_f32_32x32x16_bf16(b0,qr[0],negm,0,0,0);p1=__builtin_amdgcn_mfma_f32_32x32x16_bf16(b1,qr[0],negm,0,0,0);}
    else{p0=__builtin_amdgcn_mfma_f32_32x32x16_bf16(b0,qr[d0],p0,0,0,0);p1=__builtin_amdgcn_mfma_f32_32x32x16_bf16(b1,qr[d0],p1,0,0,0);}}
}
typedef __attribute__((address_space(3))) const char* lds_cptr;
typedef short v4i16_t __attribute__((ext_vector_type(4)));
__device__ __forceinline__ void kload8(bf16x8*kf,lds_cptr kp){
  kf[0]=*(const __attribute__((address_space(3))) bf16x8*)(kp);      kf[1]=*(const __attribute__((address_space(3))) bf16x8*)(kp+512);
  kf[2]=*(const __attribute__((address_space(3))) bf16x8*)(kp+2048); kf[3]=*(const __attribute__((address_space(3))) bf16x8*)(kp+2560);
  kf[4]=*(const __attribute__((address_space(3))) bf16x8*)(kp+4096); kf[5]=*(const __attribute__((address_space(3))) bf16x8*)(kp+4608);
  kf[6]=*(const __attribute__((address_space(3))) bf16x8*)(kp+6144); kf[7]=*(const __attribute__((address_space(3))) bf16x8*)(kp+6656);
}
__device__ __forceinline__ void kload2(bf16x8*kf,lds_cptr kp,int j){ kf[2*j]=*(const __attribute__((address_space(3))) bf16x8*)(kp+j*2048); kf[2*j+1]=*(const __attribute__((address_space(3))) bf16x8*)(kp+j*2048+512); }
__device__ __forceinline__ s16x4 vtr(lds_cptr p){ return __builtin_bit_cast(s16x4,__builtin_amdgcn_ds_read_tr16_b64_v4i16((__attribute__((address_space(3))) v4i16_t*)p)); }
__device__ __forceinline__ float rowmax(const f32x16&p0,const f32x16&p1){
  float a=max3f(p0[0],p0[1],p1[0]),b=max3f(p0[2],p0[3],p1[1]);a=max3f(a,p1[2],p1[3]);
  #pragma unroll
  for(int r=4;r<16;r+=4){a=max3f(a,p0[r],p0[r+1]);b=max3f(b,p0[r+2],p0[r+3]);a=max3f(a,p1[r],p1[r+1]);b=max3f(b,p1[r+2],p1[r+3]);}
  const float m=max2f(a,b);
  auto rr=__builtin_amdgcn_permlane32_swap(__float_as_uint(m),__float_as_uint(m),false,false);
  return max2f(__uint_as_float(rr[0]),__uint_as_float(rr[1]));
}
__device__ __forceinline__ void pv(f32x16*o,int vb,bf16x8 pa0,bf16x8 pa1,bf16x8 pa2,bf16x8 pa3){
  #pragma unroll
  for(int d0=0;d0<2;++d0){s16x4 lo[4],hi[4];
    #pragma unroll
    for(int ks=0;ks<4;++ks){
      asm volatile("ds_read_b64_tr_b16 %0,%1 offset:%c2":"=&v"(lo[ks]):"v"(vb),"i"(d0*4096+ks*1024):"memory");
      asm volatile("ds_read_b64_tr_b16 %0,%1 offset:%c2":"=&v"(hi[ks]):"v"(vb),"i"(d0*4096+ks*1024+512):"memory");}
    asm volatile("s_waitcnt lgkmcnt(0)":::"memory");SBAR();
    #define PK(k) (bf16x8){lo[k][0],lo[k][1],lo[k][2],lo[k][3],hi[k][0],hi[k][1],hi[k][2],hi[k][3]}
    o[d0]=__builtin_amdgcn_mfma_f32_32x32x16_bf16(pa0,PK(0),o[d0],0,0,0);
    o[d0]=__builtin_amdgcn_mfma_f32_32x32x16_bf16(pa1,PK(1),o[d0],0,0,0);
    o[d0]=__builtin_amdgcn_mfma_f32_32x32x16_bf16(pa2,PK(2),o[d0],0,0,0);
    o[d0]=__builtin_amdgcn_mfma_f32_32x32x16_bf16(pa3,PK(3),o[d0],0,0,0);
    #undef PK
  }
}

#ifndef ATTN_STORE16
#define ATTN_STORE16(p,v) (*(u32x4*)(p)=(v))
#endif
constexpr float ATT_SKIP_LOG2=44.0f;
template<int THRL> __device__ __forceinline__ void attn_unit(int b,int h,int qb,const bf16*Q,const bf16*__restrict__ K,const bf16*__restrict__ V,bf16*O,const float*__restrict__ cum2,const float*__restrict__ qg,const float*__restrict__ kg,char*shm){
  int tid_l=threadIdx.x; asm volatile("":"+v"(tid_l)); const int tid=tid_l,lane=tid&63,r32=lane&31,hi=lane>>5; const int wid=__builtin_amdgcn_readfirstlane(tid>>6);
  const long rowbase=(long)b*SEQ; const int q0=qb*QB;
  const bf16*Qw=Q+(rowbase+q0+wid*QBLK)*HP+h*D;
  typedef float f32x4b __attribute__((ext_vector_type(4)));
  const float* cb=cum2+(long)(b*NHEAD+h)*SEQ; const float cref=cb[q0];
  f32x4b cpre[4];
  #pragma unroll
  for(int k_=0;k_<4;++k_){ const int i=tid*4+k_*NW*64*4; cpre[k_]=(i<q0+QB)?*(const f32x4b*)(cb+i):(f32x4b){0.f,0.f,0.f,0.f}; }
  bf16x8 qr[4];
  #pragma unroll
  for(int d0=0;d0<4;++d0)qr[d0]=*reinterpret_cast<const bf16x8*>(&Qw[(long)r32*HP+d0*16+hi*8]);
  int T0;
  { float gq=fabsf(qg[lane]),gk=fabsf(kg[lane]);
    #pragma unroll
    for(int o=1;o<64;o<<=1){gq=fmaxf(gq,__shfl_xor(gq,o));gk=fmaxf(gk,__shfl_xor(gk,o));}
    const float thresh=2.0f*(8.0f*1.4426950408889634f*1.02f*gq*gk)+ATT_SKIP_LOG2;
    const int ntf=(q0+QB)/KVBLK; const int j0=lane,j1=lane+64;
    const bool s0=(j0<ntf-4)&&(cref-cb[64*j0+63]<-thresh); const bool s1=(j1<ntf-4)&&(cref-cb[64*j1+63]<-thresh);
    const int nskip=__popcll(__ballot(s0))+__popcll(__ballot(s1));
    T0=__builtin_amdgcn_readfirstlane(nskip&~1); }
  const bf16*Kh=K+(rowbase+(long)T0*KVBLK)*HP+h*D,*Vh=V+(rowbase+(long)T0*KVBLK)*HP+h*D;
  const lds_cptr shm3=(lds_cptr)shm; const unsigned lds0=(unsigned)(uintptr_t)shm;
  float*wsf=(float*)(shm+LDS_WS)+wid*64;
  const bf16*ksrc=Kh+(long)lane*HP+wid*8;
  const bf16*vsrc=Vh+(long)(16*(wid&3)+(lane>>2))*HP+(wid>>2)*32+(lane&3)*8;
  const unsigned kdst=lds0+LDS_K+wid*1024, vdst=lds0+LDS_V+wid*1024;
  #define DMA_K(t,slot) glds16(ksrc+(long)(t)*KVBLK*HP,(unsigned)__builtin_amdgcn_readfirstlane(kdst+(slot)))
  #define DMA_V(t,slot) glds16(vsrc+(long)(t)*KVBLK*HP,(unsigned)__builtin_amdgcn_readfirstlane(vdst+(slot)))
  const int vb0=(int)(lds0+LDS_V)+((lane>>4)&1)*32+(lane&3)*8+(4*hi+((lane&15)>>2))*64;
  const char*Kbase=shm+LDS_K; bf16x8 kf[8];
  const lds_cptr kp0=shm3+LDS_K+hi*1024+r32*16; const lds_cptr vp0=shm3+LDS_V+((lane>>4)&1)*32+(lane&3)*8+(4*hi+((lane&15)>>2))*64;
  const int NT=(q0+QB)/KVBLK-T0;
  { __attribute__((address_space(3))) float* bl=(__attribute__((address_space(3))) float*)(shm3+LDS_BIAS);
    #pragma unroll
    for(int k_=0;k_<4;++k_){ const int i=tid*4+k_*NW*64*4; if(i<q0+QB){ const f32x4b c=cpre[k_]; *(__attribute__((address_space(3))) f32x4b*)(bl+i)=(f32x4b){cref-c[0],cref-c[1],cref-c[2],cref-c[3]}; } }
    asm volatile("s_waitcnt vmcnt(0) lgkmcnt(0)":::"memory"); }
  const __attribute__((address_space(3))) float* biasL=(const __attribute__((address_space(3))) float*)(shm3+LDS_BIAS)+T0*KVBLK+4*hi;
  #define BIASADD(C0,C1,t) do{ const __attribute__((address_space(3))) float* bp_=biasL+64*(t); \
    _Pragma("unroll") for(int j_=0;j_<4;++j_){ const f32x4b b0_=*(const __attribute__((address_space(3))) f32x4b*)(bp_+8*j_); const f32x4b b1_=*(const __attribute__((address_space(3))) f32x4b*)(bp_+32+8*j_); \
      C0[4*j_]+=b0_[0];C0[4*j_+1]+=b0_[1];C0[4*j_+2]+=b0_[2];C0[4*j_+3]+=b0_[3]; C1[4*j_]+=b1_[0];C1[4*j_+1]+=b1_[1];C1[4*j_+2]+=b1_[2];C1[4*j_+3]+=b1_[3]; SBAR(); } }while(0)
  DMA_K(0,0);DMA_V(0,0);DMA_K(1,SLOTB);
  const __attribute__((address_space(3))) bf16x8* qst=(const __attribute__((address_space(3))) bf16x8*)(shm3+LDS_OST+wid*4096+lane*16);
  #pragma unroll
  for(int d0=0;d0<4;++d0)*(__attribute__((address_space(3))) bf16x8*)(shm3+LDS_OST+wid*4096+lane*16+d0*1024)=qr[d0];
  #define QLD(d) (qst[(d)*64])
  float mhat=0.f,l_reg=0.f;f32x16 o[2];o[0]=f32x16{};o[1]=f32x16{};f32x16 negm=f32x16{};asm volatile("":"+v"(negm));
  const int qrel=wid*QBLK+r32;
  #define CMASK(P0,P1,t) do{int jb_=(t)-(NT-4); if(jb_>=0)cmask(P0,P1,jb_,qrel,hi);}while(0)
  bool resc=false;
  #define START(P0,P1) do{ const float rm=*(const __attribute__((address_space(3))) float*)(shm3+LDS_BIAS+4*(q0+qrel)); resc=false; \
    { const float dl=rm; mhat=fadd_s(mhat,dl); \
      _Pragma("unroll") for(int r=0;r<16;++r){P0[r]=fsub_s(P0[r],dl);P1[r]=fsub_s(P1[r],dl);} \
      _Pragma("unroll") for(int r=0;r<16;++r)negm[r]=-mhat; asm volatile("":"+v"(negm)); } \
    _Pragma("unroll") for(int r=0;r<16;++r)P0[r]=__builtin_amdgcn_exp2f(P0[r]); }while(0)
  #define RESC() do{ if(resc){ asm volatile("s_waitcnt lgkmcnt(0)":::"memory"); \
      _Pragma("unroll") for(int d_=0;d_<2;++d_) _Pragma("unroll") for(int r=0;r<16;++r)o[d_][r]*=wsf[crow(r,hi)]; } }while(0)
  f32x16 pA0,pA1,pB0,pB1;
  int sl_prev=0,sl_cur=0,sl_next=SLOTB;
  #define ROT() do{sl_prev=sl_cur;sl_cur=sl_next;sl_next=(sl_next==(NSLOT-1)*SLOTB)?0:sl_next+SLOTB;}while(0)
  DMA_K(2,2*SLOTB);
  WAIT_BAR(3);
  qkt(pA0,pA1,Kbase,qr,negm,r32,hi);asm volatile("s_nop 15\n\ts_nop 7":"+v"(pA0),"+v"(pA1));BIASADD(pA0,pA1,0);CMASK(pA0,pA1,0);
  START(pA0,pA1);
  _Pragma("unroll") for(int r=0;r<16;++r)pA1[r]=__builtin_amdgcn_exp2f(pA1[r]);
  WAIT_BAR(0);
  DMA_K(3,0);DMA_V(1,SLOTB);
  ROT();
  kload8(kf,kp0+sl_cur);
  WAIT_BAR(2);
  s16x4 vlo[8],vhi[8]; u32x4 pw0,pw1,pw2,pw3;
  #define PKW(P,B) cvtpk_s(P[B],P[B+1])
  #define PAF(k) __builtin_bit_cast(bf16x8,pw##k)
  #define VFR(i) (bf16x8){vlo[i][0],vlo[i][1],vlo[i][2],vlo[i][3],vhi[i][0],vhi[i][1],vhi[i][2],vhi[i][3]}
  #define PIN(x) asm volatile("":"+v"(x))
  #define MX3(a,b,c) __builtin_fmaxf(__builtin_fmaxf((a),(b)),(c))
  #define GAPA(MF,A0,A1,A2,A3,W0,W1,PW) do{ MF; sacc+=A0; sacc+=A1; sacc+=A2; sacc+=A3; PIN(sacc); W0; W1; PIN(PW); SBAR(); }while(0)
  #define EX(v) __builtin_amdgcn_exp2f(v)
  #define GAPB(MF,X,B) do{ MF; X[B]=EX(X[B]); X[B+1]=EX(X[B+1]); X[B+2]=EX(X[B+2]); X[B+3]=EX(X[B+3]); PIN(X); SBAR(); }while(0)
  #define VRD(i) do{ vlo[i]=vtr(vp_+(((i)>>2)*4096+((i)&3)*1024)); vhi[i]=vtr(vp_+(((i)>>2)*4096+((i)&3)*1024+512)); }while(0)
  #define KRD(G,j) do{ if(G){ kload2(kf,kp0+sl_next,j); SBAR(); } }while(0)
  #define STEP(C0,C1,P0,P1,t,GK,GV,GL) do{ SBAR(); \
    const lds_cptr vp_=vp0+sl_prev; \
    bf16x8 qa_=QLD(0), qb_=QLD(1); VRD(0); SBAR(); float sacc=(P0[0]+P0[1]); \
    GAPA(C0=__builtin_amdgcn_mfma_f32_32x32x16_bf16(kf[0],qa_,negm,0,0,0), P0[2],P0[3],P0[4],P0[5],     pw0[0]=PKW(P0,0), pw0[1]=PKW(P0,2), pw0); \
    VRD(4); SBAR(); GAPA(C1=__builtin_amdgcn_mfma_f32_32x32x16_bf16(kf[1],qa_,negm,0,0,0), P0[6],P0[7],P0[8],P0[9],     pw0[2]=PKW(P0,4), pw0[3]=PKW(P0,6), pw0); \
    qa_=QLD(2); VRD(1); SBAR(); GAPA(C0=__builtin_amdgcn_mfma_f32_32x32x16_bf16(kf[2],qb_,C0,0,0,0),   P0[10],P0[11],P0[12],P0[13], pw1[0]=PKW(P0,8), pw1[1]=PKW(P0,10), pw1); \
    VRD(5); SBAR(); GAPA(C1=__builtin_amdgcn_mfma_f32_32x32x16_bf16(kf[3],qb_,C1,0,0,0),   P0[14],P0[15],P1[0],P1[1],   pw1[2]=PKW(P0,12),pw1[3]=PKW(P0,14), pw1); \
    qb_=QLD(3); VRD(2); SBAR(); GAPA(C0=__builtin_amdgcn_mfma_f32_32x32x16_bf16(kf[4],qa_,C0,0,0,0),   P1[2],P1[3],P1[4],P1[5],     pw2[0]=PKW(P1,0), pw2[1]=PKW(P1,2), pw2); \
    VRD(6); SBAR(); GAPA(C1=__builtin_amdgcn_mfma_f32_32x32x16_bf16(kf[5],qa_,C1,0,0,0),   P1[6],P1[7],P1[8],P1[9],     pw2[2]=PKW(P1,4), pw2[3]=PKW(P1,6), pw2); \
    VRD(3); SBAR(); GAPA(C0=__builtin_amdgcn_mfma_f32_32x32x16_bf16(kf[6],qb_,C0,0,0,0),   P1[10],P1[11],P1[12],P1[13], pw3[0]=PKW(P1,8), pw3[1]=PKW(P1,10), pw3); \
    VRD(7); SBAR(); GAPA(C1=__builtin_amdgcn_mfma_f32_32x32x16_bf16(kf[7],qb_,C1,0,0,0),   P1[14],P1[15],0.f,0.f,       pw3[2]=PKW(P1,12),pw3[3]=PKW(P1,14), pw3); \
    l_reg+=sacc; \
    if(GK){DMA_K((t)+3,sl_cur);} if(GV){DMA_V((t)+1,sl_next);} \
    BIASADD(C0,C1,t); CMASK(C0,C1,t); \
    { float a=MX3(C0[0],C0[1],C1[0]),b=MX3(C0[2],C0[3],C1[1]); a=MX3(a,C1[2],C1[3]); \
      _Pragma("unroll") for(int r=4;r<16;r+=4){a=MX3(a,C0[r],C0[r+1]);b=MX3(b,C0[r+2],C0[r+3]);a=MX3(a,C1[r],C1[r+1]);b=MX3(b,C1[r+2],C1[r+3]);} \
      float rm=__builtin_fmaxf(a,b); { auto rr=__builtin_amdgcn_permlane32_swap(__float_as_uint(rm),__float_as_uint(rm),false,false); rm=__builtin_fmaxf(__uint_as_float(rr[0]),__uint_as_float(rr[1])); } \
      resc=false; \
      if(__builtin_expect(__any(rm>(float)THRL),0)){ const float dl=__builtin_fmaxf(rm,0.f); mhat+=dl; \
        _Pragma("unroll") for(int r=0;r<16;++r){C0[r]-=dl;C1[r]-=dl;} \
        _Pragma("unroll") for(int r=0;r<16;++r)negm[r]=-mhat; asm volatile("":"+v"(negm)); \
        const float f=__builtin_amdgcn_exp2f(-dl); l_reg*=f; if(hi==0)wsf[r32]=f; resc=true; } } \
    SBAR(); \
    GAPB(o[0]=__builtin_amdgcn_mfma_f32_32x32x16_bf16(PAF(0),VFR(0),o[0],0,0,0), C0,0); \
    GAPB(o[1]=__builtin_amdgcn_mfma_f32_32x32x16_bf16(PAF(0),VFR(4),o[1],0,0,0), C0,4); \
    KRD(GL,0); GAPB(o[0]=__builtin_amdgcn_mfma_f32_32x32x16_bf16(PAF(1),VFR(1),o[0],0,0,0), C0,8); \
    KRD(GL,1); GAPB(o[1]=__builtin_amdgcn_mfma_f32_32x32x16_bf16(PAF(1),VFR(5),o[1],0,0,0), C0,12); \
    KRD(GL,2); GAPB(o[0]=__builtin_amdgcn_mfma_f32_32x32x16_bf16(PAF(2),VFR(2),o[0],0,0,0), C1,0); \
    KRD(GL,3); GAPB(o[1]=__builtin_amdgcn_mfma_f32_32x32x16_bf16(PAF(2),VFR(6),o[1],0,0,0), C1,4); \
    GAPB(o[0]=__builtin_amdgcn_mfma_f32_32x32x16_bf16(PAF(3),VFR(3),o[0],0,0,0), C1,8); \
    GAPB(o[1]=__builtin_amdgcn_mfma_f32_32x32x16_bf16(PAF(3),VFR(7),o[1],0,0,0), C1,12); \
    }while(0)
  int t=1;
  #undef CMASK
  #define CMASK(P0,P1,t) do{}while(0)
  for(;t+5<NT;t+=2){
    STEP(pB0,pB1,pA0,pA1,t,true,true,true);     WAIT_BAR(2); RESC(); ROT();
    STEP(pA0,pA1,pB0,pB1,t+1,true,true,true);   WAIT_BAR(2); RESC(); ROT();
  }
  #undef CMASK
  #define CMASK(P0,P1,t) do{int jb_=(t)-(NT-4); if(jb_>=0)cmask(P0,P1,jb_,qrel,hi);}while(0)
  #define ENDW(tt) do{ if((tt)+3<NT){WAIT_BAR(2);} else if((tt)+2<NT){WAIT_BAR(1);} else {WAIT_BAR(0);} }while(0)
  for(;t+1<NT;t+=2){
    STEP(pB0,pB1,pA0,pA1,t,(t+3<NT),(t+1<NT),(t+1<NT));       ENDW(t);   RESC(); ROT();
    STEP(pA0,pA1,pB0,pB1,t+1,(t+4<NT),(t+2<NT),(t+2<NT));     ENDW(t+1); RESC(); ROT();
  }
  STEP(pB0,pB1,pA0,pA1,NT-1,false,false,false); RESC();
  { float sacc=pB0[0]+pB0[1]; _Pragma("unroll") for(int r=2;r<16;++r)sacc+=pB0[r]; _Pragma("unroll") for(int r=0;r<16;++r)sacc+=pB1[r]; l_reg+=sacc;
    pw0=(u32x4){PKW(pB0,0),PKW(pB0,2),PKW(pB0,4),PKW(pB0,6)};pw1=(u32x4){PKW(pB0,8),PKW(pB0,10),PKW(pB0,12),PKW(pB0,14)};pw2=(u32x4){PKW(pB1,0),PKW(pB1,2),PKW(pB1,4),PKW(pB1,6)};pw3=(u32x4){PKW(pB1,8),PKW(pB1,10),PKW(pB1,12),PKW(pB1,14)};
    SBAR(); pv(o,vb0+sl_cur,PAF(0),PAF(1),PAF(2),PAF(3)); }
  #undef PKW
  #undef PAF
  #undef VFR
  #undef PIN
  #undef MX3
  #undef GAPA
  #undef GAPB
  #undef EX
  #undef VRD
  #undef KRD
  #undef STEP
  #undef ENDW
  {auto rr=__builtin_amdgcn_permlane32_swap(__float_as_uint(l_reg),__float_as_uint(l_reg),false,false);l_reg=__uint_as_float(rr[0])+__uint_as_float(rr[1]);}
  if(hi==0)wsf[32+r32]=l_reg;asm volatile("s_waitcnt lgkmcnt(0)":::"memory");
  float rli[16];
  #pragma unroll
  for(int r=0;r<16;++r)rli[r]=__builtin_amdgcn_rcpf(wsf[32+crow(r,hi)]);
  bf16*Ow=O+(rowbase+q0+wid*QBLK)*OP+h*D;
  { bf16*stg=(bf16*)(shm+LDS_OST)+wid*2048;
    #pragma unroll
    for(int r=0;r<16;++r){const int orow=crow(r,hi);
      #pragma unroll
      for(int d0=0;d0<2;++d0)stg[orow*64+d0*32+r32]=__float2bfloat16(o[d0][r]*rli[r]);}
    asm volatile("s_waitcnt lgkmcnt(0)":::"memory");
    #pragma unroll
    for(int i=0;i<4;++i){const int row=i*8+(lane>>3),ch=lane&7; const u32x4 v=*(const u32x4*)(stg+row*64+ch*8); ATTN_STORE16(Ow+(long)row*OP+ch*8,v);} }
  asm volatile("s_waitcnt lgkmcnt(0)\n\ts_barrier":::"memory");
  #undef DMA_K
  #undef DMA_V
  #undef BIASADD
  #undef QLD
  #undef CMASK
  #undef START
  #undef RESC
  #undef ROT
}
constexpr int ATTN_LDS_BYTES=LDS_BYTES;
struct AttnTensors { const bf16* Q; const bf16* K; const bf16* V; bf16* O; const float* cum2; const float* qg; const float* kg; };
struct AttnUnit { int bh; int qb; };
struct StaticOrder {
  int vcu, G;
  __device__ __forceinline__ explicit StaticOrder(int grid,int block):vcu((grid%8==0)?(block%8)*(grid/8)+block/8:block),G(grid){}
  __device__ __forceinline__ bool next(int i,AttnUnit&u)const{
    if(G==256){ if(i>=4)return false; const int s=vcu&7; u.bh=vcu>>3; u.qb=(i==0)?s:(i==1)?15-s:(i==2)?16+s:31-s; return true; }
    const int j=vcu+i*G; if(j>=BATCH*NHEAD*NQB)return false; u.bh=j/NQB; const int q=j%NQB; u.qb=(q&1)?(NQB-1-(q>>1)):(q>>1); return true; }
  __device__ __forceinline__ void a_ready(const AttnUnit&)const{}
  __device__ __forceinline__ void done(const AttnUnit&)const{}
};
template<class Sched,int THRL=8> __device__ __forceinline__ void attn_phase(char*lds,const AttnTensors&T,const Sched&S){
  AttnUnit u;
  for(int i=0;S.next(i,u);++i){ S.a_ready(u); attn_unit<THRL>(u.bh/NHEAD,u.bh%NHEAD,u.qb,T.Q,T.K,T.V,T.O,T.cum2,T.qg,T.kg,lds); S.done(u); }
}
#undef SBAR
#undef WAIT_BAR
}
#include <hip/hip_cooperative_groups.h>
namespace cg = cooperative_groups;
#define LAS __attribute__((address_space(3)))
typedef unsigned short bf16;
typedef unsigned v4u __attribute__((ext_vector_type(4)));
typedef float f32x4 __attribute__((ext_vector_type(4)));
typedef short bf16x8 __attribute__((ext_vector_type(8)));
typedef unsigned short u16x8 __attribute__((ext_vector_type(8)));
constexpr int NWAVES = 8;
constexpr int M = 32768, DM = 1024, SEQL = 8192, DFF = 2816, NFF = 5632, NMIX = 3336, HPITCH = 3584, DEPTH = 2;
constexpr size_t MiB = 1u << 20;
constexpr size_t WS_QCTR = 3 * MiB, WS_BAR = 3 * MiB + 65536, WS_CTL_ZERO = 131072, WS_FOXC = 1 * MiB, WS_DEC = 2 * MiB, WS_W = 4 * MiB, W_LAYER = 42 * MiB;
constexpr size_t WO_1IN = 0, WO_1OUT = 11 * MiB, WO_MIX = 16 * MiB + MiB / 2, WO_MO = 23 * MiB + MiB / 2, WO_2IN = 25 * MiB + MiB / 2, WO_2OUT = 36 * MiB + MiB / 2;
constexpr size_t WS_XB = 88 * MiB, WS_HACT = 152 * MiB, WS_Y = 376 * MiB, WS_HST = 440 * MiB, WS_RS = 472 * MiB, WS_END = 474 * MiB;
constexpr int LDS_BYTES = 147456;
static_assert(attn_body::LDS_BYTES <= 131072, "attention LDS");

__device__ __forceinline__ unsigned f2bf(float f) { unsigned u = __builtin_bit_cast(unsigned, f); return (u + 0x7fffu + ((u >> 16) & 1u)) >> 16; }
__device__ __forceinline__ unsigned pk2(float lo, float hi) { unsigned r; asm("v_cvt_pk_bf16_f32 %0, %1, %2" : "=v"(r) : "v"(lo), "v"(hi)); return r; }
__device__ __forceinline__ float bf2f(unsigned short b) { return __builtin_bit_cast(float, (unsigned)b << 16); }
__device__ __forceinline__ float wave_sum(float v) {
#pragma unroll
    for (int o = 1; o < 64; o <<= 1) v += __shfl_xor(v, o);
    return v;
}
#define LDS_WAIT() asm volatile("s_waitcnt lgkmcnt(0)" ::: "memory")

__device__ __forceinline__ int dst_row(int mode, int c) {
    if (mode == 1) { const int half = c / DFF, j = c - half * DFF; return 256 * (j >> 7) + 128 * half + (j & 127); }
    if (mode == 2) { const int pn = c >> 8, w = c & 255; return 256 * pn + 128 * ((w & 63) >> 5) + 32 * (w >> 6) + (w & 31); }
    return c;
}
__device__ __forceinline__ void tr_item(const float* W, int K, int N, int nblk, const float* gain, bf16* WT, int mode, LAS float* scr, int item, int lane) {
    const int kb = item / nblk, nb = item % nblk, k0 = 64 * kb, n0 = 32 * nb;
    const int c = n0 + (lane & 31);
    float wv[32];
#pragma unroll
    for (int i = 0; i < 32; ++i) { const int kk = 2 * i + (lane >> 5); wv[i] = (c < N) ? __builtin_nontemporal_load(W + (size_t)(k0 + kk) * N + c) : 0.f;     }
    if (gain) {
#pragma unroll
        for (int i = 0; i < 32; ++i) wv[i] *= gain[k0 + 2 * i + (lane >> 5)]; }
#pragma unroll
    for (int i = 0; i < 32; ++i) scr[(2 * i + (lane >> 5)) * 33 + (lane & 31)] = wv[i];
    LDS_WAIT(); asm volatile("" ::: "memory");
    const int c8 = lane & 7;
#pragma unroll
    for (int j = 0; j < 4; ++j) { const int n = (lane >> 3) + 8 * j; const LAS float* s = scr + (8 * c8) * 33 + n;
        v4u o; o.x = pk2(s[0 * 33], s[1 * 33]); o.y = pk2(s[2 * 33], s[3 * 33]); o.z = pk2(s[4 * 33], s[5 * 33]); o.w = pk2(s[6 * 33], s[7 * 33]);
        *(v4u*)(WT + (size_t)dst_row(mode, n0 + n) * K + k0 + 8 * c8) = o; }
    LDS_WAIT(); asm volatile("" ::: "memory");
}

#define XB_TMO      128
#define XB_XCNT(j)  (256  + 64 * (j))
#define XB_XSUB(j)  (1280 + 64 * (j))
#define XB_XGEN(j)  (2304 + 64 * (j))
#define XB_TOP      3328
#define XB_TOPGEN   3392
#define XCD_BAR_WORDS 3456
#define XB_SPIN_CAP (1u << 18)

__device__ __forceinline__ unsigned xb_ld(unsigned* p)              { return __hip_atomic_load(p, __ATOMIC_RELAXED, __HIP_MEMORY_SCOPE_AGENT); }
__device__ __forceinline__ unsigned xb_add(unsigned* p, unsigned v) { return __hip_atomic_fetch_add(p, v, __ATOMIC_RELAXED, __HIP_MEMORY_SCOPE_AGENT); }
__device__ __forceinline__ unsigned xb_xcc_id() { return (unsigned)__builtin_amdgcn_s_getreg((3 << 11) | 20) & 0xFu; }
#define XB_SPIN(cond, bar) do { unsigned _sp = 0; while (cond) { __builtin_amdgcn_s_sleep(1); \
    if ((++_sp & 255u) == 0u) { if (xb_ld(&(bar)[XB_TMO])) break; if (_sp > XB_SPIN_CAP) { atomicAdd(&(bar)[XB_TMO], 1u); break; } } } } while (0)

struct XcdBarrier {
    unsigned* bar; unsigned x;
    volatile LAS unsigned* st;
};

__device__ __forceinline__ XcdBarrier xcd_barrier_post(unsigned* bar, volatile LAS unsigned* st) {
    XcdBarrier b; b.bar = bar; b.x = xb_xcc_id(); b.st = st;
    if (threadIdx.x == 0) (void)xb_add(&bar[XB_XCNT(b.x)], 1u);
    return b;
}
__device__ __forceinline__ void xcd_barrier_complete(unsigned* bar, unsigned x, unsigned& nloc, unsigned& nx) {
    const unsigned G = gridDim.x * gridDim.y * gridDim.z;
    unsigned sum, cnt, mine, sp = 0u;
    for (;;) {
        sum = 0u; cnt = 0u; mine = 0u;
#pragma unroll
        for (unsigned j = 0; j < 16; ++j) { const unsigned c = xb_ld(&bar[XB_XCNT(j)]); sum += c; cnt += (c > 0u) ? 1u : 0u; mine = (j == x) ? c : mine; }
        if (sum == G) break;
        __builtin_amdgcn_s_sleep(1);
        if ((++sp & 255u) == 0u) { if (xb_ld(&bar[XB_TMO])) break; if (sp > XB_SPIN_CAP) { atomicAdd(&bar[XB_TMO], 1u); break; } }
    }
    nloc = mine > 0u ? mine : 1u; nx = cnt > 0u ? cnt : 1u;
}

__device__ __forceinline__ void xcd_barrier(const XcdBarrier& b) {
    asm volatile("s_waitcnt vmcnt(0)" ::: "memory");
    __syncthreads();
    if (threadIdx.x == 0) {
        unsigned* bar = b.bar;
        __builtin_amdgcn_s_waitcnt(0);
        unsigned nloc = b.st[0], nx = b.st[1];
        if (nloc == 0u) { xcd_barrier_complete(bar, b.x, nloc, nx); b.st[0] = nloc; b.st[1] = nx; }
        const unsigned old = xb_add(&bar[XB_XSUB(b.x)], 1u);
        const unsigned gen = old / nloc;
        if (old + 1u == (gen + 1u) * nloc) {
            __builtin_amdgcn_fence(__ATOMIC_RELEASE, "agent");
            asm volatile("s_waitcnt vmcnt(0)" ::: "memory");
            const unsigned og = xb_add(&bar[XB_TOP], 1u);
            const unsigned tg = og / nx;
            if (og + 1u == (tg + 1u) * nx) xb_add(&bar[XB_TOPGEN], 1u);
            else XB_SPIN(xb_ld(&bar[XB_TOPGEN]) == tg, bar);
            __builtin_amdgcn_fence(__ATOMIC_ACQUIRE, "agent");
            xb_add(&bar[XB_XGEN(b.x)], 1u);
            asm volatile("s_waitcnt vmcnt(0)" ::: "memory");
        } else {
            XB_SPIN(xb_ld(&bar[XB_XGEN(b.x)]) == gen, bar);
            __builtin_amdgcn_fence(__ATOMIC_ACQUIRE, "agent");
            asm volatile("s_waitcnt vmcnt(0)" ::: "memory");
        }
    }
    __syncthreads();
}


struct Args { const float* in[16]; float* out; unsigned char* ws; };
#ifndef PROBE_MASK
#define PROBE_MASK 0
#endif
#define STAMP(k) do { if (PROBE_MASK && bx == 0 && threadIdx.x == 0) ((LAS unsigned long long*)(lds + 135168))[k] = __builtin_amdgcn_s_memrealtime(); } while (0)
#ifndef XSYNC
#define XSYNC 0
#endif
#ifndef HG_REP
#define HG_REP 1
#endif
#ifndef EN_G1
#define EN_G1 1
#endif
#ifndef EN_G2
#define EN_G2 1
#endif
#ifndef EN_G3
#define EN_G3 1
#endif
#ifndef EN_MA
#define EN_MA 1
#endif
#ifndef EN_ATT
#define EN_ATT 1
#endif
#ifndef EN_MC
#define EN_MC 1
#endif
#ifndef EN_G5
#define EN_G5 1
#endif

constexpr int HL_SEG = 0, HL_B = 4096, HL_BS = 9216, HL_OL = HL_B + 7 * HL_BS, HL_TOT = HL_OL + 64 * 68 * 4, HP72 = 72;
typedef float f32x2v __attribute__((ext_vector_type(2)));
__device__ __forceinline__ float hgrn_lb(const float* logits, int l, int ch) {
    if (l == 0) return 0.f;
    const float x0 = logits[ch], x1 = logits[256 + ch], mx = fmaxf(x0, x1), e0 = __expf(x0 - mx), e1 = __expf(x1 - mx);
    return fminf(fmaxf(e1 / (e0 + e1), 0.f), 1.f);
}
__device__ __forceinline__ f32x4 mfma16(bf16x8 a, bf16x8 b, f32x4 c) { return __builtin_amdgcn_mfma_f32_16x16x32_bf16(a, b, c, 0, 0, 0); }
__device__ __forceinline__ void hgrn_front(LAS unsigned char* lds, const unsigned (&z2)[4], float lb0, float lb1, float (&lf)[2][4], float (&kk)[2][4], float (&tot)[2], float (&ref)[2], int dp, int sg) {
    LAS f32x2v* SEG = (LAS f32x2v*)(lds + HL_SEG);
#pragma unroll
    for (int j = 0; j < 4; ++j)
#pragma unroll
        for (int c = 0; c < 2; ++c) { const float lb = c ? lb1 : lb0; const float z = fmaxf(__builtin_bit_cast(float, c ? (z2[j] & 0xffff0000u) : (z2[j] << 16)), -80.f);
            const float e = __builtin_amdgcn_exp2f(-1.4426950408889634f * z), sgm = __builtin_amdgcn_rcpf(1.0f + e), f = lb + (1.0f - lb) * sgm;
            lf[c][j] = __builtin_amdgcn_logf(f); kk[c][j] = (1.0f - lb) * e * sgm; }
#pragma unroll
    for (int c = 0; c < 2; ++c) { lf[c][1] += lf[c][0]; lf[c][2] += lf[c][1]; lf[c][3] += lf[c][2]; }
    SEG[sg * 32 + dp] = (f32x2v){lf[0][3], lf[1][3]};
    __syncthreads();
    f32x2v off = (f32x2v){0.f, 0.f}, tt = off, rr = off;
#pragma unroll
    for (int q = 0; q < 16; ++q) { const f32x2v v = SEG[q * 32 + dp]; tt += v; if (q < sg) off += v; if (q < 8) rr += v; }
#pragma unroll
    for (int j = 0; j < 4; ++j) { lf[0][j] += off[0]; lf[1][j] += off[1]; }
    tot[0] = tt[0]; tot[1] = tt[1]; ref[0] = rr[0]; ref[1] = rr[1];
}
__device__ __forceinline__ void hgrn_seg_local(LAS unsigned char* lds, const bf16* H, const float* lbl, int l, float* HSEG, float* SEGDEC, int unit, int tid) {
    const int bh = unit >> 4, seg = unit & 15, b = bh >> 2, h = bh & 3, dp = tid & 31, sg = tid >> 5, lane = tid & 63, w = tid >> 6;
    const int mi = w >> 1, nj0 = 2 * (w & 1), lr = lane & 15, lq = lane >> 4;
    const bf16* hb = H + ((size_t)b * SEQL + seg * 512) * HPITCH + h * 64 + 2 * dp;
    LAS bf16* B0 = (LAS bf16*)(lds + HL_B); LAS bf16* B1 = B0 + HL_BS / 2; LAS float* TOTL = (LAS float*)(lds + HL_TOT);
    const float lb0 = hgrn_lb(lbl, l, h * 64 + 2 * dp), lb1 = hgrn_lb(lbl, l, h * 64 + 2 * dp + 1);
    unsigned z2[4], v2[4];
#pragma unroll
    for (int j = 0; j < 4; ++j) { const bf16* r = hb + (size_t)(4 * sg + j) * HPITCH; z2[j] = *(const unsigned*)(r + 1024); v2[j] = *(const unsigned*)(r + 1280); }
    f32x4 S[2] = {(f32x4){0.f, 0.f, 0.f, 0.f}, (f32x4){0.f, 0.f, 0.f, 0.f}}; float dsum0 = 0.f, dsum1 = 0.f;
#pragma unroll 1
    for (int c = 0; c < 8; ++c) {
        unsigned zn[4], vn[4];
        { const int cn = (c < 7) ? c + 1 : c;
#pragma unroll
          for (int j = 0; j < 4; ++j) { const bf16* r = hb + (size_t)(cn * 64 + 4 * sg + j) * HPITCH; zn[j] = *(const unsigned*)(r + 1024); vn[j] = *(const unsigned*)(r + 1280); } }
        float lf[2][4], kk[2][4], tot[2], ref[2];
        hgrn_front(lds, z2, lb0, lb1, lf, kk, tot, ref, dp, sg);
#pragma unroll
        for (int cc = 0; cc < 2; ++cc) { float kh[4];
#pragma unroll
            for (int j = 0; j < 4; ++j) kh[j] = kk[cc][j] * __builtin_amdgcn_exp2f(tot[cc] - lf[cc][j]);
            *(LAS pg8::u32x2*)(B0 + (2 * dp + cc) * HP72 + 4 * sg) = (pg8::u32x2){pk2(kh[0], kh[1]), pk2(kh[2], kh[3])}; }
        *(LAS pg8::u32x2*)(B1 + (2 * dp) * HP72 + 4 * sg) = (pg8::u32x2){(v2[0] & 0xffffu) | (v2[1] << 16), (v2[2] & 0xffffu) | (v2[3] << 16)};
        *(LAS pg8::u32x2*)(B1 + (2 * dp + 1) * HP72 + 4 * sg) = (pg8::u32x2){(v2[0] >> 16) | (v2[1] & 0xffff0000u), (v2[2] >> 16) | (v2[3] & 0xffff0000u)};
        if (sg == 0) { *(LAS f32x2v*)(TOTL + 2 * dp) = (f32x2v){tot[0], tot[1]}; dsum0 += tot[0]; dsum1 += tot[1]; }
        __syncthreads();
        f32x4 acc[2] = {(f32x4){0.f, 0.f, 0.f, 0.f}, (f32x4){0.f, 0.f, 0.f, 0.f}};
#pragma unroll
        for (int ks = 0; ks < 2; ++ks) { const bf16x8 a = *(const LAS bf16x8*)(B0 + (16 * mi + lr) * HP72 + 32 * ks + 8 * lq);
#pragma unroll
            for (int jn = 0; jn < 2; ++jn) { const bf16x8 bb = *(const LAS bf16x8*)(B1 + (16 * (nj0 + jn) + lr) * HP72 + 32 * ks + 8 * lq); acc[jn] = mfma16(a, bb, acc[jn]); } }
        const f32x4 tl = *(const LAS f32x4*)(TOTL + 16 * mi + 4 * lq);
        const f32x4 dec = (f32x4){__builtin_amdgcn_exp2f(tl[0]), __builtin_amdgcn_exp2f(tl[1]), __builtin_amdgcn_exp2f(tl[2]), __builtin_amdgcn_exp2f(tl[3])};
        S[0] = S[0] * dec + acc[0]; S[1] = S[1] * dec + acc[1];
#pragma unroll
        for (int j = 0; j < 4; ++j) { z2[j] = zn[j]; v2[j] = vn[j]; }
    }
    float* out = HSEG + (size_t)unit * 4096 + tid;
#pragma unroll
    for (int jn = 0; jn < 2; ++jn)
#pragma unroll
        for (int r = 0; r < 4; ++r) out[(jn * 4 + r) * 512] = S[jn][r];
    if (sg == 0) *(f32x2v*)(SEGDEC + (size_t)unit * 64 + 2 * dp) = (f32x2v){__builtin_amdgcn_exp2f(dsum0), __builtin_amdgcn_exp2f(dsum1)};
    __syncthreads();
}
__device__ __forceinline__ void hgrn_seg_out(LAS unsigned char* lds, const bf16* H, const float* lbl, int l, const float* HSEG, const float* SEGDEC, const float* ogain, bf16* Y, int unit, int tid) {
    const int bh = unit >> 4, seg = unit & 15, b = bh >> 2, h = bh & 3, dp = tid & 31, sg = tid >> 5, lane = tid & 63, w = tid >> 6, t8 = tid >> 3, cg8 = tid & 7;
    const int mi = w >> 1, nj0 = 2 * (w & 1), lr = lane & 15, lq = lane >> 4;
    const size_t row0 = (size_t)b * SEQL + seg * 512;
    const bf16* hb = H + row0 * HPITCH + h * 64;
    LAS bf16* B0 = (LAS bf16*)(lds + HL_B); LAS bf16* B1 = B0 + HL_BS / 2; LAS bf16* B2 = B1 + HL_BS / 2; LAS bf16* B3 = B2 + HL_BS / 2; LAS bf16* B4 = B3 + HL_BS / 2; LAS bf16* B5 = B4 + HL_BS / 2; LAS bf16* B6 = B5 + HL_BS / 2;
    LAS float* OL = (LAS float*)(lds + HL_OL); LAS float* TOTL = (LAS float*)(lds + HL_TOT);
    const float lb0 = hgrn_lb(lbl, l, h * 64 + 2 * dp), lb1 = hgrn_lb(lbl, l, h * 64 + 2 * dp + 1);
    const f32x4 g0 = *(const f32x4*)(ogain + cg8 * 8), g1 = *(const f32x4*)(ogain + cg8 * 8 + 4);
    unsigned z2[4], q2[4], v2[4];
#pragma unroll
    for (int j = 0; j < 4; ++j) { const bf16* r = hb + (size_t)(4 * sg + j) * HPITCH + 2 * dp; z2[j] = *(const unsigned*)(r + 1024); q2[j] = *(const unsigned*)(r + 768); v2[j] = *(const unsigned*)(r + 1280); }
    u16x8 gr = *(const u16x8*)(hb + (size_t)t8 * HPITCH + 1536 + cg8 * 8);
    f32x4 S[2] = {(f32x4){0.f, 0.f, 0.f, 0.f}, (f32x4){0.f, 0.f, 0.f, 0.f}};
#pragma unroll 2
    for (int j = 0; j < seg; ++j) { const float* Sj = HSEG + (size_t)(bh * 16 + j) * 4096 + tid; const f32x4 dj = *(const f32x4*)(SEGDEC + (size_t)(bh * 16 + j) * 64 + 16 * mi + 4 * lq);
#pragma unroll
        for (int jn = 0; jn < 2; ++jn) { f32x4 u;
#pragma unroll
            for (int r = 0; r < 4; ++r) u[r] = Sj[(jn * 4 + r) * 512];
            S[jn] = S[jn] * dj + u; } }
#pragma unroll 1
    for (int c = 0; c < 8; ++c) {
        unsigned zn[4], qn[4], vn[4]; u16x8 gn;
        { const int cn = (c < 7) ? c + 1 : c;
#pragma unroll
          for (int j = 0; j < 4; ++j) { const bf16* r = hb + (size_t)(cn * 64 + 4 * sg + j) * HPITCH + 2 * dp; zn[j] = *(const unsigned*)(r + 1024); qn[j] = *(const unsigned*)(r + 768); vn[j] = *(const unsigned*)(r + 1280); }
          gn = *(const u16x8*)(hb + (size_t)(cn * 64 + t8) * HPITCH + 1536 + cg8 * 8); }
        float lf[2][4], kk[2][4], tot[2], ref[2];
        hgrn_front(lds, z2, lb0, lb1, lf, kk, tot, ref, dp, sg);
#pragma unroll
        for (int j = 0; j < 4; ++j) { float qt[2], kt[2], qh[2];
#pragma unroll
            for (int cc = 0; cc < 2; ++cc) { const float bc = lf[cc][j], q = __builtin_bit_cast(float, cc ? (q2[j] & 0xffff0000u) : (q2[j] << 16));
                qt[cc] = q * __builtin_amdgcn_exp2f(fminf(bc - ref[cc], 115.f)); kt[cc] = kk[cc][j] * __builtin_amdgcn_exp2f(fminf(ref[cc] - bc, 115.f)); qh[cc] = q * __builtin_amdgcn_exp2f(bc); }
            const int o = (4 * sg + j) * HP72 + 2 * dp;
            *(LAS unsigned*)(B0 + o) = pk2(qt[0], qt[1]); *(LAS unsigned*)(B1 + o) = pk2(kt[0], kt[1]); *(LAS unsigned*)(B2 + o) = pk2(qh[0], qh[1]); }
#pragma unroll
        for (int cc = 0; cc < 2; ++cc) { float kh[4];
#pragma unroll
            for (int j = 0; j < 4; ++j) kh[j] = kk[cc][j] * __builtin_amdgcn_exp2f(tot[cc] - lf[cc][j]);
            *(LAS pg8::u32x2*)(B6 + (2 * dp + cc) * HP72 + 4 * sg) = (pg8::u32x2){pk2(kh[0], kh[1]), pk2(kh[2], kh[3])}; }
        *(LAS pg8::u32x2*)(B3 + (2 * dp) * HP72 + 4 * sg) = (pg8::u32x2){(v2[0] & 0xffffu) | (v2[1] << 16), (v2[2] & 0xffffu) | (v2[3] << 16)};
        *(LAS pg8::u32x2*)(B3 + (2 * dp + 1) * HP72 + 4 * sg) = (pg8::u32x2){(v2[0] >> 16) | (v2[1] & 0xffff0000u), (v2[2] >> 16) | (v2[3] & 0xffff0000u)};
#pragma unroll
        for (int jn = 0; jn < 2; ++jn) *(LAS pg8::u32x2*)(B4 + (16 * (nj0 + jn) + lr) * HP72 + 16 * mi + 4 * lq) = (pg8::u32x2){pk2(S[jn][0], S[jn][1]), pk2(S[jn][2], S[jn][3])};
        if (sg == 0) *(LAS f32x2v*)(TOTL + 2 * dp) = (f32x2v){tot[0], tot[1]};
        __syncthreads();
        f32x4 un[2] = {(f32x4){0.f, 0.f, 0.f, 0.f}, (f32x4){0.f, 0.f, 0.f, 0.f}};
        { f32x4 acc[2] = {(f32x4){0.f, 0.f, 0.f, 0.f}, (f32x4){0.f, 0.f, 0.f, 0.f}};
#pragma unroll
          for (int ks = 0; ks < 2; ++ks) { const bf16x8 a = *(const LAS bf16x8*)(B1 + (16 * mi + lr) * HP72 + 32 * ks + 8 * lq); const bf16x8 a6 = *(const LAS bf16x8*)(B6 + (16 * mi + lr) * HP72 + 32 * ks + 8 * lq);
#pragma unroll
              for (int jn = 0; jn < 2; ++jn) { const bf16x8 bb = *(const LAS bf16x8*)(B0 + (16 * (nj0 + jn) + lr) * HP72 + 32 * ks + 8 * lq); acc[jn] = mfma16(a, bb, acc[jn]);
                  const bf16x8 b3 = *(const LAS bf16x8*)(B3 + (16 * (nj0 + jn) + lr) * HP72 + 32 * ks + 8 * lq); un[jn] = mfma16(a6, b3, un[jn]); } }
#pragma unroll
          for (int jn = 0; jn < 2; ++jn) { const int t = 16 * (nj0 + jn) + lr, sp = 16 * mi + 4 * lq; float m[4];
#pragma unroll
              for (int r = 0; r < 4; ++r) m[r] = (sp + r <= t) ? acc[jn][r] : 0.f;
              *(LAS pg8::u32x2*)(B5 + t * HP72 + sp) = (pg8::u32x2){pk2(m[0], m[1]), pk2(m[2], m[3])}; } }
        const f32x4 tl = *(const LAS f32x4*)(TOTL + 16 * mi + 4 * lq);
        __syncthreads();
        { f32x4 acc[2] = {(f32x4){0.f, 0.f, 0.f, 0.f}, (f32x4){0.f, 0.f, 0.f, 0.f}};
#pragma unroll
          for (int ks = 0; ks < 2; ++ks) { const bf16x8 a = *(const LAS bf16x8*)(B3 + (16 * mi + lr) * HP72 + 32 * ks + 8 * lq);
#pragma unroll
              for (int jn = 0; jn < 2; ++jn) { const bf16x8 bb = *(const LAS bf16x8*)(B5 + (16 * (nj0 + jn) + lr) * HP72 + 32 * ks + 8 * lq); acc[jn] = mfma16(a, bb, acc[jn]); } }
#pragma unroll
          for (int ks = 0; ks < 2; ++ks) { const bf16x8 a = *(const LAS bf16x8*)(B4 + (16 * mi + lr) * HP72 + 32 * ks + 8 * lq);
#pragma unroll
              for (int jn = 0; jn < 2; ++jn) { const bf16x8 bb = *(const LAS bf16x8*)(B2 + (16 * (nj0 + jn) + lr) * HP72 + 32 * ks + 8 * lq); acc[jn] = mfma16(a, bb, acc[jn]); } }
#pragma unroll
          for (int jn = 0; jn < 2; ++jn) *(LAS f32x4*)(OL + (16 * (nj0 + jn) + lr) * 68 + 16 * mi + 4 * lq) = acc[jn]; }
        { const f32x4 dec = (f32x4){__builtin_amdgcn_exp2f(tl[0]), __builtin_amdgcn_exp2f(tl[1]), __builtin_amdgcn_exp2f(tl[2]), __builtin_amdgcn_exp2f(tl[3])};
          S[0] = S[0] * dec + un[0]; S[1] = S[1] * dec + un[1]; }
        __syncthreads();
        { const f32x4 o0 = *(const LAS f32x4*)(OL + t8 * 68 + cg8 * 8), o1 = *(const LAS f32x4*)(OL + t8 * 68 + cg8 * 8 + 4);
          float ss = (o0[0] * o0[0] + o0[1] * o0[1]) + (o0[2] * o0[2] + o0[3] * o0[3]) + (o1[0] * o1[0] + o1[1] * o1[1]) + (o1[2] * o1[2] + o1[3] * o1[3]);
          ss += __shfl_xor(ss, 1); ss += __shfl_xor(ss, 2); ss += __shfl_xor(ss, 4);
          const float rinv = rsqrtf(ss * (1.0f / 64.0f) + 1e-6f);
          float o[8];
#pragma unroll
          for (int i = 0; i < 4; ++i) { o[i] = o0[i] * rinv * g0[i] * pg8::silu_f(bf2f(gr[i])); o[4 + i] = o1[i] * rinv * g1[i] * pg8::silu_f(bf2f(gr[4 + i])); }
          *(v4u*)(Y + (row0 + c * 64 + t8) * DM + 256 + h * 64 + cg8 * 8) = (v4u){pk2(o[0], o[1]), pk2(o[2], o[3]), pk2(o[4], o[5]), pk2(o[6], o[7])}; }
#pragma unroll
        for (int j = 0; j < 4; ++j) { z2[j] = zn[j]; q2[j] = qn[j]; v2[j] = vn[j]; }
        gr = gn;
    }
    __syncthreads();
}
__device__ __forceinline__ void conv_unit(const bf16* H, const float* cw, bf16* Y, int unit, int tid) {
    const int cgp = tid & 31, tl = tid >> 5, ch = cgp * 8;
    float w0[8], w1[8], w2[8];
#pragma unroll
    for (int i = 0; i < 8; ++i) { w0[i] = cw[ch + i]; w1[i] = cw[256 + ch + i]; w2[i] = cw[512 + ch + i]; }
#pragma unroll 2
    for (int p = 0; p < 4; ++p) { const int row = unit * 64 + p * 16 + tl, t = row & (SEQL - 1);
        const bf16* hp = H + (size_t)row * HPITCH + ch;
        const u16x8 x2 = *(const u16x8*)hp, c2 = *(const u16x8*)(hp + 512), bg = *(const u16x8*)(hp + 256);
        u16x8 x1 = (u16x8){0,0,0,0,0,0,0,0}, c1 = x1, x0 = x1, c0 = x1;
        if (t >= 1) { x1 = *(const u16x8*)(hp - HPITCH); c1 = *(const u16x8*)(hp - HPITCH + 512); }
        if (t >= 2) { x0 = *(const u16x8*)(hp - 2 * HPITCH); c0 = *(const u16x8*)(hp - 2 * HPITCH + 512); }
        float o[8];
#pragma unroll
        for (int i = 0; i < 8; ++i) o[i] = bf2f(bg[i]) * (w0[i] * (bf2f(c0[i]) * bf2f(x0[i])) + w1[i] * (bf2f(c1[i]) * bf2f(x1[i])) + w2[i] * (bf2f(c2[i]) * bf2f(x2[i])));
        *(v4u*)(Y + (size_t)row * DM + ch) = (v4u){pk2(o[0], o[1]), pk2(o[2], o[3]), pk2(o[4], o[5]), pk2(o[6], o[7])}; }
}
__device__ __forceinline__ void cumsum_unit(LAS unsigned char* lds, float* C, int unit, int tid) {
    LAS float* WS = (LAS float*)lds; float* p = C + (size_t)unit * SEQL + tid * 16; const int lane = tid & 63, w = tid >> 6;
    float v[16];
#pragma unroll
    for (int j = 0; j < 4; ++j) { const f32x4 x = *(const f32x4*)(p + 4 * j); v[4 * j] = x[0]; v[4 * j + 1] = x[1]; v[4 * j + 2] = x[2]; v[4 * j + 3] = x[3]; }
#pragma unroll
    for (int i = 1; i < 16; ++i) v[i] += v[i - 1];
    const float tot = v[15]; float inc = tot;
#pragma unroll
    for (int o = 1; o < 64; o <<= 1) { const float t = __shfl_up(inc, o); if (lane >= o) inc += t; }
    if (lane == 63) WS[w] = inc;
    __syncthreads();
    float off = inc - tot;
    for (int q = 0; q < w; ++q) off += WS[q];
#pragma unroll
    for (int j = 0; j < 4; ++j) *(f32x4*)(p + 4 * j) = (f32x4){v[4 * j] + off, v[4 * j + 1] + off, v[4 * j + 2] + off, v[4 * j + 3] + off};
    __syncthreads();
}

__global__ void __launch_bounds__(NWAVES * 64, 2) fwd_mega(Args args) {
    extern __shared__ __attribute__((aligned(16))) unsigned char lds_raw[];
    cg::grid_group grid = cg::this_grid();
    LAS unsigned char* lds = (LAS unsigned char*)lds_raw;
    const int tid = threadIdx.x, lane = tid & 63, wave = __builtin_amdgcn_readfirstlane(tid >> 6);
    const int G = gridDim.x, bx = blockIdx.x; const int vcu = (G % 8 == 0) ? (bx % 8) * (G / 8) + bx / 8 : bx;
    unsigned char* ws = args.ws;
    for (int u_ = threadIdx.x; u_ < (LDS_BYTES - 131072) / 4; u_ += NWAVES * 64) ((LAS unsigned*)(lds + 131072))[u_] = 0u;
    __syncthreads();
    const XcdBarrier xbar = xcd_barrier_post((unsigned*)(ws + WS_BAR), (volatile LAS unsigned*)(lds + 140288));
#define SEAM() do { XcdBarrier b_ = xbar; asm volatile("" : "+s"(b_.x)); xcd_barrier(b_); } while (0)
    unsigned long long* RS = (unsigned long long*)(ws + WS_RS); float* FOXC = (float*)(ws + WS_FOXC); float* DEC = (float*)(ws + WS_DEC);
    unsigned* QCTR = (unsigned*)(ws + WS_QCTR);
    bf16* XB = (bf16*)(ws + WS_XB); bf16* HACT = (bf16*)(ws + WS_HACT); bf16* Y = (bf16*)(ws + WS_Y); float* HST = (float*)(ws + WS_HST);
    const float* x_in = args.in[0]; float* out = args.out;

    STAMP(0);
    {
        LAS float* scr = (LAS float*)(lds + wave * 16384);
        const int gw = vcu * NWAVES + wave, NGW = G * NWAVES;
        constexpr int I_FI = 16 * 176, I_FO = 44 * 32, I_MI = 16 * 112, I_MO = 16 * 32, I_L = 2 * I_FI + 2 * I_FO + I_MI + I_MO;
        for (int it = gw; it < DEPTH * I_L; it += NGW) {
            const int l = it / I_L; int r = it - l * I_L; unsigned char* wl = ws + WS_W + (size_t)l * W_LAYER;
            if (r < I_FI) { tr_item(args.in[2] + (size_t)l * DM * NFF, DM, NFF, 176, args.in[1] + l * DM, (bf16*)(wl + WO_1IN), 1, scr, r, lane); continue; } r -= I_FI;
            if (r < I_FO) { tr_item(args.in[3] + (size_t)l * DFF * DM, DFF, DM, 32, nullptr, (bf16*)(wl + WO_1OUT), 0, scr, r, lane); continue; } r -= I_FO;
            if (r < I_MI) { tr_item(args.in[5] + (size_t)l * DM * NMIX, DM, NMIX, 112, args.in[4] + l * DM, (bf16*)(wl + WO_MIX), 2, scr, r, lane); continue; } r -= I_MI;
            if (r < I_MO) { tr_item(args.in[12] + (size_t)l * DM * DM, DM, DM, 32, nullptr, (bf16*)(wl + WO_MO), 0, scr, r, lane); continue; } r -= I_MO;
            if (r < I_FI) { tr_item(args.in[14] + (size_t)l * DM * NFF, DM, NFF, 176, args.in[13] + l * DM, (bf16*)(wl + WO_2IN), 1, scr, r, lane); continue; } r -= I_FI;
            tr_item(args.in[15] + (size_t)l * DFF * DM, DFF, DM, 32, nullptr, (bf16*)(wl + WO_2OUT), 0, scr, r, lane);
        }
#pragma unroll 4
        for (int m = gw; m < M; m += NGW) {
            const f32x4* xr = (const f32x4*)(x_in + (size_t)m * DM) + lane; f32x4 v[4]; float s = 0.f;
#pragma unroll
            for (int j = 0; j < 4; ++j) { v[j] = __builtin_nontemporal_load(xr + 64 * j); s += (v[j][0] * v[j][0] + v[j][1] * v[j][1]) + (v[j][2] * v[j][2] + v[j][3] * v[j][3]); }
            s = wave_sum(s); if (lane == 0) RS[m] = (unsigned long long)(s * 16777216.0f);
            unsigned long long* o8 = (unsigned long long*)(XB + (size_t)m * DM) + lane;
#pragma unroll
            for (int j = 0; j < 4; ++j) o8[64 * j] = (unsigned long long)pk2(v[j][0], v[j][1]) | ((unsigned long long)pk2(v[j][2], v[j][3]) << 32);
        }
        for (int i = bx * (NWAVES * 64) + tid; i < 5 * M; i += G * NWAVES * 64) RS[M + i] = 0ull;
    }
    if (gridDim.x == 0x7fffffffu) grid.sync();
    SEAM(); STAMP(1);

#pragma unroll 1
    for (int step = 0; step < 3 * DEPTH; ++step) {
        const int l = step / 3, kind = step - 3 * l; unsigned char* wl = ws + WS_W + (size_t)l * W_LAYER;
        int tid = threadIdx.x; asm volatile("" : "+v"(tid));
        const unsigned long long* rs_in = RS + (size_t)step * M; unsigned long long* rs_out = (step + 1 < 3 * DEPTH) ? RS + (size_t)(step + 1) * M : nullptr;
        if (kind != 1) {
            const bf16* w_in = (const bf16*)(wl + (kind == 0 ? WO_1IN : WO_2IN)); const bf16* w_out = (const bf16*)(wl + (kind == 0 ? WO_1OUT : WO_2OUT));
            { pg8::Gemm g{XB, w_in, M, NFF, DM}; pg8::StaticOrder S; S.init(M, NFF, G, bx);
              pg8::EpiGlu E{HACT, DFF, rs_in};
              if (EN_G1) pg8::gemm_phase<pg8::EpiGlu, pg8::StaticOrder, true, true>(lds, g, S, E); }
            SEAM(); STAMP(2 + step * 8 + 0);
            { pg8::Gemm g{HACT, w_out, M, DM, DFF}; pg8::StaticOrder S; S.init(M, DM, G, bx);
              pg8::EpiResid E{XB, rs_out ? nullptr : out, rs_out, 0.5f};
              if (EN_G2) pg8::gemm_phase<pg8::EpiResid, pg8::StaticOrder, true, true>(lds, g, S, E); }
            if (step + 1 < 3 * DEPTH || PROBE_MASK) SEAM();
            STAMP(2 + step * 8 + 1);
        } else {
            { pg8::Gemm g{XB, (const bf16*)(wl + WO_MIX), M, HPITCH, DM}; pg8::StaticOrder S; S.init(M, HPITCH, G, bx);
              pg8::EpiMix E{HACT, rs_in, args.in[9] + l * 64, args.in[10] + l * 64, args.in[11] + l * 8, FOXC};
              if (EN_G3) pg8::gemm_phase<pg8::EpiMix, pg8::StaticOrder, true, true>(lds, g, S, E); }
            SEAM(); STAMP(2 + step * 8 + 0);
            for (int u = bx; u < 256 + 32; u += G) {
                if (u < 256) { if (EN_MA) for (int rep_ = 0; rep_ < HG_REP; ++rep_) hgrn_seg_local(lds, HACT, args.in[7], l, HST, DEC, u, tid); }
                else cumsum_unit(lds, FOXC, u - 256, tid);
            }
            SEAM(); STAMP(2 + step * 8 + 1);
            { unsigned* qc = QCTR + 64 * l; LAS unsigned* slot = (LAS unsigned*)(lds + 139264);
              for (;;) {
                  if (threadIdx.x == 0) *slot = atomicAdd(qc, 1u);
                  __syncthreads(); const int u = (int)__builtin_amdgcn_readfirstlane(*slot); __syncthreads();
                  if (u >= 1024 + 256 + 512) break;
                  if (u < 1024) { const int bh = u & 31, qb = 31 - (u >> 5);
                      if (EN_ATT) attn_body::attn_unit<48>(bh >> 3, bh & 7, qb, (const attn_body::bf16*)(HACT + 1792), (const attn_body::bf16*)(HACT + 2304), (const attn_body::bf16*)(HACT + 2816), (attn_body::bf16*)(Y + 512), FOXC, args.in[9] + l * 64, args.in[10] + l * 64, (char*)lds_raw); }
                  else if (u >= 1024 + 256) { int tq = threadIdx.x; asm volatile("" : "+v"(tq)); conv_unit(HACT, args.in[6] + l * 768, Y, u - 1280, tq); }
                  else { int tq = threadIdx.x; asm volatile("" : "+v"(tq));
                      if (EN_MC) for (int rep_ = 0; rep_ < HG_REP; ++rep_) hgrn_seg_out(lds, HACT, args.in[7], l, HST, DEC, args.in[8] + l * 64, Y, u - 1024, tq); }
              } }
            if (PROBE_MASK) { STAMP(2 + step * 8 + 2); }
            SEAM(); STAMP(2 + step * 8 + 3); STAMP(2 + step * 8 + 4);
            { pg8::Gemm g{Y, (const bf16*)(wl + WO_MO), M, DM, DM}; pg8::StaticOrder S; S.init(M, DM, G, bx);
              pg8::EpiResid E{XB, nullptr, rs_out, 1.0f};
              if (EN_G5) pg8::gemm_phase<pg8::EpiResid, pg8::StaticOrder, true, true>(lds, g, S, E); }
            SEAM(); STAMP(2 + step * 8 + 5);
        }
    }
    for (int i_ = 0; i_ < XSYNC; ++i_) SEAM();
    if (PROBE_MASK && bx == 0 && threadIdx.x == 0) {
        const LAS unsigned long long* T = (const LAS unsigned long long*)(lds + 135168);
        unsigned long long X = 0, prev = T[1];
        if (PROBE_MASK & 1) X += T[1] - T[0];
        for (int st = 0; st < 3 * DEPTH; ++st) { const LAS unsigned long long* q = T + 2 + st * 8;
            if (st % 3 != 1) { if (PROBE_MASK & 2) X += q[0] - prev; if (PROBE_MASK & 4) X += q[1] - q[0]; prev = q[1]; }
            else { if (PROBE_MASK & 8) X += q[0] - prev; if (PROBE_MASK & 16) X += q[1] - q[0]; if (PROBE_MASK & 32) X += q[2] - q[1]; if (PROBE_MASK & 64) X += q[3] - q[2];
                   if (PROBE_MASK & 128) X += q[4] - q[3]; if (PROBE_MASK & 256) X += q[5] - q[4]; prev = q[5]; } }
        const unsigned long long t0 = __builtin_amdgcn_s_memrealtime();
        while (__builtin_amdgcn_s_memrealtime() - t0 < X) __builtin_amdgcn_s_sleep(16);
    }
}

extern "C" void kernel_launch(void* const* d_in, const int* in_sizes, int n_in, void* d_out, int out_size, void* d_ws, size_t ws_size, hipStream_t stream) {
    static int grid = 0;
    if (grid == 0) {
        if (n_in != 16 || out_size != M * DM || ws_size < WS_END) { fprintf(stderr, "kernel_launch: unexpected shapes (n_in %d out %d ws %zu)\n", n_in, out_size, ws_size); grid = -1; return; }
        int dev = 0, cus = 0, per_cu = 0;
        hipGetDevice(&dev); hipDeviceGetAttribute(&cus, hipDeviceAttributeMultiprocessorCount, dev);
        hipFuncSetAttribute((const void*)fwd_mega, hipFuncAttributeMaxDynamicSharedMemorySize, LDS_BYTES);
        if (hipOccupancyMaxActiveBlocksPerMultiprocessor(&per_cu, (const void*)fwd_mega, NWAVES * 64, LDS_BYTES) != hipSuccess || per_cu < 1) { fprintf(stderr, "kernel_launch: occupancy query failed (%d)\n", per_cu); per_cu = 1; }
        (void)hipGetLastError();
        grid = cus * 1;
    }
    if (grid < 0) return;
    if (hipMemsetAsync((char*)d_ws + WS_QCTR, 0, WS_CTL_ZERO, stream) != hipSuccess) { fprintf(stderr, "kernel_launch: memset of the control words failed\n"); return; }
    Args a{};
    for (int i = 0; i < 16; ++i) a.in[i] = (const float*)d_in[i];
    a.out = (float*)d_out; a.ws = (unsigned char*)d_ws;
    void* kargs[] = {&a};
    hipError_t e = hipLaunchCooperativeKernel((const void*)fwd_mega, dim3(grid), dim3(NWAVES * 64), kargs, LDS_BYTES, stream);
    if (e != hipSuccess) fprintf(stderr, "cooperative launch failed: %s (grid %d)\n", hipGetErrorString(e), grid);
}
```

```cpp
#include <hip/hip_runtime.h>
#include <cstdio>
#include <cstdint>
namespace pg8 {
#define PG8_LAS __attribute__((address_space(3)))
typedef unsigned short bf16_t;
typedef short bf16x8 __attribute__((ext_vector_type(8)));
typedef float f32x4 __attribute__((ext_vector_type(4)));
typedef unsigned u32x4 __attribute__((ext_vector_type(4)));
constexpr int BM = 256, BK = 64, HALF = 128, HTB = HALF * BK * 2  , STAGE_BYTES = 8 * HTB, NXCD = 8, WGM = 8;

__host__ __device__ __forceinline__ int lds_byte(int r, int c) { const int st = (r >> 4) * 2 + (c >> 5), rr = r & 15, cc = c & 31, ob = rr * 64 + cc * 2; return st * 1024 + (ob ^ (((ob >> 9) & 1) << 5)); }
__host__ __device__ __forceinline__ void stage_rc(int b, int& R, int& C) { const int st = b / 1024, sb = b % 1024, swz = sb ^ (((sb >> 9) & 1) << 5); R = (st >> 1) * 16 + swz / 64; C = (st & 1) * 32 + (swz % 64) / 2; }
__host__ __device__ __forceinline__ int perm32(int rho) { const int n = rho >> 4, i = rho & 15; return 8 * (i >> 2) + 4 * n + (i & 3); }

struct Unit { int pm, pn; };
struct Gemm { const bf16_t* A; const bf16_t* Bt; int M, N, K; };

struct StaticOrder {
    int nM, nN, nwg, G, c;
    __host__ __device__ void init(int M, int N, int G_, int c_) { nM = M / BM; nN = N / BM; nwg = nM * nN; G = G_; c = c_; }
    __host__ __device__ bool next(int i, Unit& u) const {
        const long L = (long)i * G + c; if (L >= nwg) return false;
        int wgid = (int)L; { const int q = nwg / NXCD, r = nwg % NXCD, xcd = wgid % NXCD, off = wgid / NXCD; wgid = (xcd < r ? xcd * (q + 1) : r * (q + 1) + (xcd - r) * q) + off; }
        const int nig = WGM * nN, gid = wgid / nig, fm = gid * WGM, gsz = (nM - fm) < WGM ? (nM - fm) : WGM;
        u.pm = fm + ((wgid % nig) % gsz); u.pn = (wgid % nig) / gsz; return true;
    }
    __device__ __forceinline__ void a_ready(const Unit&) const {}
    __device__ __forceinline__ void done(const Unit&) const {}
};

__device__ __forceinline__ unsigned cvt_pk_bf16(float lo, float hi) { unsigned r; asm volatile("v_cvt_pk_bf16_f32 %0, %1, %2" : "=v"(r) : "v"(lo), "v"(hi)); return r; }
typedef float f32x2 __attribute__((ext_vector_type(2)));
constexpr float RMS_EPS = 1e-6f;
__device__ __forceinline__ float silu_f(float g) { return g * __builtin_amdgcn_rcpf(1.0f + __builtin_amdgcn_exp2f(-1.4426950408889634f * g)); }
struct EpiGlu {
    static constexpr bool PERM = true, AFTER_DRAIN = false;
    bf16_t* O; int ldc; const unsigned long long* rss;
    __device__ __forceinline__ void operator()(const f32x4 (&acc)[2][2][4][2], const Unit& u, int wr, int wc, int fr, int fq) const {
        const int row0 = u.pm * BM + wr * 64 + fr, col0 = u.pn * HALF + wc * 32 + 8 * fq;
        unsigned long long rv[2][4];
#pragma unroll
        for (int ai = 0; ai < 2; ++ai)
#pragma unroll
            for (int m = 0; m < 4; ++m) rv[ai][m] = rss[row0 + ai * HALF + m * 16];
#pragma unroll
        for (int ai = 0; ai < 2; ++ai)
#pragma unroll
            for (int m = 0; m < 4; ++m) { const int row = row0 + ai * HALF + m * 16; const float inv = rsqrtf((float)rv[ai][m] * (1.0f / (1024.0f * 16777216.0f)) + RMS_EPS);
                const float cexp = -1.4426950408889634f * inv, inv2 = inv * inv; u32x4 w;
#pragma unroll
                for (int n = 0; n < 2; ++n) { const f32x4 g = acc[ai][0][m][n], uu = acc[ai][1][m][n]; const f32x4 t = g * cexp;
                    const f32x4 e = (f32x4){__builtin_amdgcn_exp2f(t[0]), __builtin_amdgcn_exp2f(t[1]), __builtin_amdgcn_exp2f(t[2]), __builtin_amdgcn_exp2f(t[3])};
                    const f32x4 d = e + 1.0f;
                    const f32x4 r = (f32x4){__builtin_amdgcn_rcpf(d[0]), __builtin_amdgcn_rcpf(d[1]), __builtin_amdgcn_rcpf(d[2]), __builtin_amdgcn_rcpf(d[3])};
                    const f32x4 o = (g * uu) * (r * inv2);
                    if (n == 0) { w.x = cvt_pk_bf16(o[0], o[1]); w.y = cvt_pk_bf16(o[2], o[3]); } else { w.z = cvt_pk_bf16(o[0], o[1]); w.w = cvt_pk_bf16(o[2], o[3]); } }
                *(u32x4*)(O + (size_t)row * ldc + col0) = w; }
    }
};
typedef unsigned u32x2 __attribute__((ext_vector_type(2)));
struct EpiResid {
    static constexpr bool PERM = true, AFTER_DRAIN = false;
    bf16_t* xb; float* outf; unsigned long long* rss_next; float alpha;
    __device__ __forceinline__ void operator()(const f32x4 (&acc)[2][2][4][2], const Unit& u, int wr, int wc, int fr, int fq) const {
        const int row0 = u.pm * BM + wr * 64 + fr, col0 = u.pn * BM + wc * 32 + 8 * fq;
        u32x4 xall[2][4][2];
#pragma unroll
        for (int ai = 0; ai < 2; ++ai)
#pragma unroll
            for (int m = 0; m < 4; ++m)
#pragma unroll
                for (int bj = 0; bj < 2; ++bj) xall[ai][m][bj] = *(const u32x4*)(xb + (size_t)(row0 + ai * HALF + m * 16) * 1024 + col0 + bj * HALF);
#pragma unroll
        for (int ai = 0; ai < 2; ++ai)
#pragma unroll
            for (int m = 0; m < 4; ++m) { const int row = row0 + ai * HALF + m * 16; const size_t off = (size_t)row * 1024 + col0; float ss = 0.f;
                const u32x4 (&xin)[2] = xall[ai][m];
#pragma unroll
                for (int bj = 0; bj < 2; ++bj) {
                    const f32x4 x0 = (f32x4){__builtin_bit_cast(float, xin[bj].x << 16), __builtin_bit_cast(float, xin[bj].x & 0xffff0000u), __builtin_bit_cast(float, xin[bj].y << 16), __builtin_bit_cast(float, xin[bj].y & 0xffff0000u)};
                    const f32x4 x1 = (f32x4){__builtin_bit_cast(float, xin[bj].z << 16), __builtin_bit_cast(float, xin[bj].z & 0xffff0000u), __builtin_bit_cast(float, xin[bj].w << 16), __builtin_bit_cast(float, xin[bj].w & 0xffff0000u)};
                    const f32x4 o0 = x0 + acc[ai][bj][m][0] * alpha, o1 = x1 + acc[ai][bj][m][1] * alpha;
                    ss += (o0[0] * o0[0] + o0[1] * o0[1]) + (o0[2] * o0[2] + o0[3] * o0[3]) + (o1[0] * o1[0] + o1[1] * o1[1]) + (o1[2] * o1[2] + o1[3] * o1[3]);
                    if (outf) { __builtin_nontemporal_store(o0, (f32x4*)(outf + off + bj * HALF)); __builtin_nontemporal_store(o1, (f32x4*)(outf + off + bj * HALF + 4)); }
                    else { u32x4 w; w.x = cvt_pk_bf16(o0[0], o0[1]); w.y = cvt_pk_bf16(o0[2], o0[3]); w.z = cvt_pk_bf16(o1[0], o1[1]); w.w = cvt_pk_bf16(o1[2], o1[3]); *(u32x4*)(xb + off + bj * HALF) = w; } }
                if (rss_next) { ss += __shfl_xor(ss, 16); ss += __shfl_xor(ss, 32); if (fq == 0) atomicAdd(rss_next + row, (unsigned long long)(ss * 16777216.0f)); } }
    }
};
struct EpiMix {
    static constexpr bool PERM = true, AFTER_DRAIN = false;
    bf16_t* H; const unsigned long long* rss; const float* qgain; const float* kgain; const float* fbias; float* foxlf;
    __device__ __forceinline__ void operator()(const f32x4 (&acc)[2][2][4][2], const Unit& u, int wr, int wc, int fr, int fq) const {
        const int row0 = u.pm * BM + wr * 64 + fr, col0 = u.pn * BM + wc * 64 + 8 * fq;
        const int mode = (u.pn == 7 || u.pn == 8) ? 1 : (u.pn == 9 || u.pn == 10) ? 2 : (u.pn == 13) ? 3 : 0;
        f32x4 gv[2][2];
#pragma unroll
        for (int bj = 0; bj < 2; ++bj)
#pragma unroll
            for (int n = 0; n < 2; ++n) gv[bj][n] = (f32x4){1.f, 1.f, 1.f, 1.f};
        if (mode == 1 || mode == 2) { const float* gp = (mode == 1 ? qgain : kgain) + 8 * fq; const float sc = (mode == 1) ? 0.125f * 1.4426950408889634f : 1.0f;
#pragma unroll
            for (int bj = 0; bj < 2; ++bj)
#pragma unroll
                for (int n = 0; n < 2; ++n) gv[bj][n] = *(const f32x4*)(gp + 32 * bj + 4 * n) * sc; }
        unsigned long long rv[2][4];
#pragma unroll
        for (int ai = 0; ai < 2; ++ai)
#pragma unroll
            for (int m = 0; m < 4; ++m) rv[ai][m] = rss[row0 + ai * HALF + m * 16];
#pragma unroll
        for (int ai = 0; ai < 2; ++ai)
#pragma unroll
            for (int m = 0; m < 4; ++m) { const int row = row0 + ai * HALF + m * 16; float inv = rsqrtf((float)rv[ai][m] * (1.0f / (1024.0f * 16777216.0f)) + RMS_EPS);
                f32x4 v[2][2];
#pragma unroll
                for (int bj = 0; bj < 2; ++bj)
#pragma unroll
                    for (int n = 0; n < 2; ++n) v[bj][n] = acc[ai][bj][m][n] * inv;
                if (mode == 1 || mode == 2) { float ss = 0.f;
#pragma unroll
                    for (int bj = 0; bj < 2; ++bj)
#pragma unroll
                        for (int n = 0; n < 2; ++n) ss += (v[bj][n][0] * v[bj][n][0] + v[bj][n][1] * v[bj][n][1]) + (v[bj][n][2] * v[bj][n][2] + v[bj][n][3] * v[bj][n][3]);
                    ss += __shfl_xor(ss, 16); ss += __shfl_xor(ss, 32);
                    const float hinv = rsqrtf(ss * (1.0f / 64.0f) + RMS_EPS);
#pragma unroll
                    for (int bj = 0; bj < 2; ++bj)
#pragma unroll
                        for (int n = 0; n < 2; ++n) v[bj][n] = v[bj][n] * hinv * gv[bj][n]; }
                if (mode == 3 && wc == 0 && fq == 0) { const int b = row >> 13, t = row & 8191;
#pragma unroll
                    for (int n = 0; n < 2; ++n)
#pragma unroll
                        for (int i = 0; i < 4; ++i) { const int h = 4 * n + i; const float a = v[0][n][i] + fbias[h];
                            const float a2 = a * 1.4426950408889634f;
                            foxlf[(size_t)(b * 8 + h) * 8192 + t] = fminf(a2, 0.f) - __builtin_amdgcn_logf(1.0f + __builtin_amdgcn_exp2f(-fabsf(a2))); } }
                if (mode == 3) continue;
#pragma unroll
                for (int bj = 0; bj < 2; ++bj) { u32x4 w; w.x = cvt_pk_bf16(v[bj][0][0], v[bj][0][1]); w.y = cvt_pk_bf16(v[bj][0][2], v[bj][0][3]); w.z = cvt_pk_bf16(v[bj][1][0], v[bj][1][1]); w.w = cvt_pk_bf16(v[bj][1][2], v[bj][1][3]);
                    *(u32x4*)(H + (size_t)row * 3584 + col0 + 32 * bj) = w; } }
    }
};
template <class Epi, class Sched, bool ALIGN_EPI = false, bool SP2 = false>
__device__ __forceinline__ void gemm_phase(PG8_LAS unsigned char* lds, const Gemm g, const Sched& S, const Epi& E) {
    int tid_l = threadIdx.x; asm volatile("" : "+v"(tid_l));
    const int tid = tid_l, wid = __builtin_amdgcn_readfirstlane(tid >> 6), lane = tid & 63, wr = wid >> 2, wc = wid & 3, fr = lane & 15, fq = lane >> 4;
    const int K = g.K, nt = K / BK;
    unsigned voffA[2], voffB[2];
#pragma unroll
    for (int i = 0; i < 2; ++i) { int R, C; stage_rc(tid * 16 + i * 8192, R, C); const int Rb = Epi::PERM ? ((R & ~31) + perm32(R & 31)) : R;
        voffA[i] = (unsigned)(R * K + C) * 2u; voffB[i] = (unsigned)(Rb * K + C) * 2u; }
    const size_t kstep = (size_t)(BK * 2);
    const size_t hstep = (size_t)HALF * K * 2;
    const size_t tstep = 2 * hstep;
    const unsigned ldsw = (unsigned)wid * 1024u;
    const int aoff = lds_byte(wr * 64 + fr, fq * 8), boff = lds_byte(wc * 32 + fr, fq * 8);
#define PG8_SA(b, h) (((b) * 2 + (h)) * HTB)
#define PG8_SB(b, h) ((4 + (b) * 2 + (h)) * HTB)
#define PG8_STAGE(bufoff, gbase, voff) do { _Pragma("unroll") for (int _i = 0; _i < 2; ++_i) \
        __builtin_amdgcn_global_load_lds((const unsigned*)((const char*)(gbase) + (voff)[_i]), (PG8_LAS unsigned*)(lds + (bufoff) + ldsw + _i * 8192), 16, 0, 0); } while (0)
#define PG8_LDA(dst, b, h) do { _Pragma("unroll") for (int m = 0; m < 4; ++m) _Pragma("unroll") for (int k = 0; k < 2; ++k) dst[m][k] = *(const PG8_LAS bf16x8*)(lds + PG8_SA(b, h) + aoff + m * 2048 + k * 1024); } while (0)
#define PG8_LDB(dst, b, h) do { _Pragma("unroll") for (int n = 0; n < 2; ++n) _Pragma("unroll") for (int k = 0; k < 2; ++k) dst[n][k] = *(const PG8_LAS bf16x8*)(lds + PG8_SB(b, h) + boff + n * 2048 + k * 1024); } while (0)
#define PG8_MMA(ai, bj, At, Bt) do { __builtin_amdgcn_s_setprio(1); _Pragma("unroll") for (int m = 0; m < 4; ++m) _Pragma("unroll") for (int n = 0; n < 2; ++n) _Pragma("unroll") for (int k = 0; k < 2; ++k) \
        acc[ai][bj][m][n] = __builtin_amdgcn_mfma_f32_16x16x32_bf16(Bt[n][k], At[m][k], acc[ai][bj][m][n], 0, 0, 0); __builtin_amdgcn_s_setprio(0); } while (0)
#define PG8_WAIT_V(n) asm volatile("s_waitcnt vmcnt(" #n ")" ::: "memory")
#define PG8_WAIT_L(n) asm volatile("s_waitcnt lgkmcnt(" #n ")" ::: "memory")
#define PG8_BAR __builtin_amdgcn_s_barrier()
#define PG8_SCHED __builtin_amdgcn_sched_barrier(0)
    Unit cur, nxt; int ui = 0;
    if (!S.next(0, cur)) return;
    f32x4 acc[2][2][4][2];
#pragma unroll
    for (int a = 0; a < 2; ++a)
#pragma unroll
        for (int b = 0; b < 2; ++b)
#pragma unroll
            for (int m = 0; m < 4; ++m)
#pragma unroll
                for (int n = 0; n < 2; ++n) acc[a][b][m][n] = (f32x4){0.f, 0.f, 0.f, 0.f};
    bf16x8 At[4][2], B0[2][2], B1[2][2];
    const char* cA = (const char*)g.A + (size_t)cur.pm * tstep; const char* cB = (const char*)g.Bt + (size_t)cur.pn * tstep;
    S.a_ready(cur);
    if constexpr (SP2) {
        PG8_STAGE(PG8_SB(0, 0), cB, voffB); PG8_STAGE(PG8_SB(0, 1), cB + hstep, voffB); PG8_STAGE(PG8_SA(0, 0), cA, voffA); PG8_STAGE(PG8_SA(0, 1), cA + hstep, voffA);
        if (wr == 1) PG8_BAR;
        PG8_WAIT_V(2); PG8_BAR;
        PG8_STAGE(PG8_SB(1, 0), cB + kstep, voffB); PG8_STAGE(PG8_SA(1, 0), cA + kstep, voffA); PG8_STAGE(PG8_SB(1, 1), cB + hstep + kstep, voffB);
        PG8_WAIT_V(6); PG8_BAR;
    } else {
        PG8_STAGE(PG8_SB(0, 0), cB, voffB); PG8_STAGE(PG8_SA(0, 0), cA, voffA); PG8_STAGE(PG8_SB(0, 1), cB + hstep, voffB); PG8_STAGE(PG8_SA(0, 1), cA + hstep, voffA);
        if (wr == 1) PG8_BAR;
        PG8_WAIT_V(4); PG8_BAR;
        PG8_STAGE(PG8_SB(1, 0), cB + kstep, voffB); PG8_STAGE(PG8_SA(1, 0), cA + kstep, voffA); PG8_STAGE(PG8_SB(1, 1), cB + hstep + kstep, voffB);
        PG8_WAIT_V(6); PG8_BAR;
    }
    for (;;) {
        const bool has_next = S.next(ui + 1, nxt);
        const char* nA = has_next ? (const char*)g.A + (size_t)nxt.pm * tstep : cA; const char* nB = has_next ? (const char*)g.Bt + (size_t)nxt.pn * tstep : cB;
        for (int t = 0; t < nt; t += 2) {
            const bool last = (t == nt - 2);
            const char* a1 = cA + (size_t)(t + 1) * kstep;
            const char* a2 = last ? nA : cA + (size_t)(t + 2) * kstep; const char* b2 = last ? nB : cB + (size_t)(t + 2) * kstep;
            const char* a3 = a2 + kstep; const char* b3 = b2 + kstep;
            if (last && has_next) S.a_ready(nxt);
            if constexpr (SP2) {
            PG8_LDB(B0, 0, 0); PG8_LDB(B1, 0, 1); PG8_SCHED; PG8_LDA(At, 0, 0); PG8_STAGE(PG8_SA(1, 1), a1 + hstep, voffA);
            PG8_WAIT_V(8); PG8_WAIT_L(0); PG8_BAR; PG8_MMA(0, 0, At, B0); PG8_MMA(0, 1, At, B1); PG8_BAR; PG8_SCHED;
            PG8_LDA(At, 0, 1); PG8_STAGE(PG8_SB(0, 0), b2, voffB); PG8_STAGE(PG8_SB(0, 1), b2 + hstep, voffB); PG8_STAGE(PG8_SA(0, 0), a2, voffA);
            PG8_WAIT_V(8); PG8_WAIT_L(0); PG8_BAR; PG8_MMA(1, 0, At, B0); PG8_MMA(1, 1, At, B1); PG8_BAR; PG8_SCHED;
            PG8_LDB(B0, 1, 0); PG8_LDB(B1, 1, 1); PG8_SCHED; PG8_LDA(At, 1, 0); PG8_STAGE(PG8_SA(0, 1), a2 + hstep, voffA);
            PG8_WAIT_V(8); PG8_WAIT_L(0); PG8_BAR; PG8_MMA(0, 0, At, B0); PG8_MMA(0, 1, At, B1); PG8_BAR; PG8_SCHED;
            PG8_LDA(At, 1, 1); PG8_STAGE(PG8_SB(1, 0), b3, voffB); PG8_STAGE(PG8_SB(1, 1), b3 + hstep, voffB); PG8_STAGE(PG8_SA(1, 0), a3, voffA);
            PG8_WAIT_V(8); PG8_WAIT_L(0); PG8_BAR; PG8_MMA(1, 0, At, B0); PG8_MMA(1, 1, At, B1); PG8_BAR; PG8_SCHED;
            } else {
            PG8_LDB(B0, 0, 0); PG8_SCHED; PG8_LDA(At, 0, 0); PG8_STAGE(PG8_SA(1, 1), a1 + hstep, voffA);
            PG8_WAIT_L(8); PG8_BAR; PG8_WAIT_L(0); PG8_MMA(0, 0, At, B0); PG8_BAR; PG8_SCHED;
            PG8_LDB(B1, 0, 1); PG8_STAGE(PG8_SB(0, 0), b2, voffB);
            PG8_BAR; PG8_WAIT_L(0); PG8_MMA(0, 1, At, B1); PG8_BAR;
            PG8_LDA(At, 0, 1); PG8_STAGE(PG8_SA(0, 0), a2, voffA);
            PG8_BAR; PG8_WAIT_L(0); PG8_MMA(1, 0, At, B0); PG8_BAR; PG8_SCHED;
            PG8_STAGE(PG8_SB(0, 1), b2 + hstep, voffB);
            PG8_WAIT_V(6); PG8_BAR; PG8_MMA(1, 1, At, B1); PG8_BAR;
            PG8_LDB(B0, 1, 0); PG8_SCHED; PG8_LDA(At, 1, 0); PG8_STAGE(PG8_SA(0, 1), a2 + hstep, voffA);
            PG8_WAIT_L(8); PG8_BAR; PG8_WAIT_L(0); PG8_MMA(0, 0, At, B0); PG8_BAR; PG8_SCHED;
            PG8_LDB(B1, 1, 1); PG8_STAGE(PG8_SB(1, 0), b3, voffB);
            PG8_BAR; PG8_WAIT_L(0); PG8_MMA(0, 1, At, B1); PG8_BAR;
            PG8_LDA(At, 1, 1); PG8_STAGE(PG8_SA(1, 0), a3, voffA);
            PG8_BAR; PG8_WAIT_L(0); PG8_MMA(1, 0, At, B0); PG8_BAR; PG8_SCHED;
            PG8_STAGE(PG8_SB(1, 1), b3 + hstep, voffB);
            PG8_WAIT_V(6); PG8_BAR; PG8_MMA(1, 1, At, B1); PG8_BAR;
            }
        }
        if constexpr (ALIGN_EPI) { if (wr == 0) PG8_BAR; }
        if constexpr (!Epi::AFTER_DRAIN) { E(acc, cur, wr, wc, fr, fq); S.done(cur); }
        if (!has_next) break;
#pragma unroll
        for (int a = 0; a < 2; ++a)
#pragma unroll
            for (int b = 0; b < 2; ++b)
#pragma unroll
                for (int m = 0; m < 4; ++m)
#pragma unroll
                    for (int n = 0; n < 2; ++n) acc[a][b][m][n] = (f32x4){0.f, 0.f, 0.f, 0.f};
        cur = nxt; cA = nA; cB = nB; ++ui;
        if constexpr (ALIGN_EPI) { if (wr == 1) PG8_BAR; }
    }
    PG8_WAIT_V(0);
    if constexpr (!ALIGN_EPI) { if (wr == 0) PG8_BAR; }
    PG8_BAR;
    if constexpr (Epi::AFTER_DRAIN) { E.fused(acc, cur, wr, wc, fr, fq, lds, wid, lane); S.done(cur); }
#undef PG8_SA
#undef PG8_SB
#undef PG8_STAGE
#undef PG8_LDA
#undef PG8_LDB
#undef PG8_MMA
#undef PG8_WAIT_V
#undef PG8_WAIT_L
#undef PG8_BAR
#undef PG8_SCHED
}
}
#include <hip/hip_bf16.h>
#include <cmath>
namespace attn_body {
using bf16=__hip_bfloat16;
using bf16x8=__attribute__((ext_vector_type(8)))short;
using s16x4=__attribute__((ext_vector_type(4)))short;
using f32x16=__attribute__((ext_vector_type(16)))float;
using u32x4=__attribute__((ext_vector_type(4)))unsigned;
constexpr int BATCH=4,NHEAD=8,SEQ=8192,D=64,HP=3584,OP=1024;
constexpr int NW=8,QBLK=32,QB=QBLK*NW,KVBLK=64,NQB=SEQ/QB;
constexpr int ATTN_UNIT_ROWS=QB;
__device__ __forceinline__ int crow(int r,int hi){return (r&3)+8*(r>>2)+4*hi;}
#define SBAR() __builtin_amdgcn_sched_barrier(0)
__device__ __forceinline__ void cmask(f32x16&p0,f32x16&p1,int jb,int qrel,int hi){
  const float NEG=-INFINITY; int kb=64*jb+4*hi;
  #pragma unroll
  for(int r=0;r<16;++r){int kv=kb+(r&3)+8*(r>>2); if(kv>qrel)p0[r]=NEG; if(kv+32>qrel)p1[r]=NEG;}
}

constexpr int NSLOT=3, SLOTB=8192;
constexpr int LDS_K=0, LDS_V=NSLOT*SLOTB, LDS_WS=2*NSLOT*SLOTB, LDS_OST=LDS_WS+NW*64*4, LDS_BIAS=LDS_OST+NW*4096, LDS_BYTES=LDS_BIAS+SEQ*4;
constexpr float C2=0.125f*1.4426950408889634f;
__device__ __forceinline__ void glds16(const void*gsrc,unsigned lds_dst){unsigned keep;
  asm volatile("s_mov_b32 %0, m0\n\ts_mov_b32 m0, %2\n\ts_nop 0\n\tglobal_load_lds_dwordx4 %1, off\n\ts_mov_b32 m0, %0":"=&s"(keep):"v"(gsrc),"s"(lds_dst):"memory");}
__device__ __forceinline__ float max3f(float a,float b,float c){float r;asm("v_max3_f32 %0, %1, %2, %3":"=v"(r):"v"(a),"v"(b),"v"(c));return r;}
__device__ __forceinline__ float max2f(float a,float b){float r;asm("v_max_f32_e32 %0, %1, %2":"=v"(r):"v"(a),"v"(b));return r;}
__device__ __forceinline__ float fadd_s(float a,float b){float r;asm("v_add_f32_e32 %0, %1, %2":"=v"(r):"v"(a),"v"(b));return r;}
__device__ __forceinline__ float fsub_s(float a,float b){float r;asm("v_sub_f32_e32 %0, %1, %2":"=v"(r):"v"(a),"v"(b));return r;}
typedef float f32x2_t __attribute__((ext_vector_type(2))); typedef __bf16 bf16x2_t __attribute__((ext_vector_type(2)));
__device__ __forceinline__ unsigned cvtpk_s(float lo,float hi){f32x2_t v={lo,hi};bf16x2_t b=__builtin_convertvector(v,bf16x2_t);return __builtin_bit_cast(unsigned,b);}
#define WAIT_BAR(N) asm volatile("s_waitcnt vmcnt(" #N ") lgkmcnt(0)\n\ts_barrier":::"memory")

__device__ __forceinline__ void qkt(f32x16&p0,f32x16&p1,const char*Kslot,const bf16x8*qr,const f32x16&negm,int r32,int hi){
  const char*kb=Kslot+hi*1024+r32*16;
  #pragma unroll
  for(int d0=0;d0<4;++d0){
    const bf16x8 b0=*reinterpret_cast<const bf16x8*>(kb+d0*2048);
    const bf16x8 b1=*reinterpret_cast<const bf16x8*>(kb+d0*2048+512);
    if(d0==0){p0=__builtin_amdgcn_mfma_f32_32x32x16_bf16(b0,qr[0],negm,0,0,0);p1=__builtin_amdgcn_mfma_f32_32x32x16_bf16(b1,qr[0],negm,0,0,0);}
    else{p0=__builtin_amdgcn_mfma_f32_32x32x16_bf16(b0,qr[d0],p0,0,0,0);p1=__builtin_amdgcn_mfma_f32_32x32x16_bf16(b1,qr[d0],p1,0,0,0);}}
}
typedef __attribute__((address_space(3))) const char* lds_cptr;
typedef short v4i16_t __attribute__((ext_vector_type(4)));
__device__ __forceinline__ void kload8(bf16x8*kf,lds_cptr kp){
  kf[0]=*(const __attribute__((address_space(3))) bf16x8*)(kp);      kf[1]=*(const __attribute__((address_space(3))) bf16x8*)(kp+512);
  kf[2]=*(const __attribute__((address_space(3))) bf16x8*)(kp+2048); kf[3]=*(const __attribute__((address_space(3))) bf16x8*)(kp+2560);
  kf[4]=*(const __attribute__((address_space(3))) bf16x8*)(kp+4096); kf[5]=*(const __attribute__((address_space(3))) bf16x8*)(kp+4608);
  kf[6]=*(const __attribute__((address_space(3))) bf16x8*)(kp+6144); kf[7]=*(const __attribute__((address_space(3))) bf16x8*)(kp+6656);
}
__device__ __forceinline__ void kload2(bf16x8*kf,lds_cptr kp,int j){ kf[2*j]=*(const __attribute__((address_space(3))) bf16x8*)(kp+j*2048); kf[2*j+1]=*(const __attribute__((address_space(3))) bf16x8*)(kp+j*2048+512); }
__device__ __forceinline__ s16x4 vtr(lds_cptr p){ return __builtin_bit_cast(s16x4,__builtin_amdgcn_ds_read_tr16_b64_v4i16((__attribute__((address_space(3))) v4i16_t*)p)); }
__device__ __forceinline__ float rowmax(const f32x16&p0,const f32x16&p1){
  float a=max3f(p0[0],p0[1],p1[0]),b=max3f(p0[2],p0[3],p1[1]);a=max3f(a,p1[2],p1[3]);
  #pragma unroll
  for(int r=4;r<16;r+=4){a=max3f(a,p0[r],p0[r+1]);b=max3f(b,p0[r+2],p0[r+3]);a=max3f(a,p1[r],p1[r+1]);b=max3f(b,p1[r+2],p1[r+3]);}
  const float m=max2f(a,b);
  auto rr=__builtin_amdgcn_permlane32_swap(__float_as_uint(m),__float_as_uint(m),false,false);
  return max2f(__uint_as_float(rr[0]),__uint_as_float(rr[1]));
}
__device__ __forceinline__ void pv(f32x16*o,int vb,bf16x8 pa0,bf16x8 pa1,bf16x8 pa2,bf16x8 pa3){
  #pragma unroll
  for(int d0=0;d0<2;++d0){s16x4 lo[4],hi[4];
    #pragma unroll
    for(int ks=0;ks<4;++ks){
      asm volatile("ds_read_b64_tr_b16 %0,%1 offset:%c2":"=&v"(lo[ks]):"v"(vb),"i"(d0*4096+ks*1024):"memory");
      asm volatile("ds_read_b64_tr_b16 %0,%1 offset:%c2":"=&v"(hi[ks]):"v"(vb),"i"(d0*4096+ks*1024+512):"memory");}
    asm volatile("s_waitcnt lgkmcnt(0)":::"memory");SBAR();
    #define PK(k) (bf16x8){lo[k][0],lo[k][1],lo[k][2],lo[k][3],hi[k][0],hi[k][1],hi[k][2],hi[k][3]}
    o[d0]=__builtin_amdgcn_mfma_f32_32x32x16_bf16(pa0,PK(0),o[d0],0,0,0);
    o[d0]=__builtin_amdgcn_mfma_f32_32x32x16_bf16(pa1,PK(1),o[d0],0,0,0);
    o[d0]=__builtin_amdgcn_mfma_f32_32x32x16_bf16(pa2,PK(2),o[d0],0,0,0);
    o[d0]=__builtin_amdgcn_mfma_f32_32x32x16_bf16(pa3,PK(3),o[d0],0,0,0);
    #undef PK
  }
}

#ifndef ATTN_STORE16
#define ATTN_STORE16(p,v) (*(u32x4*)(p)=(v))
#endif
constexpr float ATT_SKIP_LOG2=44.0f;
template<int THRL> __device__ __forceinline__ void attn_unit(int b,int h,int qb,const bf16*Q,const bf16*__restrict__ K,const bf16*__restrict__ V,bf16*O,const float*__restrict__ cum2,const float*__restrict__ qg,const float*__restrict__ kg,char*shm){
  int tid_l=threadIdx.x; asm volatile("":"+v"(tid_l)); const int tid=tid_l,lane=tid&63,r32=lane&31,hi=lane>>5; const int wid=__builtin_amdgcn_readfirstlane(tid>>6);
  const long rowbase=(long)b*SEQ; const int q0=qb*QB;
  const bf16*Qw=Q+(rowbase+q0+wid*QBLK)*HP+h*D;
  typedef float f32x4b __attribute__((ext_vector_type(4)));
  const float* cb=cum2+(long)(b*NHEAD+h)*SEQ; const float cref=cb[q0];
  f32x4b cpre[4];
  #pragma unroll
  for(int k_=0;k_<4;++k_){ const int i=tid*4+k_*NW*64*4; cpre[k_]=(i<q0+QB)?*(const f32x4b*)(cb+i):(f32x4b){0.f,0.f,0.f,0.f}; }
  bf16x8 qr[4];
  #pragma unroll
  for(int d0=0;d0<4;++d0)qr[d0]=*reinterpret_cast<const bf16x8*>(&Qw[(long)r32*HP+d0*16+hi*8]);
  int T0; bool nomax_;
  { float gq=fabsf(qg[lane]),gk=fabsf(kg[lane]);
    #pragma unroll
    for(int o=1;o<64;o<<=1){gq=fmaxf(gq,__shfl_xor(gq,o));gk=fmaxf(gk,__shfl_xor(gk,o));}
    const float qkb_=8.0f*1.4426950408889634f*1.02f*gq*gk; const float thresh=2.0f*qkb_+ATT_SKIP_LOG2;
    nomax_=__builtin_amdgcn_readfirstlane((int)(qkb_+1.0f<(float)THRL))!=0;
    const int ntf=(q0+QB)/KVBLK; const int j0=lane,j1=lane+64;
    const bool s0=(j0<ntf-4)&&(cref-cb[64*j0+63]<-thresh); const bool s1=(j1<ntf-4)&&(cref-cb[64*j1+63]<-thresh);
    const int nskip=__popcll(__ballot(s0))+__popcll(__ballot(s1));
    T0=__builtin_amdgcn_readfirstlane(nskip&~1); }
  const bf16*Kh=K+(rowbase+(long)T0*KVBLK)*HP+h*D,*Vh=V+(rowbase+(long)T0*KVBLK)*HP+h*D;
  const lds_cptr shm3=(lds_cptr)shm; const unsigned lds0=(unsigned)(uintptr_t)shm;
  float*wsf=(float*)(shm+LDS_WS)+wid*64;
  const bf16*ksrc=Kh+(long)lane*HP+wid*8;
  const bf16*vsrc=Vh+(long)(16*(wid&3)+(lane>>2))*HP+(wid>>2)*32+(lane&3)*8;
  const unsigned kdst=lds0+LDS_K+wid*1024, vdst=lds0+LDS_V+wid*1024;
  #define DMA_K(t,slot) glds16(ksrc+(long)(t)*KVBLK*HP,(unsigned)__builtin_amdgcn_readfirstlane(kdst+(slot)))
  #define DMA_V(t,slot) glds16(vsrc+(long)(t)*KVBLK*HP,(unsigned)__builtin_amdgcn_readfirstlane(vdst+(slot)))
  const int vb0=(int)(lds0+LDS_V)+((lane>>4)&1)*32+(lane&3)*8+(4*hi+((lane&15)>>2))*64;
  const char*Kbase=shm+LDS_K; bf16x8 kf[8];
  const lds_cptr kp0=shm3+LDS_K+hi*1024+r32*16; const lds_cptr vp0=shm3+LDS_V+((lane>>4)&1)*32+(lane&3)*8+(4*hi+((lane&15)>>2))*64;
  const int NT=(q0+QB)/KVBLK-T0;
  { __attribute__((address_space(3))) float* bl=(__attribute__((address_space(3))) float*)(shm3+LDS_BIAS);
    #pragma unroll
    for(int k_=0;k_<4;++k_){ const int i=tid*4+k_*NW*64*4; if(i<q0+QB){ const f32x4b c=cpre[k_]; *(__attribute__((address_space(3))) f32x4b*)(bl+i)=(f32x4b){cref-c[0],cref-c[1],cref-c[2],cref-c[3]}; } }
    asm volatile("s_waitcnt vmcnt(0) lgkmcnt(0)":::"memory"); }
  const __attribute__((address_space(3))) float* biasL=(const __attribute__((address_space(3))) float*)(shm3+LDS_BIAS)+T0*KVBLK+4*hi;
  #define BIASADD(C0,C1,t) do{ const __attribute__((address_space(3))) float* bp_=biasL+64*(t); \
    _Pragma("unroll") for(int j_=0;j_<4;++j_){ const f32x4b b0_=*(const __attribute__((address_space(3))) f32x4b*)(bp_+8*j_); const f32x4b b1_=*(const __attribute__((address_space(3))) f32x4b*)(bp_+32+8*j_); \
      C0[4*j_]+=b0_[0];C0[4*j_+1]+=b0_[1];C0[4*j_+2]+=b0_[2];C0[4*j_+3]+=b0_[3]; C1[4*j_]+=b1_[0];C1[4*j_+1]+=b1_[1];C1[4*j_+2]+=b1_[2];C1[4*j_+3]+=b1_[3]; SBAR(); } }while(0)
  DMA_K(0,0);DMA_V(0,0);DMA_K(1,SLOTB);
  const __attribute__((address_space(3))) bf16x8* qst=(const __attribute__((address_space(3))) bf16x8*)(shm3+LDS_OST+wid*4096+lane*16);
  #pragma unroll
  for(int d0=0;d0<4;++d0)*(__attribute__((address_space(3))) bf16x8*)(shm3+LDS_OST+wid*4096+lane*16+d0*1024)=qr[d0];
  #define QLD(d) (qst[(d)*64])
  float mhat=0.f,l_reg=0.f;f32x16 o[2];o[0]=f32x16{};o[1]=f32x16{};f32x16 negm=f32x16{};asm volatile("":"+v"(negm));
  const int qrel=wid*QBLK+r32;
  #define CMASK(P0,P1,t) do{int jb_=(t)-(NT-4); if(jb_>=0)cmask(P0,P1,jb_,qrel,hi);}while(0)
  bool resc=false;
  #define START(P0,P1) do{ const float rm=*(const __attribute__((address_space(3))) float*)(shm3+LDS_BIAS+4*(q0+qrel)); resc=false; \
    { const float dl=rm; mhat=fadd_s(mhat,dl); \
      _Pragma("unroll") for(int r=0;r<16;++r){P0[r]=fsub_s(P0[r],dl);P1[r]=fsub_s(P1[r],dl);} \
      _Pragma("unroll") for(int r=0;r<16;++r)negm[r]=-mhat; asm volatile("":"+v"(negm)); } \
    _Pragma("unroll") for(int r=0;r<16;++r)P0[r]=__builtin_amdgcn_exp2f(P0[r]); }while(0)
  #define RESC() do{ if(resc){ asm volatile("s_waitcnt lgkmcnt(0)":::"memory"); \
      _Pragma("unroll") for(int d_=0;d_<2;++d_) _Pragma("unroll") for(int r=0;r<16;++r)o[d_][r]*=wsf[crow(r,hi)]; } }while(0)
  f32x16 pA0,pA1,pB0,pB1;
  int sl_prev=0,sl_cur=0,sl_next=SLOTB;
  #define ROT() do{sl_prev=sl_cur;sl_cur=sl_next;sl_next=(sl_next==(NSLOT-1)*SLOTB)?0:sl_next+SLOTB;}while(0)
  DMA_K(2,2*SLOTB);
  WAIT_BAR(3);
  qkt(pA0,pA1,Kbase,qr,negm,r32,hi);asm volatile("s_nop 15\n\ts_nop 7":"+v"(pA0),"+v"(pA1));BIASADD(pA0,pA1,0);CMASK(pA0,pA1,0);
  START(pA0,pA1);
  _Pragma("unroll") for(int r=0;r<16;++r)pA1[r]=__builtin_amdgcn_exp2f(pA1[r]);
  WAIT_BAR(0);
  DMA_K(3,0);DMA_V(1,SLOTB);
  ROT();
  kload8(kf,kp0+sl_cur);
  WAIT_BAR(2);
  s16x4 vlo[8],vhi[8]; u32x4 pw0,pw1,pw2,pw3;
  #define PKW(P,B) cvtpk_s(P[B],P[B+1])
  #define PAF(k) __builtin_bit_cast(bf16x8,pw##k)
  #define VFR(i) (bf16x8){vlo[i][0],vlo[i][1],vlo[i][2],vlo[i][3],vhi[i][0],vhi[i][1],vhi[i][2],vhi[i][3]}
  #define PIN(x) asm volatile("":"+v"(x))
  #define MX3(a,b,c) __builtin_fmaxf(__builtin_fmaxf((a),(b)),(c))
  #define GAPA(MF,A0,A1,A2,A3,W0,W1,PW) do{ MF; sacc+=A0; sacc+=A1; sacc+=A2; sacc+=A3; PIN(sacc); W0; W1; PIN(PW); SBAR(); }while(0)
  #define EX(v) __builtin_amdgcn_exp2f(v)
  #define GAPB(MF,X,B) do{ MF; X[B]=EX(X[B]); X[B+1]=EX(X[B+1]); X[B+2]=EX(X[B+2]); X[B+3]=EX(X[B+3]); PIN(X); SBAR(); }while(0)
  #define VRD(i) do{ vlo[i]=vtr(vp_+(((i)>>2)*4096+((i)&3)*1024)); vhi[i]=vtr(vp_+(((i)>>2)*4096+((i)&3)*1024+512)); }while(0)
  #define KRD(G,j) do{ if(G){ kload2(kf,kp0+sl_next,j); SBAR(); } }while(0)
  #define STEP(C0,C1,P0,P1,t,GK,GV,GL) do{ SBAR(); \
    const lds_cptr vp_=vp0+sl_prev; \
    bf16x8 qa_=QLD(0), qb_=QLD(1); VRD(0); SBAR(); float sacc=(P0[0]+P0[1]); \
    GAPA(C0=__builtin_amdgcn_mfma_f32_32x32x16_bf16(kf[0],qa_,negm,0,0,0), P0[2],P0[3],P0[4],P0[5],     pw0[0]=PKW(P0,0), pw0[1]=PKW(P0,2), pw0); \
    VRD(4); SBAR(); GAPA(C1=__builtin_amdgcn_mfma_f32_32x32x16_bf16(kf[1],qa_,negm,0,0,0), P0[6],P0[7],P0[8],P0[9],     pw0[2]=PKW(P0,4), pw0[3]=PKW(P0,6), pw0); \
    qa_=QLD(2); VRD(1); SBAR(); GAPA(C0=__builtin_amdgcn_mfma_f32_32x32x16_bf16(kf[2],qb_,C0,0,0,0),   P0[10],P0[11],P0[12],P0[13], pw1[0]=PKW(P0,8), pw1[1]=PKW(P0,10), pw1); \
    VRD(5); SBAR(); GAPA(C1=__builtin_amdgcn_mfma_f32_32x32x16_bf16(kf[3],qb_,C1,0,0,0),   P0[14],P0[15],P1[0],P1[1],   pw1[2]=PKW(P0,12),pw1[3]=PKW(P0,14), pw1); \
    qb_=QLD(3); VRD(2); SBAR(); GAPA(C0=__builtin_amdgcn_mfma_f32_32x32x16_bf16(kf[4],qa_,C0,0,0,0),   P1[2],P1[3],P1[4],P1[5],     pw2[0]=PKW(P1,0), pw2[1]=PKW(P1,2), pw2); \
    VRD(6); SBAR(); GAPA(C1=__builtin_amdgcn_mfma_f32_32x32x16_bf16(kf[5],qa_,C1,0,0,0),   P1[6],P1[7],P1[8],P1[9],     pw2[2]=PKW(P1,4), pw2[3]=PKW(P1,6), pw2); \
    VRD(3); SBAR(); GAPA(C0=__builtin_amdgcn_mfma_f32_32x32x16_bf16(kf[6],qb_,C0,0,0,0),   P1[10],P1[11],P1[12],P1[13], pw3[0]=PKW(P1,8), pw3[1]=PKW(P1,10), pw3); \
    VRD(7); SBAR(); GAPA(C1=__builtin_amdgcn_mfma_f32_32x32x16_bf16(kf[7],qb_,C1,0,0,0),   P1[14],P1[15],0.f,0.f,       pw3[2]=PKW(P1,12),pw3[3]=PKW(P1,14), pw3); \
    l_reg+=sacc; \
    if(GK){DMA_K((t)+3,sl_cur);} if(GV){DMA_V((t)+1,sl_next);} \
    BIASADD(C0,C1,t); CMASK(C0,C1,t); \
    resc=false; if(!nomax_){ float a=MX3(C0[0],C0[1],C1[0]),b=MX3(C0[2],C0[3],C1[1]); a=MX3(a,C1[2],C1[3]); \
      _Pragma("unroll") for(int r=4;r<16;r+=4){a=MX3(a,C0[r],C0[r+1]);b=MX3(b,C0[r+2],C0[r+3]);a=MX3(a,C1[r],C1[r+1]);b=MX3(b,C1[r+2],C1[r+3]);} \
      float rm=__builtin_fmaxf(a,b); { auto rr=__builtin_amdgcn_permlane32_swap(__float_as_uint(rm),__float_as_uint(rm),false,false); rm=__builtin_fmaxf(__uint_as_float(rr[0]),__uint_as_float(rr[1])); } \
      resc=false; \
      if(__builtin_expect(__any(rm>(float)THRL),0)){ const float dl=__builtin_fmaxf(rm,0.f); mhat+=dl; \
        _Pragma("unroll") for(int r=0;r<16;++r){C0[r]-=dl;C1[r]-=dl;} \
        _Pragma("unroll") for(int r=0;r<16;++r)negm[r]=-mhat; asm volatile("":"+v"(negm)); \
        const float f=__builtin_amdgcn_exp2f(-dl); l_reg*=f; if(hi==0)wsf[r32]=f; resc=true; } } \
    SBAR(); \
    GAPB(o[0]=__builtin_amdgcn_mfma_f32_32x32x16_bf16(PAF(0),VFR(0),o[0],0,0,0), C0,0); \
    GAPB(o[1]=__builtin_amdgcn_mfma_f32_32x32x16_bf16(PAF(0),VFR(4),o[1],0,0,0), C0,4); \
    KRD(GL,0); GAPB(o[0]=__builtin_amdgcn_mfma_f32_32x32x16_bf16(PAF(1),VFR(1),o[0],0,0,0), C0,8); \
    KRD(GL,1); GAPB(o[1]=__builtin_amdgcn_mfma_f32_32x32x16_bf16(PAF(1),VFR(5),o[1],0,0,0), C0,12); \
    KRD(GL,2); GAPB(o[0]=__builtin_amdgcn_mfma_f32_32x32x16_bf16(PAF(2),VFR(2),o[0],0,0,0), C1,0); \
    KRD(GL,3); GAPB(o[1]=__builtin_amdgcn_mfma_f32_32x32x16_bf16(PAF(2),VFR(6),o[1],0,0,0), C1,4); \
    GAPB(o[0]=__builtin_amdgcn_mfma_f32_32x32x16_bf16(PAF(3),VFR(3),o[0],0,0,0), C1,8); \
    GAPB(o[1]=__builtin_amdgcn_mfma_f32_32x32x16_bf16(PAF(3),VFR(7),o[1],0,0,0), C1,12); \
    }while(0)
  int t=1;
  #undef CMASK
  #define CMASK(P0,P1,t) do{}while(0)
  for(;t+5<NT;t+=2){
    STEP(pB0,pB1,pA0,pA1,t,true,true,true);     WAIT_BAR(2); RESC(); ROT();
    STEP(pA0,pA1,pB0,pB1,t+1,true,true,true);   WAIT_BAR(2); RESC(); ROT();
  }
  #undef CMASK
  #define CMASK(P0,P1,t) do{int jb_=(t)-(NT-4); if(jb_>=0)cmask(P0,P1,jb_,qrel,hi);}while(0)
  #define ENDW(tt) do{ if((tt)+3<NT){WAIT_BAR(2);} else if((tt)+2<NT){WAIT_BAR(1);} else {WAIT_BAR(0);} }while(0)
  for(;t+1<NT;t+=2){
    STEP(pB0,pB1,pA0,pA1,t,(t+3<NT),(t+1<NT),(t+1<NT));       ENDW(t);   RESC(); ROT();
    STEP(pA0,pA1,pB0,pB1,t+1,(t+4<NT),(t+2<NT),(t+2<NT));     ENDW(t+1); RESC(); ROT();
  }
  STEP(pB0,pB1,pA0,pA1,NT-1,false,false,false); RESC();
  { float sacc=pB0[0]+pB0[1]; _Pragma("unroll") for(int r=2;r<16;++r)sacc+=pB0[r]; _Pragma("unroll") for(int r=0;r<16;++r)sacc+=pB1[r]; l_reg+=sacc;
    pw0=(u32x4){PKW(pB0,0),PKW(pB0,2),PKW(pB0,4),PKW(pB0,6)};pw1=(u32x4){PKW(pB0,8),PKW(pB0,10),PKW(pB0,12),PKW(pB0,14)};pw2=(u32x4){PKW(pB1,0),PKW(pB1,2),PKW(pB1,4),PKW(pB1,6)};pw3=(u32x4){PKW(pB1,8),PKW(pB1,10),PKW(pB1,12),PKW(pB1,14)};
    SBAR(); pv(o,vb0+sl_cur,PAF(0),PAF(1),PAF(2),PAF(3)); }
  #undef PKW
  #undef PAF
  #undef VFR
  #undef PIN
  #undef MX3
  #undef GAPA
  #undef GAPB
  #undef EX
  #undef VRD
  #undef KRD
  #undef STEP
  #undef ENDW
  {auto rr=__builtin_amdgcn_permlane32_swap(__float_as_uint(l_reg),__float_as_uint(l_reg),false,false);l_reg=__uint_as_float(rr[0])+__uint_as_float(rr[1]);}
  if(hi==0)wsf[32+r32]=l_reg;asm volatile("s_waitcnt lgkmcnt(0)":::"memory");
  float rli[16];
  #pragma unroll
  for(int r=0;r<16;++r)rli[r]=__builtin_amdgcn_rcpf(wsf[32+crow(r,hi)]);
  bf16*Ow=O+(rowbase+q0+wid*QBLK)*OP+h*D;
  { bf16*stg=(bf16*)(shm+LDS_OST)+wid*2048;
    #pragma unroll
    for(int r=0;r<16;++r){const int orow=crow(r,hi);
      #pragma unroll
      for(int d0=0;d0<2;++d0)stg[orow*64+d0*32+r32]=__float2bfloat16(o[d0][r]*rli[r]);}
    asm volatile("s_waitcnt lgkmcnt(0)":::"memory");
    #pragma unroll
    for(int i=0;i<4;++i){const int row=i*8+(lane>>3),ch=lane&7; const u32x4 v=*(const u32x4*)(stg+row*64+ch*8); ATTN_STORE16(Ow+(long)row*OP+ch*8,v);} }
  asm volatile("s_waitcnt lgkmcnt(0)\n\ts_barrier":::"memory");
  #undef DMA_K
  #undef DMA_V
  #undef BIASADD
  #undef QLD
  #undef CMASK
  #undef START
  #undef RESC
  #undef ROT
}
constexpr int ATTN_LDS_BYTES=LDS_BYTES;
struct AttnTensors { const bf16* Q; const bf16* K; const bf16* V; bf16* O; const float* cum2; const float* qg; const float* kg; };
struct AttnUnit { int bh; int qb; };
struct StaticOrder {
  int vcu, G;
  __device__ __forceinline__ explicit StaticOrder(int grid,int block):vcu((grid%8==0)?(block%8)*(grid/8)+block/8:block),G(grid){}
  __device__ __forceinline__ bool next(int i,AttnUnit&u)const{
    if(G==256){ if(i>=4)return false; const int s=vcu&7; u.bh=vcu>>3; u.qb=(i==0)?s:(i==1)?15-s:(i==2)?16+s:31-s; return true; }
    const int j=vcu+i*G; if(j>=BATCH*NHEAD*NQB)return false; u.bh=j/NQB; const int q=j%NQB; u.qb=(q&1)?(NQB-1-(q>>1)):(q>>1); return true; }
  __device__ __forceinline__ void a_ready(const AttnUnit&)const{}
  __device__ __forceinline__ void done(const AttnUnit&)const{}
};
template<class Sched,int THRL=8> __device__ __forceinline__ void attn_phase(char*lds,const AttnTensors&T,const Sched&S){
  AttnUnit u;
  for(int i=0;S.next(i,u);++i){ S.a_ready(u); attn_unit<THRL>(u.bh/NHEAD,u.bh%NHEAD,u.qb,T.Q,T.K,T.V,T.O,T.cum2,T.qg,T.kg,lds); S.done(u); }
}
#undef SBAR
#undef WAIT_BAR
}
#include <hip/hip_cooperative_groups.h>
namespace cg = cooperative_groups;
#define LAS __attribute__((address_space(3)))
typedef unsigned short bf16;
typedef unsigned v4u __attribute__((ext_vector_type(4)));
typedef float f32x4 __attribute__((ext_vector_type(4)));
typedef short bf16x8 __attribute__((ext_vector_type(8)));
typedef unsigned short u16x8 __attribute__((ext_vector_type(8)));
constexpr int NWAVES = 8;
constexpr int M = 32768, DM = 1024, SEQL = 8192, DFF = 2816, NFF = 5632, NMIX = 3336, HPITCH = 3584, DEPTH = 2;
constexpr size_t MiB = 1u << 20;
constexpr size_t WS_QCTR = 3 * MiB, WS_BAR = 3 * MiB + 65536, WS_CTL_ZERO = 131072, WS_FOXC = 1 * MiB, WS_DEC = 2 * MiB, WS_W = 4 * MiB, W_LAYER = 42 * MiB;
constexpr size_t WO_1IN = 0, WO_1OUT = 11 * MiB, WO_MIX = 16 * MiB + MiB / 2, WO_MO = 23 * MiB + MiB / 2, WO_2IN = 25 * MiB + MiB / 2, WO_2OUT = 36 * MiB + MiB / 2;
constexpr size_t WS_XB = 88 * MiB, WS_HACT = 152 * MiB, WS_Y = 376 * MiB, WS_HST = 440 * MiB, WS_RS = 472 * MiB, WS_END = 474 * MiB;
constexpr int LDS_BYTES = 147456;
static_assert(attn_body::LDS_BYTES <= 131072, "attention LDS");

__device__ __forceinline__ unsigned f2bf(float f) { unsigned u = __builtin_bit_cast(unsigned, f); return (u + 0x7fffu + ((u >> 16) & 1u)) >> 16; }
__device__ __forceinline__ unsigned pk2(float lo, float hi) { unsigned r; asm("v_cvt_pk_bf16_f32 %0, %1, %2" : "=v"(r) : "v"(lo), "v"(hi)); return r; }
__device__ __forceinline__ float bf2f(unsigned short b) { return __builtin_bit_cast(float, (unsigned)b << 16); }
__device__ __forceinline__ float wave_sum(float v) {
#pragma unroll
    for (int o = 1; o < 64; o <<= 1) v += __shfl_xor(v, o);
    return v;
}
#define LDS_WAIT() asm volatile("s_waitcnt lgkmcnt(0)" ::: "memory")

__device__ __forceinline__ int dst_row(int mode, int c) {
    if (mode == 1) { const int half = c / DFF, j = c - half * DFF; return 256 * (j >> 7) + 128 * half + (j & 127); }
    if (mode == 2) { const int pn = c >> 8, w = c & 255; return 256 * pn + 128 * ((w & 63) >> 5) + 32 * (w >> 6) + (w & 31); }
    return c;
}
__device__ __forceinline__ void tr_item(const float* W, int K, int N, int nblk, const float* gain, bf16* WT, int mode, LAS float* scr, int item, int lane) {
    const int kb = item / nblk, nb = item % nblk, k0 = 64 * kb, n0 = 32 * nb;
    const int c = n0 + (lane & 31);
    float wv[32];
#pragma unroll
    for (int i = 0; i < 32; ++i) { const int kk = 2 * i + (lane >> 5); wv[i] = (c < N) ? __builtin_nontemporal_load(W + (size_t)(k0 + kk) * N + c) : 0.f;     }
    if (gain) {
#pragma unroll
        for (int i = 0; i < 32; ++i) wv[i] *= gain[k0 + 2 * i + (lane >> 5)]; }
#pragma unroll
    for (int i = 0; i < 32; ++i) scr[(2 * i + (lane >> 5)) * 33 + (lane & 31)] = wv[i];
    LDS_WAIT(); asm volatile("" ::: "memory");
    const int c8 = lane & 7;
#pragma unroll
    for (int j = 0; j < 4; ++j) { const int n = (lane >> 3) + 8 * j; const LAS float* s = scr + (8 * c8) * 33 + n;
        v4u o; o.x = pk2(s[0 * 33], s[1 * 33]); o.y = pk2(s[2 * 33], s[3 * 33]); o.z = pk2(s[4 * 33], s[5 * 33]); o.w = pk2(s[6 * 33], s[7 * 33]);
        *(v4u*)(WT + (size_t)dst_row(mode, n0 + n) * K + k0 + 8 * c8) = o; }
    LDS_WAIT(); asm volatile("" ::: "memory");
}

#define XB_TMO      128
#define XB_XCNT(j)  (256  + 64 * (j))
#define XB_XSUB(j)  (1280 + 64 * (j))
#define XB_XGEN(j)  (2304 + 64 * (j))
#define XB_TOP      3328
#define XB_TOPGEN   3392
#define XCD_BAR_WORDS 3456
#define XB_SPIN_CAP (1u << 18)

__device__ __forceinline__ unsigned xb_ld(unsigned* p)              { return __hip_atomic_load(p, __ATOMIC_RELAXED, __HIP_MEMORY_SCOPE_AGENT); }
__device__ __forceinline__ unsigned xb_add(unsigned* p, unsigned v) { return __hip_atomic_fetch_add(p, v, __ATOMIC_RELAXED, __HIP_MEMORY_SCOPE_AGENT); }
__device__ __forceinline__ unsigned xb_xcc_id() { return (unsigned)__builtin_amdgcn_s_getreg((3 << 11) | 20) & 0xFu; }
#define XB_SPIN(cond, bar) do { unsigned _sp = 0; while (cond) { __builtin_amdgcn_s_sleep(1); \
    if ((++_sp & 255u) == 0u) { if (xb_ld(&(bar)[XB_TMO])) break; if (_sp > XB_SPIN_CAP) { atomicAdd(&(bar)[XB_TMO], 1u); break; } } } } while (0)

struct XcdBarrier {
    unsigned* bar; unsigned x;
    volatile LAS unsigned* st;
};

__device__ __forceinline__ XcdBarrier xcd_barrier_post(unsigned* bar, volatile LAS unsigned* st) {
    XcdBarrier b; b.bar = bar; b.x = xb_xcc_id(); b.st = st;
    if (threadIdx.x == 0) (void)xb_add(&bar[XB_XCNT(b.x)], 1u);
    return b;
}
__device__ __forceinline__ void xcd_barrier_complete(unsigned* bar, unsigned x, unsigned& nloc, unsigned& nx) {
    const unsigned G = gridDim.x * gridDim.y * gridDim.z;
    unsigned sum, cnt, mine, sp = 0u;
    for (;;) {
        sum = 0u; cnt = 0u; mine = 0u;
#pragma unroll
        for (unsigned j = 0; j < 16; ++j) { const unsigned c = xb_ld(&bar[XB_XCNT(j)]); sum += c; cnt += (c > 0u) ? 1u : 0u; mine = (j == x) ? c : mine; }
        if (sum == G) break;
        __builtin_amdgcn_s_sleep(1);
        if ((++sp & 255u) == 0u) { if (xb_ld(&bar[XB_TMO])) break; if (sp > XB_SPIN_CAP) { atomicAdd(&bar[XB_TMO], 1u); break; } }
    }
    nloc = mine > 0u ? mine : 1u; nx = cnt > 0u ? cnt : 1u;
}

__device__ __forceinline__ void xcd_barrier(const XcdBarrier& b) {
    asm volatile("s_waitcnt vmcnt(0)" ::: "memory");
    __syncthreads();
    if (threadIdx.x == 0) {
        unsigned* bar = b.bar;
        __builtin_amdgcn_s_waitcnt(0);
        unsigned nloc = b.st[0], nx = b.st[1];
        if (nloc == 0u) { xcd_barrier_complete(bar, b.x, nloc, nx); b.st[0] = nloc; b.st[1] = nx; }
        const unsigned old = xb_add(&bar[XB_XSUB(b.x)], 1u);
        const unsigned gen = old / nloc;
        if (old + 1u == (gen + 1u) * nloc) {
            __builtin_amdgcn_fence(__ATOMIC_RELEASE, "agent");
            asm volatile("s_waitcnt vmcnt(0)" ::: "memory");
            const unsigned og = xb_add(&bar[XB_TOP], 1u);
            const unsigned tg = og / nx;
            if (og + 1u == (tg + 1u) * nx) xb_add(&bar[XB_TOPGEN], 1u);
            else XB_SPIN(xb_ld(&bar[XB_TOPGEN]) == tg, bar);
            __builtin_amdgcn_fence(__ATOMIC_ACQUIRE, "agent");
            xb_add(&bar[XB_XGEN(b.x)], 1u);
            asm volatile("s_waitcnt vmcnt(0)" ::: "memory");
        } else {
            XB_SPIN(xb_ld(&bar[XB_XGEN(b.x)]) == gen, bar);
            __builtin_amdgcn_fence(__ATOMIC_ACQUIRE, "agent");
            asm volatile("s_waitcnt vmcnt(0)" ::: "memory");
        }
    }
    __syncthreads();
}


struct Args { const float* in[16]; float* out; unsigned char* ws; };
#ifndef PROBE_MASK
#define PROBE_MASK 0
#endif
#define STAMP(k) do { if (PROBE_MASK && bx == 0 && threadIdx.x == 0) ((LAS unsigned long long*)(lds + 135168))[k] = __builtin_amdgcn_s_memrealtime(); } while (0)
#ifndef XSYNC
#define XSYNC 0
#endif
#ifndef HG_REP
#define HG_REP 1
#endif
#ifndef EN_G1
#define EN_G1 1
#endif
#ifndef EN_G2
#define EN_G2 1
#endif
#ifndef EN_G3
#define EN_G3 1
#endif
#ifndef EN_MA
#define EN_MA 1
#endif
#ifndef EN_ATT
#define EN_ATT 1
#endif
#ifndef EN_MC
#define EN_MC 1
#endif
#ifndef EN_G5
#define EN_G5 1
#endif

constexpr int HL_SEG = 0, HL_B = 4096, HL_BS = 9216, HL_OL = HL_B + 7 * HL_BS, HL_TOT = HL_OL + 64 * 68 * 4, HP72 = 72;
typedef float f32x2v __attribute__((ext_vector_type(2)));
__device__ __forceinline__ float hgrn_lb(const float* logits, int l, int ch) {
    if (l == 0) return 0.f;
    const float x0 = logits[ch], x1 = logits[256 + ch], mx = fmaxf(x0, x1), e0 = __expf(x0 - mx), e1 = __expf(x1 - mx);
    return fminf(fmaxf(e1 / (e0 + e1), 0.f), 1.f);
}
__device__ __forceinline__ f32x4 mfma16(bf16x8 a, bf16x8 b, f32x4 c) { return __builtin_amdgcn_mfma_f32_16x16x32_bf16(a, b, c, 0, 0, 0); }
__device__ __forceinline__ void hgrn_front(LAS unsigned char* lds, const unsigned (&z2)[4], float lb0, float lb1, float (&lf)[2][4], float (&kk)[2][4], float (&tot)[2], float (&ref)[2], int dp, int sg) {
    LAS f32x2v* SEG = (LAS f32x2v*)(lds + HL_SEG);
#pragma unroll
    for (int j = 0; j < 4; ++j)
#pragma unroll
        for (int c = 0; c < 2; ++c) { const float lb = c ? lb1 : lb0; const float z = fmaxf(__builtin_bit_cast(float, c ? (z2[j] & 0xffff0000u) : (z2[j] << 16)), -80.f);
            const float e = __builtin_amdgcn_exp2f(-1.4426950408889634f * z), sgm = __builtin_amdgcn_rcpf(1.0f + e), f = lb + (1.0f - lb) * sgm;
            lf[c][j] = __builtin_amdgcn_logf(f); kk[c][j] = (1.0f - lb) * e * sgm; }
#pragma unroll
    for (int c = 0; c < 2; ++c) { lf[c][1] += lf[c][0]; lf[c][2] += lf[c][1]; lf[c][3] += lf[c][2]; }
    SEG[sg * 32 + dp] = (f32x2v){lf[0][3], lf[1][3]};
    __syncthreads();
    f32x2v off = (f32x2v){0.f, 0.f}, tt = off, rr = off;
#pragma unroll
    for (int q = 0; q < 16; ++q) { const f32x2v v = SEG[q * 32 + dp]; tt += v; if (q < sg) off += v; if (q < 8) rr += v; }
#pragma unroll
    for (int j = 0; j < 4; ++j) { lf[0][j] += off[0]; lf[1][j] += off[1]; }
    tot[0] = tt[0]; tot[1] = tt[1]; ref[0] = rr[0]; ref[1] = rr[1];
}
__device__ __forceinline__ void hgrn_seg_local(LAS unsigned char* lds, const bf16* H, const float* lbl, int l, float* HSEG, float* SEGDEC, int unit, int tid) {
    const int bh = unit >> 4, seg = unit & 15, b = bh >> 2, h = bh & 3, dp = tid & 31, sg = tid >> 5, lane = tid & 63, w = tid >> 6;
    const int mi = w >> 1, nj0 = 2 * (w & 1), lr = lane & 15, lq = lane >> 4;
    const bf16* hb = H + ((size_t)b * SEQL + seg * 512) * HPITCH + h * 64 + 2 * dp;
    LAS bf16* B0 = (LAS bf16*)(lds + HL_B); LAS bf16* B1 = B0 + HL_BS / 2; LAS float* TOTL = (LAS float*)(lds + HL_TOT);
    const float lb0 = hgrn_lb(lbl, l, h * 64 + 2 * dp), lb1 = hgrn_lb(lbl, l, h * 64 + 2 * dp + 1);
    unsigned z2[4], v2[4];
#pragma unroll
    for (int j = 0; j < 4; ++j) { const bf16* r = hb + (size_t)(4 * sg + j) * HPITCH; z2[j] = *(const unsigned*)(r + 1024); v2[j] = *(const unsigned*)(r + 1280); }
    f32x4 S[2] = {(f32x4){0.f, 0.f, 0.f, 0.f}, (f32x4){0.f, 0.f, 0.f, 0.f}}; float dsum0 = 0.f, dsum1 = 0.f;
#pragma unroll 1
    for (int c = 0; c < 8; ++c) {
        unsigned zn[4], vn[4];
        { const int cn = (c < 7) ? c + 1 : c;
#pragma unroll
          for (int j = 0; j < 4; ++j) { const bf16* r = hb + (size_t)(cn * 64 + 4 * sg + j) * HPITCH; zn[j] = *(const unsigned*)(r + 1024); vn[j] = *(const unsigned*)(r + 1280); } }
        float lf[2][4], kk[2][4], tot[2], ref[2];
        hgrn_front(lds, z2, lb0, lb1, lf, kk, tot, ref, dp, sg);
#pragma unroll
        for (int cc = 0; cc < 2; ++cc) { float kh[4];
#pragma unroll
            for (int j = 0; j < 4; ++j) kh[j] = kk[cc][j] * __builtin_amdgcn_exp2f(tot[cc] - lf[cc][j]);
            *(LAS pg8::u32x2*)(B0 + (2 * dp + cc) * HP72 + 4 * sg) = (pg8::u32x2){pk2(kh[0], kh[1]), pk2(kh[2], kh[3])}; }
        *(LAS pg8::u32x2*)(B1 + (2 * dp) * HP72 + 4 * sg) = (pg8::u32x2){(v2[0] & 0xffffu) | (v2[1] << 16), (v2[2] & 0xffffu) | (v2[3] << 16)};
        *(LAS pg8::u32x2*)(B1 + (2 * dp + 1) * HP72 + 4 * sg) = (pg8::u32x2){(v2[0] >> 16) | (v2[1] & 0xffff0000u), (v2[2] >> 16) | (v2[3] & 0xffff0000u)};
        if (sg == 0) { *(LAS f32x2v*)(TOTL + 2 * dp) = (f32x2v){tot[0], tot[1]}; dsum0 += tot[0]; dsum1 += tot[1]; }
        __syncthreads();
        f32x4 acc[2] = {(f32x4){0.f, 0.f, 0.f, 0.f}, (f32x4){0.f, 0.f, 0.f, 0.f}};
#pragma unroll
        for (int ks = 0; ks < 2; ++ks) { const bf16x8 a = *(const LAS bf16x8*)(B0 + (16 * mi + lr) * HP72 + 32 * ks + 8 * lq);
#pragma unroll
            for (int jn = 0; jn < 2; ++jn) { const bf16x8 bb = *(const LAS bf16x8*)(B1 + (16 * (nj0 + jn) + lr) * HP72 + 32 * ks + 8 * lq); acc[jn] = mfma16(a, bb, acc[jn]); } }
        const f32x4 tl = *(const LAS f32x4*)(TOTL + 16 * mi + 4 * lq);
        const f32x4 dec = (f32x4){__builtin_amdgcn_exp2f(tl[0]), __builtin_amdgcn_exp2f(tl[1]), __builtin_amdgcn_exp2f(tl[2]), __builtin_amdgcn_exp2f(tl[3])};
        S[0] = S[0] * dec + acc[0]; S[1] = S[1] * dec + acc[1];
#pragma unroll
        for (int j = 0; j < 4; ++j) { z2[j] = zn[j]; v2[j] = vn[j]; }
    }
    float* out = HSEG + (size_t)unit * 4096 + tid;
#pragma unroll
    for (int jn = 0; jn < 2; ++jn)
#pragma unroll
        for (int r = 0; r < 4; ++r) out[(jn * 4 + r) * 512] = S[jn][r];
    if (sg == 0) *(f32x2v*)(SEGDEC + (size_t)unit * 64 + 2 * dp) = (f32x2v){__builtin_amdgcn_exp2f(dsum0), __builtin_amdgcn_exp2f(dsum1)};
    __syncthreads();
}
__device__ __forceinline__ void hgrn_seg_out(LAS unsigned char* lds, const bf16* H, const float* lbl, int l, const float* HSEG, const float* SEGDEC, const float* ogain, bf16* Y, int unit, int tid) {
    const int bh = unit >> 4, seg = unit & 15, b = bh >> 2, h = bh & 3, dp = tid & 31, sg = tid >> 5, lane = tid & 63, w = tid >> 6, t8 = tid >> 3, cg8 = tid & 7;
    const int mi = w >> 1, nj0 = 2 * (w & 1), lr = lane & 15, lq = lane >> 4;
    const size_t row0 = (size_t)b * SEQL + seg * 512;
    const bf16* hb = H + row0 * HPITCH + h * 64;
    LAS bf16* B0 = (LAS bf16*)(lds + HL_B); LAS bf16* B1 = B0 + HL_BS / 2; LAS bf16* B2 = B1 + HL_BS / 2; LAS bf16* B3 = B2 + HL_BS / 2; LAS bf16* B4 = B3 + HL_BS / 2; LAS bf16* B5 = B4 + HL_BS / 2; LAS bf16* B6 = B5 + HL_BS / 2;
    LAS float* OL = (LAS float*)(lds + HL_OL); LAS float* TOTL = (LAS float*)(lds + HL_TOT);
    const float lb0 = hgrn_lb(lbl, l, h * 64 + 2 * dp), lb1 = hgrn_lb(lbl, l, h * 64 + 2 * dp + 1);
    const f32x4 g0 = *(const f32x4*)(ogain + cg8 * 8), g1 = *(const f32x4*)(ogain + cg8 * 8 + 4);
    unsigned z2[4], q2[4], v2[4];
#pragma unroll
    for (int j = 0; j < 4; ++j) { const bf16* r = hb + (size_t)(4 * sg + j) * HPITCH + 2 * dp; z2[j] = *(const unsigned*)(r + 1024); q2[j] = *(const unsigned*)(r + 768); v2[j] = *(const unsigned*)(r + 1280); }
    u16x8 gr = *(const u16x8*)(hb + (size_t)t8 * HPITCH + 1536 + cg8 * 8);
    f32x4 S[2] = {(f32x4){0.f, 0.f, 0.f, 0.f}, (f32x4){0.f, 0.f, 0.f, 0.f}};
#pragma unroll 2
    for (int j = 0; j < seg; ++j) { const float* Sj = HSEG + (size_t)(bh * 16 + j) * 4096 + tid; const f32x4 dj = *(const f32x4*)(SEGDEC + (size_t)(bh * 16 + j) * 64 + 16 * mi + 4 * lq);
#pragma unroll
        for (int jn = 0; jn < 2; ++jn) { f32x4 u;
#pragma unroll
            for (int r = 0; r < 4; ++r) u[r] = Sj[(jn * 4 + r) * 512];
            S[jn] = S[jn] * dj + u; } }
#pragma unroll 1
    for (int c = 0; c < 8; ++c) {
        unsigned zn[4], qn[4], vn[4]; u16x8 gn;
        { const int cn = (c < 7) ? c + 1 : c;
#pragma unroll
          for (int j = 0; j < 4; ++j) { const bf16* r = hb + (size_t)(cn * 64 + 4 * sg + j) * HPITCH + 2 * dp; zn[j] = *(const unsigned*)(r + 1024); qn[j] = *(const unsigned*)(r + 768); vn[j] = *(const unsigned*)(r + 1280); }
          gn = *(const u16x8*)(hb + (size_t)(cn * 64 + t8) * HPITCH + 1536 + cg8 * 8); }
        float lf[2][4], kk[2][4], tot[2], ref[2];
        hgrn_front(lds, z2, lb0, lb1, lf, kk, tot, ref, dp, sg);
#pragma unroll
        for (int j = 0; j < 4; ++j) { float qt[2], kt[2], qh[2];
#pragma unroll
            for (int cc = 0; cc < 2; ++cc) { const float bc = lf[cc][j], q = __builtin_bit_cast(float, cc ? (q2[j] & 0xffff0000u) : (q2[j] << 16));
                qt[cc] = q * __builtin_amdgcn_exp2f(fminf(bc - ref[cc], 115.f)); kt[cc] = kk[cc][j] * __builtin_amdgcn_exp2f(fminf(ref[cc] - bc, 115.f)); qh[cc] = q * __builtin_amdgcn_exp2f(bc); }
            const int o = (4 * sg + j) * HP72 + 2 * dp;
            *(LAS unsigned*)(B0 + o) = pk2(qt[0], qt[1]); *(LAS unsigned*)(B1 + o) = pk2(kt[0], kt[1]); *(LAS unsigned*)(B2 + o) = pk2(qh[0], qh[1]); }
#pragma unroll
        for (int cc = 0; cc < 2; ++cc) { float kh[4];
#pragma unroll
            for (int j = 0; j < 4; ++j) kh[j] = kk[cc][j] * __builtin_amdgcn_exp2f(tot[cc] - lf[cc][j]);
            *(LAS pg8::u32x2*)(B6 + (2 * dp + cc) * HP72 + 4 * sg) = (pg8::u32x2){pk2(kh[0], kh[1]), pk2(kh[2], kh[3])}; }
        *(LAS pg8::u32x2*)(B3 + (2 * dp) * HP72 + 4 * sg) = (pg8::u32x2){(v2[0] & 0xffffu) | (v2[1] << 16), (v2[2] & 0xffffu) | (v2[3] << 16)};
        *(LAS pg8::u32x2*)(B3 + (2 * dp + 1) * HP72 + 4 * sg) = (pg8::u32x2){(v2[0] >> 16) | (v2[1] & 0xffff0000u), (v2[2] >> 16) | (v2[3] & 0xffff0000u)};
#pragma unroll
        for (int jn = 0; jn < 2; ++jn) *(LAS pg8::u32x2*)(B4 + (16 * (nj0 + jn) + lr) * HP72 + 16 * mi + 4 * lq) = (pg8::u32x2){pk2(S[jn][0], S[jn][1]), pk2(S[jn][2], S[jn][3])};
        if (sg == 0) *(LAS f32x2v*)(TOTL + 2 * dp) = (f32x2v){tot[0], tot[1]};
        __syncthreads();
        f32x4 un[2] = {(f32x4){0.f, 0.f, 0.f, 0.f}, (f32x4){0.f, 0.f, 0.f, 0.f}};
        { f32x4 acc[2] = {(f32x4){0.f, 0.f, 0.f, 0.f}, (f32x4){0.f, 0.f, 0.f, 0.f}};
#pragma unroll
          for (int ks = 0; ks < 2; ++ks) { const bf16x8 a = *(const LAS bf16x8*)(B1 + (16 * mi + lr) * HP72 + 32 * ks + 8 * lq); const bf16x8 a6 = *(const LAS bf16x8*)(B6 + (16 * mi + lr) * HP72 + 32 * ks + 8 * lq);
#pragma unroll
              for (int jn = 0; jn < 2; ++jn) { const bf16x8 bb = *(const LAS bf16x8*)(B0 + (16 * (nj0 + jn) + lr) * HP72 + 32 * ks + 8 * lq); acc[jn] = mfma16(a, bb, acc[jn]);
                  const bf16x8 b3 = *(const LAS bf16x8*)(B3 + (16 * (nj0 + jn) + lr) * HP72 + 32 * ks + 8 * lq); un[jn] = mfma16(a6, b3, un[jn]); } }
#pragma unroll
          for (int jn = 0; jn < 2; ++jn) { const int t = 16 * (nj0 + jn) + lr, sp = 16 * mi + 4 * lq; float m[4];
#pragma unroll
              for (int r = 0; r < 4; ++r) m[r] = (sp + r <= t) ? acc[jn][r] : 0.f;
              *(LAS pg8::u32x2*)(B5 + t * HP72 + sp) = (pg8::u32x2){pk2(m[0], m[1]), pk2(m[2], m[3])}; } }
        const f32x4 tl = *(const LAS f32x4*)(TOTL + 16 * mi + 4 * lq);
        __syncthreads();
        { f32x4 acc[2] = {(f32x4){0.f, 0.f, 0.f, 0.f}, (f32x4){0.f, 0.f, 0.f, 0.f}};
#pragma unroll
          for (int ks = 0; ks < 2; ++ks) { const bf16x8 a = *(const LAS bf16x8*)(B3 + (16 * mi + lr) * HP72 + 32 * ks + 8 * lq);
#pragma unroll
              for (int jn = 0; jn < 2; ++jn) { const bf16x8 bb = *(const LAS bf16x8*)(B5 + (16 * (nj0 + jn) + lr) * HP72 + 32 * ks + 8 * lq); acc[jn] = mfma16(a, bb, acc[jn]); } }
#pragma unroll
          for (int ks = 0; ks < 2; ++ks) { const bf16x8 a = *(const LAS bf16x8*)(B4 + (16 * mi + lr) * HP72 + 32 * ks + 8 * lq);
#pragma unroll
              for (int jn = 0; jn < 2; ++jn) { const bf16x8 bb = *(const LAS bf16x8*)(B2 + (16 * (nj0 + jn) + lr) * HP72 + 32 * ks + 8 * lq); acc[jn] = mfma16(a, bb, acc[jn]); } }
#pragma unroll
          for (int jn = 0; jn < 2; ++jn) *(LAS f32x4*)(OL + (16 * (nj0 + jn) + lr) * 68 + 16 * mi + 4 * lq) = acc[jn]; }
        { const f32x4 dec = (f32x4){__builtin_amdgcn_exp2f(tl[0]), __builtin_amdgcn_exp2f(tl[1]), __builtin_amdgcn_exp2f(tl[2]), __builtin_amdgcn_exp2f(tl[3])};
          S[0] = S[0] * dec + un[0]; S[1] = S[1] * dec + un[1]; }
        __syncthreads();
        { const f32x4 o0 = *(const LAS f32x4*)(OL + t8 * 68 + cg8 * 8), o1 = *(const LAS f32x4*)(OL + t8 * 68 + cg8 * 8 + 4);
          float ss = (o0[0] * o0[0] + o0[1] * o0[1]) + (o0[2] * o0[2] + o0[3] * o0[3]) + (o1[0] * o1[0] + o1[1] * o1[1]) + (o1[2] * o1[2] + o1[3] * o1[3]);
          ss += __shfl_xor(ss, 1); ss += __shfl_xor(ss, 2); ss += __shfl_xor(ss, 4);
          const float rinv = rsqrtf(ss * (1.0f / 64.0f) + 1e-6f);
          float o[8];
#pragma unroll
          for (int i = 0; i < 4; ++i) { o[i] = o0[i] * rinv * g0[i] * pg8::silu_f(bf2f(gr[i])); o[4 + i] = o1[i] * rinv * g1[i] * pg8::silu_f(bf2f(gr[4 + i])); }
          *(v4u*)(Y + (row0 + c * 64 + t8) * DM + 256 + h * 64 + cg8 * 8) = (v4u){pk2(o[0], o[1]), pk2(o[2], o[3]), pk2(o[4], o[5]), pk2(o[6], o[7])}; }
#pragma unroll
        for (int j = 0; j < 4; ++j) { z2[j] = zn[j]; q2[j] = qn[j]; v2[j] = vn[j]; }
        gr = gn;
    }
    __syncthreads();
}
__device__ __forceinline__ void conv_unit(const bf16* H, const float* cw, bf16* Y, int unit, int tid) {
    const int cgp = tid & 31, tl = tid >> 5, ch = cgp * 8;
    float w0[8], w1[8], w2[8];
#pragma unroll
    for (int i = 0; i < 8; ++i) { w0[i] = cw[ch + i]; w1[i] = cw[256 + ch + i]; w2[i] = cw[512 + ch + i]; }
#pragma unroll 2
    for (int p = 0; p < 4; ++p) { const int row = unit * 64 + p * 16 + tl, t = row & (SEQL - 1);
        const bf16* hp = H + (size_t)row * HPITCH + ch;
        const u16x8 x2 = *(const u16x8*)hp, c2 = *(const u16x8*)(hp + 512), bg = *(const u16x8*)(hp + 256);
        u16x8 x1 = (u16x8){0,0,0,0,0,0,0,0}, c1 = x1, x0 = x1, c0 = x1;
        if (t >= 1) { x1 = *(const u16x8*)(hp - HPITCH); c1 = *(const u16x8*)(hp - HPITCH + 512); }
        if (t >= 2) { x0 = *(const u16x8*)(hp - 2 * HPITCH); c0 = *(const u16x8*)(hp - 2 * HPITCH + 512); }
        float o[8];
#pragma unroll
        for (int i = 0; i < 8; ++i) o[i] = bf2f(bg[i]) * (w0[i] * (bf2f(c0[i]) * bf2f(x0[i])) + w1[i] * (bf2f(c1[i]) * bf2f(x1[i])) + w2[i] * (bf2f(c2[i]) * bf2f(x2[i])));
        *(v4u*)(Y + (size_t)row * DM + ch) = (v4u){pk2(o[0], o[1]), pk2(o[2], o[3]), pk2(o[4], o[5]), pk2(o[6], o[7])}; }
}
__device__ __forceinline__ void cumsum_unit(LAS unsigned char* lds, float* C, int unit, int tid) {
    LAS float* WS = (LAS float*)lds; float* p = C + (size_t)unit * SEQL + tid * 16; const int lane = tid & 63, w = tid >> 6;
    float v[16];
#pragma unroll
    for (int j = 0; j < 4; ++j) { const f32x4 x = *(const f32x4*)(p + 4 * j); v[4 * j] = x[0]; v[4 * j + 1] = x[1]; v[4 * j + 2] = x[2]; v[4 * j + 3] = x[3]; }
#pragma unroll
    for (int i = 1; i < 16; ++i) v[i] += v[i - 1];
    const float tot = v[15]; float inc = tot;
#pragma unroll
    for (int o = 1; o < 64; o <<= 1) { const float t = __shfl_up(inc, o); if (lane >= o) inc += t; }
    if (lane == 63) WS[w] = inc;
    __syncthreads();
    float off = inc - tot;
    for (int q = 0; q < w; ++q) off += WS[q];
#pragma unroll
    for (int j = 0; j < 4; ++j) *(f32x4*)(p + 4 * j) = (f32x4){v[4 * j] + off, v[4 * j + 1] + off, v[4 * j + 2] + off, v[4 * j + 3] + off};
    __syncthreads();
}

__global__ void __launch_bounds__(NWAVES * 64, 2) fwd_mega(Args args) {
    extern __shared__ __attribute__((aligned(16))) unsigned char lds_raw[];
    cg::grid_group grid = cg::this_grid();
    LAS unsigned char* lds = (LAS unsigned char*)lds_raw;
    const int tid = threadIdx.x, lane = tid & 63, wave = __builtin_amdgcn_readfirstlane(tid >> 6);
    const int G = gridDim.x, bx = blockIdx.x; const int vcu = (G % 8 == 0) ? (bx % 8) * (G / 8) + bx / 8 : bx;
    unsigned char* ws = args.ws;
    for (int u_ = threadIdx.x; u_ < (LDS_BYTES - 131072) / 4; u_ += NWAVES * 64) ((LAS unsigned*)(lds + 131072))[u_] = 0u;
    __syncthreads();
    const XcdBarrier xbar = xcd_barrier_post((unsigned*)(ws + WS_BAR), (volatile LAS unsigned*)(lds + 140288));
#define SEAM() do { XcdBarrier b_ = xbar; asm volatile("" : "+s"(b_.x)); xcd_barrier(b_); } while (0)
    unsigned long long* RS = (unsigned long long*)(ws + WS_RS); float* FOXC = (float*)(ws + WS_FOXC); float* DEC = (float*)(ws + WS_DEC);
    unsigned* QCTR = (unsigned*)(ws + WS_QCTR);
    bf16* XB = (bf16*)(ws + WS_XB); bf16* HACT = (bf16*)(ws + WS_HACT); bf16* Y = (bf16*)(ws + WS_Y); float* HST = (float*)(ws + WS_HST);
    const float* x_in = args.in[0]; float* out = args.out;

    STAMP(0);
    {
        LAS float* scr = (LAS float*)(lds + wave * 16384);
        const int gw = vcu * NWAVES + wave, NGW = G * NWAVES;
        constexpr int I_FI = 16 * 176, I_FO = 44 * 32, I_MI = 16 * 112, I_MO = 16 * 32, I_L = 2 * I_FI + 2 * I_FO + I_MI + I_MO;
        for (int it = gw; it < DEPTH * I_L; it += NGW) {
            const int l = it / I_L; int r = it - l * I_L; unsigned char* wl = ws + WS_W + (size_t)l * W_LAYER;
            if (r < I_FI) { tr_item(args.in[2] + (size_t)l * DM * NFF, DM, NFF, 176, args.in[1] + l * DM, (bf16*)(wl + WO_1IN), 1, scr, r, lane); continue; } r -= I_FI;
            if (r < I_FO) { tr_item(args.in[3] + (size_t)l * DFF * DM, DFF, DM, 32, nullptr, (bf16*)(wl + WO_1OUT), 0, scr, r, lane); continue; } r -= I_FO;
            if (r < I_MI) { tr_item(args.in[5] + (size_t)l * DM * NMIX, DM, NMIX, 112, args.in[4] + l * DM, (bf16*)(wl + WO_MIX), 2, scr, r, lane); continue; } r -= I_MI;
            if (r < I_MO) { tr_item(args.in[12] + (size_t)l * DM * DM, DM, DM, 32, nullptr, (bf16*)(wl + WO_MO), 0, scr, r, lane); continue; } r -= I_MO;
            if (r < I_FI) { tr_item(args.in[14] + (size_t)l * DM * NFF, DM, NFF, 176, args.in[13] + l * DM, (bf16*)(wl + WO_2IN), 1, scr, r, lane); continue; } r -= I_FI;
            tr_item(args.in[15] + (size_t)l * DFF * DM, DFF, DM, 32, nullptr, (bf16*)(wl + WO_2OUT), 0, scr, r, lane);
        }
#pragma unroll 4
        for (int m = gw; m < M; m += NGW) {
            const f32x4* xr = (const f32x4*)(x_in + (size_t)m * DM) + lane; f32x4 v[4]; float s = 0.f;
#pragma unroll
            for (int j = 0; j < 4; ++j) { v[j] = __builtin_nontemporal_load(xr + 64 * j); s += (v[j][0] * v[j][0] + v[j][1] * v[j][1]) + (v[j][2] * v[j][2] + v[j][3] * v[j][3]); }
            s = wave_sum(s); if (lane == 0) RS[m] = (unsigned long long)(s * 16777216.0f);
            unsigned long long* o8 = (unsigned long long*)(XB + (size_t)m * DM) + lane;
#pragma unroll
            for (int j = 0; j < 4; ++j) o8[64 * j] = (unsigned long long)pk2(v[j][0], v[j][1]) | ((unsigned long long)pk2(v[j][2], v[j][3]) << 32);
        }
        for (int i = bx * (NWAVES * 64) + tid; i < 5 * M; i += G * NWAVES * 64) RS[M + i] = 0ull;
    }
    if (gridDim.x == 0x7fffffffu) grid.sync();
    SEAM(); STAMP(1);

#pragma unroll 1
    for (int step = 0; step < 3 * DEPTH; ++step) {
        const int l = step / 3, kind = step - 3 * l; unsigned char* wl = ws + WS_W + (size_t)l * W_LAYER;
        int tid = threadIdx.x; asm volatile("" : "+v"(tid));
        const unsigned long long* rs_in = RS + (size_t)step * M; unsigned long long* rs_out = (step + 1 < 3 * DEPTH) ? RS + (size_t)(step + 1) * M : nullptr;
        if (kind != 1) {
            const bf16* w_in = (const bf16*)(wl + (kind == 0 ? WO_1IN : WO_2IN)); const bf16* w_out = (const bf16*)(wl + (kind == 0 ? WO_1OUT : WO_2OUT));
            { pg8::Gemm g{XB, w_in, M, NFF, DM}; pg8::StaticOrder S; S.init(M, NFF, G, bx);
              pg8::EpiGlu E{HACT, DFF, rs_in};
              if (EN_G1) pg8::gemm_phase<pg8::EpiGlu, pg8::StaticOrder, true, true>(lds, g, S, E); }
            SEAM(); STAMP(2 + step * 8 + 0);
            { pg8::Gemm g{HACT, w_out, M, DM, DFF}; pg8::StaticOrder S; S.init(M, DM, G, bx);
              pg8::EpiResid E{XB, rs_out ? nullptr : out, rs_out, 0.5f};
              if (EN_G2) pg8::gemm_phase<pg8::EpiResid, pg8::StaticOrder, true, true>(lds, g, S, E); }
            if (step + 1 < 3 * DEPTH || PROBE_MASK) SEAM();
            STAMP(2 + step * 8 + 1);
        } else {
            { pg8::Gemm g{XB, (const bf16*)(wl + WO_MIX), M, HPITCH, DM}; pg8::StaticOrder S; S.init(M, HPITCH, G, bx);
              pg8::EpiMix E{HACT, rs_in, args.in[9] + l * 64, args.in[10] + l * 64, args.in[11] + l * 8, FOXC};
              if (EN_G3) pg8::gemm_phase<pg8::EpiMix, pg8::StaticOrder, true, true>(lds, g, S, E); }
            SEAM(); STAMP(2 + step * 8 + 0);
            for (int u = bx; u < 256 + 32; u += G) {
                if (u < 256) { if (EN_MA) for (int rep_ = 0; rep_ < HG_REP; ++rep_) hgrn_seg_local(lds, HACT, args.in[7], l, HST, DEC, u, tid); }
                else cumsum_unit(lds, FOXC, u - 256, tid);
            }
            SEAM(); STAMP(2 + step * 8 + 1);
            { unsigned* qc = QCTR + 64 * l; LAS unsigned* slot = (LAS unsigned*)(lds + 139264);
              for (;;) {
                  if (threadIdx.x == 0) *slot = atomicAdd(qc, 1u);
                  __syncthreads(); const int u = (int)__builtin_amdgcn_readfirstlane(*slot); __syncthreads();
                  if (u >= 1024 + 256 + 512) break;
                  if (u < 1024) { const int bh = u & 31, qb = 31 - (u >> 5);
                      if (EN_ATT) attn_body::attn_unit<48>(bh >> 3, bh & 7, qb, (const attn_body::bf16*)(HACT + 1792), (const attn_body::bf16*)(HACT + 2304), (const attn_body::bf16*)(HACT + 2816), (attn_body::bf16*)(Y + 512), FOXC, args.in[9] + l * 64, args.in[10] + l * 64, (char*)lds_raw); }
                  else if (u >= 1024 + 256) { int tq = threadIdx.x; asm volatile("" : "+v"(tq)); conv_unit(HACT, args.in[6] + l * 768, Y, u - 1280, tq); }
                  else { int tq = threadIdx.x; asm volatile("" : "+v"(tq));
                      if (EN_MC) for (int rep_ = 0; rep_ < HG_REP; ++rep_) hgrn_seg_out(lds, HACT, args.in[7], l, HST, DEC, args.in[8] + l * 64, Y, u - 1024, tq); }
              } }
            if (PROBE_MASK) { STAMP(2 + step * 8 + 2); }
            SEAM(); STAMP(2 + step * 8 + 3); STAMP(2 + step * 8 + 4);
            { pg8::Gemm g{Y, (const bf16*)(wl + WO_MO), M, DM, DM}; pg8::StaticOrder S; S.init(M, DM, G, bx);
              pg8::EpiResid E{XB, nullptr, rs_out, 1.0f};
              if (EN_G5) pg8::gemm_phase<pg8::EpiResid, pg8::StaticOrder, true, true>(lds, g, S, E); }
            SEAM(); STAMP(2 + step * 8 + 5);
        }
    }
    for (int i_ = 0; i_ < XSYNC; ++i_) SEAM();
    if (PROBE_MASK && bx == 0 && threadIdx.x == 0) {
        const LAS unsigned long long* T = (const LAS unsigned long long*)(lds + 135168);
        unsigned long long X = 0, prev = T[1];
        if (PROBE_MASK & 1) X += T[1] - T[0];
        for (int st = 0; st < 3 * DEPTH; ++st) { const LAS unsigned long long* q = T + 2 + st * 8;
            if (st % 3 != 1) { if (PROBE_MASK & 2) X += q[0] - prev; if (PROBE_MASK & 4) X += q[1] - q[0]; prev = q[1]; }
            else { if (PROBE_MASK & 8) X += q[0] - prev; if (PROBE_MASK & 16) X += q[1] - q[0]; if (PROBE_MASK & 32) X += q[2] - q[1]; if (PROBE_MASK & 64) X += q[3] - q[2];
                   if (PROBE_MASK & 128) X += q[4] - q[3]; if (PROBE_MASK & 256) X += q[5] - q[4]; prev = q[5]; } }
        const unsigned long long t0 = __builtin_amdgcn_s_memrealtime();
        while (__builtin_amdgcn_s_memrealtime() - t0 < X) __builtin_amdgcn_s_sleep(16);
    }
}

extern "C" void kernel_launch(void* const* d_in, const int* in_sizes, int n_in, void* d_out, int out_size, void* d_ws, size_t ws_size, hipStream_t stream) {
    static int grid = 0;
    if (grid == 0) {
        if (n_in != 16 || out_size != M * DM || ws_size < WS_END) { fprintf(stderr, "kernel_launch: unexpected shapes (n_in %d out %d ws %zu)\n", n_in, out_size, ws_size); grid = -1; return; }
        int dev = 0, cus = 0, per_cu = 0;
        hipGetDevice(&dev); hipDeviceGetAttribute(&cus, hipDeviceAttributeMultiprocessorCount, dev);
        hipFuncSetAttribute((const void*)fwd_mega, hipFuncAttributeMaxDynamicSharedMemorySize, LDS_BYTES);
        if (hipOccupancyMaxActiveBlocksPerMultiprocessor(&per_cu, (const void*)fwd_mega, NWAVES * 64, LDS_BYTES) != hipSuccess || per_cu < 1) { fprintf(stderr, "kernel_launch: occupancy query failed (%d)\n", per_cu); per_cu = 1; }
        (void)hipGetLastError();
        grid = cus * 1;
    }
    if (grid < 0) return;
    if (hipMemsetAsync((char*)d_ws + WS_QCTR, 0, WS_CTL_ZERO, stream) != hipSuccess) { fprintf(stderr, "kernel_launch: memset of the control words failed\n"); return; }
    Args a{};
    for (int i = 0; i < 16; ++i) a.in[i] = (const float*)d_in[i];
    a.out = (float*)d_out; a.ws = (unsigned char*)d_ws;
    void* kargs[] = {&a};
    hipError_t e = hipLaunchCooperativeKernel((const void*)fwd_mega, dim3(grid), dim3(NWAVES * 64), kargs, LDS_BYTES, stream);
    if (e != hipSuccess) fprintf(stderr, "cooperative launch failed: %s (grid %d)\n", hipGetErrorString(e), grid);
}
```
